# Optimizing an MI355X kernel written in HIP

```python
import jax, jax.numpy as jnp
from jax import lax
import numpy as np

D_MODEL = 1024
BATCH = 16
SEQ = 2048
DEPTH = 1

GRID_W = 64
CTX_LEN = 256
D_MIX = D_MODEL
GLA_WIDTH = D_MIX // 2
POOL_WIDTH = D_MIX - GLA_WIDTH
GLA_HEADS = 4
GLA_DV = GLA_WIDTH // GLA_HEADS
GLA_DK = GLA_DV // 2
GLA_QK = GLA_HEADS * GLA_DK
GATE_RANK = 16
GATE_NORMALIZER = 16.0
GLA_CHUNK = 64
POOL_GROUPS = 4
POOL_GC = POOL_WIDTH // POOL_GROUPS
POOL_WINDOWS = (2, 4, 8, 16)
N_EXPERTS = 32
TOP_K = 4
D_FF = D_MODEL
SWIGLU_LIMIT = 7.0
SWIGLU_ALPHA = 1.702
EXPERT_BLOCK = 128
N_MOD = 6
EPS = 1e-6
D_IN = 2 * GLA_QK + 2 * GLA_WIDTH + 2 * GATE_RANK + POOL_WIDTH
SPLIT_POINTS = (GLA_QK, 2 * GLA_QK, 2 * GLA_QK + GLA_WIDTH, 2 * GLA_QK + 2 * GLA_WIDTH,
                2 * GLA_QK + 2 * GLA_WIDTH + GATE_RANK, 2 * GLA_QK + 2 * GLA_WIDTH + 2 * GATE_RANK)

kernel_name = "hybrid_gla_pool_moe_diffusion_layer"


def rmsnorm(x, w):
    xf = x.astype(jnp.float32)
    var = jnp.mean(xf * xf, axis=-1, keepdims=True)
    return (xf * lax.rsqrt(var + EPS) * w.astype(jnp.float32)).astype(x.dtype)


def modulate(h, shift, scale):
    return h * (1.0 + scale) + shift


def to_heads(t, d):
    b_, n, _ = t.shape
    return t.reshape(b_, n, GLA_HEADS, d).transpose(0, 2, 1, 3).astype(jnp.float32)


def mixer_inputs(p, w_gk_f, b_gk_f, w_gk_b, b_gk_b):
    q, k, v, g, r_f, r_b, pool_in = jnp.split(p, SPLIT_POINTS, axis=-1)
    gk_f = jax.nn.log_sigmoid((r_f @ w_gk_f + b_gk_f).astype(jnp.float32)) / GATE_NORMALIZER
    gk_b = jax.nn.log_sigmoid((r_b @ w_gk_b + b_gk_b).astype(jnp.float32)) / GATE_NORMALIZER
    return (to_heads(q, GLA_DK), to_heads(k, GLA_DK), to_heads(v, GLA_DV),
            to_heads(gk_f, GLA_DK), to_heads(gk_b, GLA_DK), g, pool_in)


def gla_chunked(q, k, v, gk, s0, with_output=True):
    b_, h_, t_, dk = q.shape
    dv = v.shape[-1]
    n_ch = t_ // GLA_CHUNK
    qc = q.reshape(b_, h_, n_ch, GLA_CHUNK, dk) * (dk ** -0.5)
    kc = k.reshape(b_, h_, n_ch, GLA_CHUNK, dk)
    vc = v.reshape(b_, h_, n_ch, GLA_CHUNK, dv)
    bcum = jnp.cumsum(gk.reshape(b_, h_, n_ch, GLA_CHUNK, dk), axis=3)
    b_last = bcum[:, :, :, -1:, :]
    u = jnp.einsum('bhnsk,bhnsv->bhnkv', kc * jnp.exp(b_last - bcum), vc)
    decay = jnp.exp(b_last[:, :, :, 0, :])

    def step(s, inp):
        d, un = inp
        return d[..., None] * s + un, s

    s_final, s_prev = lax.scan(step, s0, (jnp.moveaxis(decay, 2, 0), jnp.moveaxis(u, 2, 0)))
    if not with_output:
        return None, s_final
    s_prev = jnp.moveaxis(s_prev, 0, 2)
    b_mid = bcum[:, :, :, GLA_CHUNK // 2 - 1:GLA_CHUNK // 2, :]
    a = jnp.einsum('bhntk,bhnsk->bhnts', qc * jnp.exp(bcum - b_mid), kc * jnp.exp(b_mid - bcum))
    mask = jnp.tril(jnp.ones((GLA_CHUNK, GLA_CHUNK), dtype=bool))
    a = jnp.where(mask, a, 0.0)
    o = (jnp.einsum('bhnts,bhnsv->bhntv', a, vc)
         + jnp.einsum('bhntk,bhnkv->bhntv', qc * jnp.exp(bcum), s_prev))
    return o.reshape(b_, h_, t_, dv), s_final


def gla_bidir(q, k, v, gk_f, gk_b, s0_f, s0_b, with_output=True):
    flip = lambda t: jnp.flip(t, axis=2)
    o_f, s_f = gla_chunked(q, k, v, gk_f, s0_f, with_output)
    o_b, s_b = gla_chunked(flip(q), flip(k), flip(v), flip(gk_b), s0_b, with_output)
    o = o_f + flip(o_b) if with_output else None
    return o, s_f, s_b


def gla_output(o, g, w_norm):
    b_, _, n, _ = o.shape
    o = o.transpose(0, 2, 1, 3)
    o = o * lax.rsqrt(jnp.mean(o * o, axis=-1, keepdims=True) + EPS) * w_norm.astype(jnp.float32)
    gate = jax.nn.silu(g.astype(jnp.float32)).reshape(o.shape)
    return (o * gate).reshape(b_, n, GLA_WIDTH)


def window_bounds(pos, w, length):
    lo = w // 2
    hi = w - 1 - lo
    return jnp.clip(pos - lo, 0, length), jnp.clip(pos + hi + 1, 0, length)


def pool_grid(xp, rows):
    b_, n, _ = xp.shape
    xf = xp.astype(jnp.float32).reshape(b_, rows, GRID_W, POOL_GROUPS, POOL_GC)
    sat = jnp.pad(jnp.cumsum(jnp.cumsum(xf, axis=1), axis=2), ((0, 0), (1, 0), (1, 0), (0, 0), (0, 0)))
    r = jnp.arange(rows)
    col = jnp.arange(GRID_W)
    outs = []
    for gi, w in enumerate(POOL_WINDOWS):
        r0, r1 = window_bounds(r, w, rows)
        c0, c1 = window_bounds(col, w, GRID_W)
        s = sat[:, :, :, gi]
        s_r1, s_r0 = s[:, r1], s[:, r0]
        tot = s_r1[:, :, c1] - s_r0[:, :, c1] - s_r1[:, :, c0] + s_r0[:, :, c0]
        cnt = ((r1 - r0)[:, None] * (c1 - c0)[None, :]).astype(jnp.float32)
        outs.append(tot / cnt[None, :, :, None])
    mean = jnp.stack(outs, axis=3)
    return (mean - xf).reshape(b_, n, POOL_GROUPS, POOL_GC)


def pool_seq(xp):
    b_, n, _ = xp.shape
    xf = xp.astype(jnp.float32).reshape(b_, n, POOL_GROUPS, POOL_GC)
    cs = jnp.pad(jnp.cumsum(xf, axis=1), ((0, 0), (1, 0), (0, 0), (0, 0)))
    pos = jnp.arange(n)
    outs = []
    for gi, w in enumerate(POOL_WINDOWS):
        i0, i1 = window_bounds(pos, w, n)
        outs.append((cs[:, i1, gi] - cs[:, i0, gi]) / (i1 - i0).astype(jnp.float32)[None, :, None])
    return jnp.stack(outs, axis=2) - xf


def pool_project(pooled, w_pool, pool_scale):
    b_, n = pooled.shape[:2]
    y = jnp.einsum('bngc,gcd->bngd', pooled, w_pool.astype(jnp.float32)).reshape(b_, n, POOL_WIDTH)
    return y * pool_scale.astype(jnp.float32)


def moe(h, w_router, b_router, w_gu, b_gu, w_down, b_down):
    shp = h.shape
    xt = h.reshape(-1, D_MODEL)
    n_tok = xt.shape[0]
    n_assign = n_tok * TOP_K
    logits = (xt @ w_router + b_router).astype(jnp.float32)
    top_vals, top_idx = lax.top_k(logits, TOP_K)
    weights = jax.nn.softmax(top_vals, axis=-1)
    flat_e = top_idx.reshape(-1)
    flat_tok = jnp.repeat(jnp.arange(n_tok, dtype=jnp.int32), TOP_K)
    flat_w = weights.reshape(-1)
    order = jnp.argsort(flat_e)
    sorted_e = flat_e[order]
    counts = jnp.bincount(flat_e, length=N_EXPERTS)
    padded = (counts + EXPERT_BLOCK - 1) // EXPERT_BLOCK * EXPERT_BLOCK
    start_unpad = jnp.cumsum(counts) - counts
    pad_end = jnp.cumsum(padded)
    start_pad = pad_end - padded
    dest = start_pad[sorted_e] + (jnp.arange(n_assign) - start_unpad[sorted_e])
    n_pad = n_assign + N_EXPERTS * EXPERT_BLOCK
    n_blocks = n_pad // EXPERT_BLOCK
    buf_tok = jnp.full((n_pad,), n_tok, dtype=jnp.int32).at[dest].set(flat_tok[order])
    buf_w = jnp.zeros((n_pad,), jnp.float32).at[dest].set(flat_w[order])
    block_e = jnp.minimum(jnp.searchsorted(pad_end, jnp.arange(n_blocks) * EXPERT_BLOCK, side='right'),
                          N_EXPERTS - 1)
    x_pad = jnp.concatenate([xt, jnp.zeros((1, D_MODEL), xt.dtype)], axis=0)
    xb = x_pad[buf_tok].reshape(n_blocks, EXPERT_BLOCK, D_MODEL)

    def expert_block(args):
        xblk, e = args
        gu = xblk @ w_gu[e] + b_gu[e]
        gate, up = jnp.split(gu, 2, axis=-1)
        gate = jnp.minimum(gate, SWIGLU_LIMIT)
        up = jnp.clip(up, -SWIGLU_LIMIT, SWIGLU_LIMIT)
        act = (up + 1.0) * gate * jax.nn.sigmoid(SWIGLU_ALPHA * gate)
        return act @ w_down[e] + b_down[e]

    yb = lax.map(expert_block, (xb, block_e)).reshape(n_pad, D_MODEL)
    y = jnp.zeros((n_tok + 1, D_MODEL), yb.dtype).at[buf_tok].add(yb * buf_w[:, None].astype(yb.dtype))
    return y[:n_tok].reshape(shp)


def setup_inputs(seed: int = 0) -> dict:
    key = jax.random.key(seed)
    ks = jax.random.split(key, 32)
    nrm = lambda k, shp, s: jax.random.normal(k, shp, jnp.float32) * s
    L, D, E = DEPTH, D_MODEL, N_EXPERTS
    return {
        "x": nrm(ks[0], (BATCH, SEQ, D), 1.0),
        "c": nrm(ks[1], (BATCH, D), 1.0),
        "ctx": nrm(ks[2], (BATCH, CTX_LEN, D), 1.0),
        "c_ctx": nrm(ks[3], (D,), 1.0),
        "w_ada": nrm(ks[4], (L, D, N_MOD * D), 0.5 * D ** -0.5),
        "b_ada": nrm(ks[5], (L, N_MOD * D), 0.02),
        "norm_mix_w": 1.0 + nrm(ks[6], (L, D), 0.02),
        "norm_mlp_w": 1.0 + nrm(ks[7], (L, D), 0.02),
        "w_in": nrm(ks[8], (L, D, D_IN), D ** -0.5),
        "w_gk_f": nrm(ks[9], (L, GATE_RANK, GLA_QK), GATE_RANK ** -0.5),
        "b_gk_f": jax.random.uniform(ks[10], (L, GLA_QK), jnp.float32, -2.0, 4.0),
        "w_gk_b": nrm(ks[11], (L, GATE_RANK, GLA_QK), GATE_RANK ** -0.5),
        "b_gk_b": jax.random.uniform(ks[12], (L, GLA_QK), jnp.float32, -2.0, 4.0),
        "gla_norm_w": 1.0 + nrm(ks[13], (L, GLA_DV), 0.02),
        "w_pool": nrm(ks[14], (L, POOL_GROUPS, POOL_GC, POOL_GC), POOL_GC ** -0.5),
        "pool_scale": 1.0 + nrm(ks[15], (L, POOL_WIDTH), 0.1),
        "w_out": nrm(ks[16], (L, D_MIX, D), D_MIX ** -0.5),
        "w_router": nrm(ks[17], (L, D, E), D ** -0.5),
        "b_router": nrm(ks[18], (L, E), 0.01),
        "w_gu": nrm(ks[19], (L, E, D, 2 * D_FF), D ** -0.5),
        "b_gu": nrm(ks[20], (L, E, 2 * D_FF), 0.02),
        "w_down": nrm(ks[21], (L, E, D_FF, D), D_FF ** -0.5),
        "b_down": nrm(ks[22], (L, E, D), 0.02),
        "final_norm_w": 1.0 + nrm(ks[23], (D,), 0.02),
    }


def reference(x, c, ctx, c_ctx, w_ada, b_ada, norm_mix_w, norm_mlp_w, w_in, w_gk_f, b_gk_f, w_gk_b,
              b_gk_b, gla_norm_w, w_pool, pool_scale, w_out, w_router, b_router, w_gu, b_gu, w_down,
              b_down, final_norm_w):
    h, hc = x, ctx
    b_, n_lat, _ = x.shape
    rows = n_lat // GRID_W
    for l in range(DEPTH):
        last = l == DEPTH - 1
        mod_x = (jax.nn.silu(c) @ w_ada[l] + b_ada[l])[:, None, :]
        mod_c = jax.nn.silu(c_ctx) @ w_ada[l] + b_ada[l]
        sh1, sc1, g1, sh2, sc2, g2 = jnp.split(mod_x, N_MOD, axis=-1)
        csh1, csc1, cg1, csh2, csc2, cg2 = jnp.split(mod_c, N_MOD, axis=-1)

        p_x = modulate(rmsnorm(h, norm_mix_w[l]), sh1, sc1) @ w_in[l]
        p_c = modulate(rmsnorm(hc, norm_mix_w[l]), csh1, csc1) @ w_in[l]
        qx, kx, vx, gkfx, gkbx, gx, poolx = mixer_inputs(p_x, w_gk_f[l], b_gk_f[l], w_gk_b[l], b_gk_b[l])
        qc, kc, vc, gkfc, gkbc, gc, poolc = mixer_inputs(p_c, w_gk_f[l], b_gk_f[l], w_gk_b[l], b_gk_b[l])

        s0 = jnp.zeros((b_, GLA_HEADS, GLA_DK, GLA_DV), jnp.float32)
        o_c, s_f, s_b = gla_bidir(qc, kc, vc, gkfc, gkbc, s0, s0, with_output=not last)
        o_x, _, _ = gla_bidir(qx, kx, vx, gkfx, gkbx, s_f, s_b)

        mix_x = jnp.concatenate([gla_output(o_x, gx, gla_norm_w[l]),
                                 pool_project(pool_grid(poolx, rows), w_pool[l], pool_scale[l])], axis=-1)
        h = h + g1 * (mix_x.astype(h.dtype) @ w_out[l])

        if not last:
            mix_c = jnp.concatenate([gla_output(o_c, gc, gla_norm_w[l]),
                                     pool_project(pool_seq(poolc), w_pool[l], pool_scale[l])], axis=-1)
            hc = hc + cg1 * (mix_c.astype(hc.dtype) @ w_out[l])
            hc = hc + cg2 * moe(modulate(rmsnorm(hc, norm_mlp_w[l]), csh2, csc2),
                                w_router[l], b_router[l], w_gu[l], b_gu[l], w_down[l], b_down[l])

        h = h + g2 * moe(modulate(rmsnorm(h, norm_mlp_w[l]), sh2, sc2),
                         w_router[l], b_router[l], w_gu[l], b_gu[l], w_down[l], b_down[l])
    return rmsnorm(h, final_norm_w)
```

```cpp
#include <hip/hip_runtime.h>
#include <stdint.h>
#include <stdio.h>

#define LAS __attribute__((address_space(3)))
#define GAS __attribute__((address_space(1)))
typedef unsigned short bf16_t;
typedef short bf16x8 __attribute__((ext_vector_type(8)));
typedef float f32x4 __attribute__((ext_vector_type(4)));
typedef float f32x2 __attribute__((ext_vector_type(2)));
typedef float f32x16 __attribute__((ext_vector_type(16)));
typedef unsigned u32x4 __attribute__((ext_vector_type(4)));
typedef unsigned u32x2 __attribute__((ext_vector_type(2)));

constexpr int D = 1024, NB = 16, SEQ = 2048, CTX = 256;
constexpr int NTOK = NB * SEQ, NCTX = NB * CTX, NROW = NTOK + NCTX;
constexpr int DIN = 2080, NE = 32, DFF = 1024;
constexpr int GW = 64, GROWS = 32;
constexpr int NMOD = 6144;
constexpr float EPS = 1e-6f;
constexpr int NWAVES = 8, NTHR = 512;
constexpr int WIN_N = 2304;
constexpr int NPADROWS = NTOK * 4 + NE * 256;

__device__ __forceinline__ unsigned f2bf(float f) { unsigned u = __builtin_bit_cast(unsigned, f); return (u + 0x7fffu + ((u >> 16) & 1u)) >> 16; }
__device__ __forceinline__ unsigned pk2(float lo, float hi) { return f2bf(lo) | (f2bf(hi) << 16); }
__device__ __forceinline__ float bf2f(unsigned v) { return __builtin_bit_cast(float, v << 16); }
__device__ __forceinline__ float bflo(unsigned w) { return __builtin_bit_cast(float, w << 16); }
__device__ __forceinline__ float bfhi(unsigned w) { return __builtin_bit_cast(float, w & 0xffff0000u); }
__device__ __forceinline__ unsigned cvt_pk_bf16(float lo, float hi) { unsigned r; asm volatile("v_cvt_pk_bf16_f32 %0, %1, %2" : "=v"(r) : "v"(lo), "v"(hi)); return r; }
__device__ __forceinline__ float wave_sum(float v) {
#pragma unroll
    for (int o = 1; o < 64; o <<= 1) v += __shfl_xor(v, o);
    return v;
}
__device__ __forceinline__ float silu_f(float x) { return x / (1.f + __expf(-x)); }
__device__ __forceinline__ float logsigmoid_f(float x) { return fminf(x, 0.f) - log1pf(expf(-fabsf(x))); }
#define LDS_WAIT() asm volatile("s_waitcnt lgkmcnt(0)" ::: "memory")
#define VM_WAIT() asm volatile("s_waitcnt vmcnt(0)" ::: "memory")

namespace pg8 {
constexpr int BM = 256, BK = 64, HALF = 128, HTB = HALF * BK * 2  , STAGE_BYTES = 8 * HTB, NXCD = 8, WGM = 8;
__host__ __device__ __forceinline__ int lds_byte(int r, int c) { const int st = (r >> 4) * 2 + (c >> 5), rr = r & 15, cc = c & 31, ob = rr * 64 + cc * 2; return st * 1024 + (ob ^ (((ob >> 9) & 1) << 5)); }
__host__ __device__ __forceinline__ void stage_rc(int b, int& R, int& C) { const int st = b / 1024, sb = b % 1024, swz = sb ^ (((sb >> 9) & 1) << 5); R = (st >> 1) * 16 + swz / 64; C = (st & 1) * 32 + (swz % 64) / 2; }
__host__ __device__ __forceinline__ int perm32(int rho) { const int n = rho >> 4, i = rho & 15; return 8 * (i >> 2) + 4 * n + (i & 3); }

struct Unit { int pm, pn, arow, bt, nvalid, e; };

typedef int i32x8 __attribute__((ext_vector_type(8)));
typedef int i32x4v __attribute__((ext_vector_type(4)));
__device__ __forceinline__ i32x8 cat8(const bf16x8 a, const bf16x8 b) { const i32x4v x = __builtin_bit_cast(i32x4v, a), y = __builtin_bit_cast(i32x4v, b); return __builtin_shufflevector(x, y, 0, 1, 2, 3, 4, 5, 6, 7); }
__device__ __forceinline__ bf16x8 lo8(const i32x8 v) { return __builtin_bit_cast(bf16x8, (i32x4v)__builtin_shufflevector(v, v, 0, 1, 2, 3)); }
__device__ __forceinline__ bf16x8 hi8(const i32x8 v) { return __builtin_bit_cast(bf16x8, (i32x4v)__builtin_shufflevector(v, v, 4, 5, 6, 7)); }
template <class Epi, class Sched, bool ALIGN_EPI, bool FP8>
__device__ __forceinline__ void gemm_phase(LAS unsigned char* lds, const char* Abase, const char* Bbase, const int pitch, const Sched& S, const Epi& E) {
    const int tid = threadIdx.x, wid = __builtin_amdgcn_readfirstlane(tid >> 6), lane = tid & 63, wr = wid >> 2, wc = wid & 3, fr = lane & 15, fq = lane >> 4;
    const int nt = pitch / 128;
    unsigned voffB[2];
#pragma unroll
    for (int i = 0; i < 2; ++i) { int R, C; stage_rc(tid * 16 + i * 8192, R, C); const int Rb = (R & ~31) + perm32(R & 31);
        voffB[i] = (unsigned)(Rb * pitch) + (unsigned)C * 2u; }
    const size_t kstep = (size_t)(BK * 2);
    const size_t hstep = (size_t)HALF * pitch;
    const unsigned ldsw = (unsigned)wid * 1024u;
    const int aoff = lds_byte(wr * 64 + fr, fq * 8), boff = lds_byte(wc * 32 + fr, fq * 8);
#define PG8_SA(b, h) (((b) * 2 + (h)) * HTB)
#define PG8_SB(b, h) ((4 + (b) * 2 + (h)) * HTB)
#define PG8_STAGE_B(bufoff, gbase) do { _Pragma("unroll") for (int _i = 0; _i < 2; ++_i) \
        __builtin_amdgcn_global_load_lds((const unsigned*)((const char*)(gbase) + voffB[_i]), (LAS unsigned*)(lds + (bufoff) + ldsw + _i * 8192), 16, 0, 0); } while (0)
#define PG8_STAGE_A(bufoff, ao, kb) do { _Pragma("unroll") for (int _i = 0; _i < 2; ++_i) \
        __builtin_amdgcn_global_load_lds((const unsigned*)(Abase + (size_t)(ao)[_i] + (size_t)(kb)), (LAS unsigned*)(lds + (bufoff) + ldsw + _i * 8192), 16, 0, 0); } while (0)
#define PG8_LDA(dst, b, h) do { _Pragma("unroll") for (int m = 0; m < 4; ++m) dst[m] = cat8(*(const LAS bf16x8*)(lds + PG8_SA(b, h) + aoff + m * 2048), *(const LAS bf16x8*)(lds + PG8_SA(b, h) + aoff + m * 2048 + 1024)); } while (0)
#define PG8_LDB(dst, b, h) do { _Pragma("unroll") for (int n = 0; n < 2; ++n) dst[n] = cat8(*(const LAS bf16x8*)(lds + PG8_SB(b, h) + boff + n * 2048), *(const LAS bf16x8*)(lds + PG8_SB(b, h) + boff + n * 2048 + 1024)); } while (0)
#define PG8_MMA(ai, bj, At, Bt) do { __builtin_amdgcn_s_setprio(1); _Pragma("unroll") for (int m = 0; m < 4; ++m) _Pragma("unroll") for (int n = 0; n < 2; ++n) { \
        if constexpr (FP8) { acc[ai][bj][m][n] = __builtin_amdgcn_mfma_scale_f32_16x16x128_f8f6f4(Bt[n], At[m], acc[ai][bj][m][n], 0, 0, 0, 0x7f7f7f7f, 0, 0x7f7f7f7f); } \
        else { acc[ai][bj][m][n] = __builtin_amdgcn_mfma_f32_16x16x32_bf16(lo8(Bt[n]), lo8(At[m]), acc[ai][bj][m][n], 0, 0, 0); \
               acc[ai][bj][m][n] = __builtin_amdgcn_mfma_f32_16x16x32_bf16(hi8(Bt[n]), hi8(At[m]), acc[ai][bj][m][n], 0, 0, 0); } } \
        __builtin_amdgcn_s_setprio(0); } while (0)
#define PG8_WAIT_V(n) asm volatile("s_waitcnt vmcnt(" #n ")" ::: "memory")
#define PG8_WAIT_L(n) asm volatile("s_waitcnt lgkmcnt(" #n ")" ::: "memory")
#define PG8_BAR __builtin_amdgcn_s_barrier()
#define PG8_SCHED __builtin_amdgcn_sched_barrier(0)
    Unit cur, nxt; int ui = 0;
    if (!S.next(0, cur)) return;
    f32x4 acc[2][2][4][2];
#pragma unroll
    for (int a = 0; a < 2; ++a)
#pragma unroll
        for (int b = 0; b < 2; ++b)
#pragma unroll
            for (int m = 0; m < 4; ++m)
#pragma unroll
                for (int n = 0; n < 2; ++n) acc[a][b][m][n] = (f32x4){0.f, 0.f, 0.f, 0.f};
    i32x8 At[4], B0[2], B1[2];
    unsigned aoc[2][2];
    LAS u32x4* nxslot = (LAS u32x4*)(lds + STAGE_BYTES) + tid;
#pragma unroll
    for (int h = 0; h < 2; ++h)
#pragma unroll
        for (int i = 0; i < 2; ++i) { int R2, C2; stage_rc(tid * 16 + i * 8192, R2, C2); aoc[h][i] = S.arow(cur, h * HALF + R2) * (unsigned)pitch + (unsigned)C2 * 2u; }
    const char* cB = Bbase + (size_t)cur.bt * pitch;
    PG8_STAGE_B(PG8_SB(0, 0), cB); PG8_STAGE_B(PG8_SB(0, 1), cB + hstep); PG8_STAGE_A(PG8_SA(0, 0), aoc[0], 0); PG8_STAGE_A(PG8_SA(0, 1), aoc[1], 0);
    if (wr == 1) PG8_BAR;
    PG8_WAIT_V(2); PG8_BAR;
    PG8_STAGE_B(PG8_SB(1, 0), cB + kstep); PG8_STAGE_A(PG8_SA(1, 0), aoc[0], kstep); PG8_STAGE_B(PG8_SB(1, 1), cB + hstep + kstep);
    PG8_WAIT_V(6); PG8_BAR;
    for (;;) {
        const bool has_next = S.next(ui + 1, nxt);
        int tq = tid; asm volatile("" : "+v"(tq));
        { unsigned nx4[4];
#pragma unroll
          for (int h = 0; h < 2; ++h)
#pragma unroll
              for (int i = 0; i < 2; ++i) { int R2, C2; stage_rc(tq * 16 + i * 8192, R2, C2); nx4[h * 2 + i] = has_next ? S.arow(nxt, h * HALF + R2) * (unsigned)pitch + (unsigned)C2 * 2u : aoc[h][i]; }
          *nxslot = (u32x4){nx4[0], nx4[1], nx4[2], nx4[3]}; }
        const char* nB = has_next ? Bbase + (size_t)nxt.bt * pitch : cB;
#pragma nounroll
        for (int t = 0; t < nt; t += 2) {
            const bool last = (t == nt - 2);
            const size_t k1 = (size_t)(t + 1) * kstep;
            const size_t k2 = last ? (size_t)0 : (size_t)(t + 2) * kstep, k3 = k2 + kstep;
            const char* b2 = last ? nB : cB + (size_t)(t + 2) * kstep; const char* b3 = b2 + kstep;
            PG8_LDB(B0, 0, 0); PG8_LDB(B1, 0, 1); PG8_SCHED; PG8_LDA(At, 0, 0); PG8_STAGE_A(PG8_SA(1, 1), aoc[1], k1);
            if (last) { const u32x4 nx = *nxslot; aoc[0][0] = nx.x; aoc[0][1] = nx.y; aoc[1][0] = nx.z; aoc[1][1] = nx.w; }
            PG8_WAIT_V(8); PG8_WAIT_L(0); PG8_BAR; PG8_MMA(0, 0, At, B0); PG8_MMA(0, 1, At, B1); PG8_BAR; PG8_SCHED;
            PG8_LDA(At, 0, 1); PG8_STAGE_B(PG8_SB(0, 0), b2); PG8_STAGE_B(PG8_SB(0, 1), b2 + hstep); PG8_STAGE_A(PG8_SA(0, 0), aoc[0], k2);
            PG8_WAIT_V(8); PG8_WAIT_L(0); PG8_BAR; PG8_MMA(1, 0, At, B0); PG8_MMA(1, 1, At, B1); PG8_BAR; PG8_SCHED;
            PG8_LDB(B0, 1, 0); PG8_LDB(B1, 1, 1); PG8_SCHED; PG8_LDA(At, 1, 0); PG8_STAGE_A(PG8_SA(0, 1), aoc[1], k2);
            PG8_WAIT_V(8); PG8_WAIT_L(0); PG8_BAR; PG8_MMA(0, 0, At, B0); PG8_MMA(0, 1, At, B1); PG8_BAR; PG8_SCHED;
            PG8_LDA(At, 1, 1); PG8_STAGE_B(PG8_SB(1, 0), b3); PG8_STAGE_B(PG8_SB(1, 1), b3 + hstep); PG8_STAGE_A(PG8_SA(1, 0), aoc[0], k3);
            PG8_WAIT_V(8); PG8_WAIT_L(0); PG8_BAR; PG8_MMA(1, 0, At, B0); PG8_MMA(1, 1, At, B1); PG8_BAR; PG8_SCHED;
        }
        if constexpr (ALIGN_EPI) { if (wr == 0) PG8_BAR; }
        E(acc, cur, wr, wc, fr, fq);
        if (!has_next) break;
#pragma unroll
        for (int a = 0; a < 2; ++a)
#pragma unroll
            for (int b = 0; b < 2; ++b)
#pragma unroll
                for (int m = 0; m < 4; ++m)
#pragma unroll
                    for (int n = 0; n < 2; ++n) acc[a][b][m][n] = (f32x4){0.f, 0.f, 0.f, 0.f};
        cur = nxt; cB = nB; ++ui;
        if constexpr (ALIGN_EPI) { if (wr == 1) PG8_BAR; }
    }
    PG8_WAIT_V(0);
    if constexpr (!ALIGN_EPI) { if (wr == 0) PG8_BAR; }
    PG8_BAR;
#undef PG8_SA
#undef PG8_SB
#undef PG8_STAGE_A
#undef PG8_STAGE_B
#undef PG8_LDA
#undef PG8_LDB
#undef PG8_MMA
#undef PG8_WAIT_V
#undef PG8_WAIT_L
#undef PG8_BAR
#undef PG8_SCHED
}

__device__ __forceinline__ int xcd_remap(int L, int nwg) { const int q = nwg / NXCD, r = nwg % NXCD, xcd = L % NXCD, off = L / NXCD; return (xcd < r ? xcd * (q + 1) : r * (q + 1) + (xcd - r) * q) + off; }

struct SchedInProj {
    int G, c;
    __device__ __forceinline__ bool next(int i, Unit& u) const {
        constexpr int NLAT = 128 * 9, NWG = NLAT + 16 * 4;
        const int L = i * G + c; if (L >= NWG) return false;
        const int wgid = xcd_remap(L, NWG); int pm, pn;
        if (wgid < NLAT) { const int nig = WGM * 9, gid = wgid / nig; pm = gid * WGM + (wgid % nig) % WGM; pn = (wgid % nig) / WGM; }
        else { const int w = wgid - NLAT, nig = WGM * 4, gid = w / nig; pm = 128 + gid * WGM + (w % nig) % WGM; pn = (w % nig) / WGM; }
        u.pm = pm; u.pn = pn; u.arow = pm * BM; u.bt = pn * BM; u.nvalid = BM; u.e = 0; return true;
    }
    __device__ __forceinline__ unsigned arow(const Unit& u, int rloc) const { return (unsigned)(u.arow + rloc); }
};
struct SchedPlain {
    int G, c, nM, nN;
    __device__ __forceinline__ bool next(int i, Unit& u) const {
        const int nwg = nM * nN, L = i * G + c; if (L >= nwg) return false;
        const int wgid = xcd_remap(L, nwg), nig = WGM * nN, gid = wgid / nig, fm = gid * WGM, gsz = (nM - fm) < WGM ? (nM - fm) : WGM;
        u.pm = fm + ((wgid % nig) % gsz); u.pn = (wgid % nig) / gsz; u.arow = u.pm * BM; u.bt = u.pn * BM; u.nvalid = BM; u.e = 0; return true;
    }
    __device__ __forceinline__ unsigned arow(const Unit& u, int rloc) const { return (unsigned)(u.arow + rloc); }
};
template <int NT, bool GATHER>
struct SchedMoE {
    int G, c; const LAS int* tst; const LAS int* cnt; const int* list;
    __device__ __forceinline__ bool next(int i, Unit& u) const {
        const int nwg = tst[NE] * NT, L = i * G + c; if (L >= nwg) return false;
        const int wgid = xcd_remap(L, nwg);
        int e = 0;
#pragma unroll
        for (int s = 16; s >= 1; s >>= 1) { if (tst[e + s] * NT <= wgid) e += s; }
        const int t0 = tst[e], mt = tst[e + 1] - t0, w = wgid - t0 * NT, nig = WGM * NT, gid = w / nig, fm = gid * WGM, gsz = (mt - fm) < WGM ? (mt - fm) : WGM;
        const int m = fm + ((w % nig) % gsz), n = (w % nig) / gsz;
        u.pm = t0 + m; u.pn = n; u.e = e; u.bt = (e * NT + n) * BM;
        if (GATHER) { u.arow = e * NTOK + m * BM; const int left = cnt[e] - m * BM; u.nvalid = left < BM ? left : BM; }
        else { u.arow = u.pm * BM; u.nvalid = BM; }
        return true;
    }
    __device__ __forceinline__ unsigned arow(const Unit& u, int rloc) const {
        if (GATHER) { const int tok = (rloc < u.nvalid) ? (list[u.arow + rloc] >> 2) : 0; return (unsigned)tok; }
        return (unsigned)(u.arow + rloc);
    }
};

struct EpiInProj {
    bf16_t *KB, *VB, *QB, *GB, *PB; float* RB;
    __device__ __forceinline__ void operator()(const f32x4 (&acc)[2][2][4][2], const Unit& u, int wr, int wc, int fr, int fq) const {
        const int pn = u.pn, row0 = u.pm * BM + wr * 64 + fr;
        if (pn == 3) {
            if (wc != 0) return;
#pragma unroll
            for (int ai = 0; ai < 2; ++ai)
#pragma unroll
                for (int m = 0; m < 4; ++m) { float* rp = RB + (size_t)(row0 + ai * HALF + m * 16) * 32 + 8 * fq;
                    *(f32x4*)rp = acc[ai][0][m][0]; *(f32x4*)(rp + 4) = acc[ai][0][m][1]; }
            return;
        }
        if (pn >= 7) {
#pragma unroll
            for (int ai = 0; ai < 2; ++ai)
#pragma unroll
                for (int m = 0; m < 4; ++m) { const int row = row0 + ai * HALF + m * 16, b = row >> 11, t = row & 2047;
#pragma unroll
                    for (int bj = 0; bj < 2; ++bj) { const int g = (pn - 7) * 2 + bj, cblk = wc * 4 + fq;
                        const f32x4 v0 = acc[ai][bj][m][0], v1 = acc[ai][bj][m][1]; u32x4 w; w.x = cvt_pk_bf16(v0[0], v0[1]); w.y = cvt_pk_bf16(v0[2], v0[3]); w.z = cvt_pk_bf16(v1[0], v1[1]); w.w = cvt_pk_bf16(v1[2], v1[3]);
                        *(u32x4*)(PB + ((((size_t)(b * 4 + g) * 16 + cblk) * 2048 + t) * 8)) = w; } }
            return;
        }
        bf16_t* base; int ldc, coff;
        if (pn == 0) { base = KB; ldc = 256; coff = 0; } else if (pn <= 2) { base = VB; ldc = 512; coff = (pn - 1) * 256; }
        else if (pn == 4) { base = QB; ldc = 256; coff = 0; } else { base = GB; ldc = 512; coff = (pn - 5) * 256; }
        const int col0 = coff + wc * 32 + 8 * fq;
#pragma unroll
        for (int ai = 0; ai < 2; ++ai)
#pragma unroll
            for (int m = 0; m < 4; ++m) { bf16_t* rowp = base + (size_t)(row0 + ai * HALF + m * 16) * ldc + col0;
#pragma unroll
                for (int bj = 0; bj < 2; ++bj) { const f32x4 v0 = acc[ai][bj][m][0], v1 = acc[ai][bj][m][1];
                    u32x4 w; w.x = cvt_pk_bf16(v0[0], v0[1]); w.y = cvt_pk_bf16(v0[2], v0[3]); w.z = cvt_pk_bf16(v1[0], v1[1]); w.w = cvt_pk_bf16(v1[2], v1[3]);
                    *(u32x4*)(rowp + bj * HALF) = w; } }
    }
};
struct EpiResid {
    const float* x; const float* mod; float* out;
    __device__ __forceinline__ void operator()(const f32x4 (&acc)[2][2][4][2], const Unit& u, int wr, int wc, int fr, int fq) const {
        const int row0 = u.pm * BM + wr * 64 + fr, col0 = u.pn * BM + wc * 32 + 8 * fq;
        const float* g1 = mod + (size_t)(row0 >> 11) * NMOD + 2048 + col0;
        f32x4 gv[2][2];
#pragma unroll
        for (int bj = 0; bj < 2; ++bj)
#pragma unroll
            for (int n = 0; n < 2; ++n) gv[bj][n] = *(const f32x4*)(g1 + bj * HALF + 4 * n);
        f32x4 xa[2][2], xb[2][2];
#define RES_LOAD(dst, g_) do { const size_t _o = (size_t)(row0 + ((g_) >> 2) * HALF + ((g_) & 3) * 16) * D + col0; \
            _Pragma("unroll") for (int bj = 0; bj < 2; ++bj) _Pragma("unroll") for (int n = 0; n < 2; ++n) dst[bj][n] = *(const f32x4*)(x + _o + bj * HALF + 4 * n); } while (0)
#define RES_STORE(src, g_) do { const size_t _o = (size_t)(row0 + ((g_) >> 2) * HALF + ((g_) & 3) * 16) * D + col0; \
            _Pragma("unroll") for (int bj = 0; bj < 2; ++bj) _Pragma("unroll") for (int n = 0; n < 2; ++n) *(f32x4*)(out + _o + bj * HALF + 4 * n) = src[bj][n] + gv[bj][n] * acc[(g_) >> 2][bj][(g_) & 3][n]; } while (0)
        RES_LOAD(xa, 0);
#pragma unroll
        for (int g2 = 0; g2 < 8; g2 += 2) { RES_LOAD(xb, g2 + 1); RES_STORE(xa, g2); if (g2 + 2 < 8) RES_LOAD(xa, g2 + 2); RES_STORE(xb, g2 + 1); }
#undef RES_LOAD
#undef RES_STORE
    }
};
__device__ __forceinline__ unsigned pk4_fp8(float a, float b, float c, float d) { int w = 0; w = __builtin_amdgcn_cvt_pk_fp8_f32(a, b, w, false); w = __builtin_amdgcn_cvt_pk_fp8_f32(c, d, w, true); return (unsigned)w; }
template <bool FP8>
struct EpiSwiglu {
    void* act; const float* bgu; float ascale;
    __device__ __forceinline__ void operator()(const f32x4 (&acc)[2][2][4][2], const Unit& u, int wr, int wc, int fr, int fq) const {
        const int row0 = u.pm * BM + wr * 64 + fr, cc = u.pn * HALF + wc * 32 + 8 * fq;
        const float* bg = bgu + (size_t)u.e * 2048 + cc;
        f32x4 bgv[2], buv[2];
#pragma unroll
        for (int n = 0; n < 2; ++n) { bgv[n] = *(const f32x4*)(bg + 4 * n); buv[n] = *(const f32x4*)(bg + 1024 + 4 * n); }
#pragma unroll
        for (int ai = 0; ai < 2; ++ai)
#pragma unroll
            for (int m = 0; m < 4; ++m) { float r[8];
#pragma unroll
                for (int n = 0; n < 2; ++n) { const f32x4 gq = acc[ai][0][m][n] * ascale + bgv[n], uq = acc[ai][1][m][n] * ascale + buv[n];
#pragma unroll
                    for (int j = 0; j < 4; ++j) { const float gt = fminf(gq[j], 7.f), up = fminf(fmaxf(uq[j], -7.f), 7.f);
                        r[4 * n + j] = (up + 1.f) * gt * __builtin_amdgcn_rcpf(1.f + __expf(-1.702f * gt)); } }
                if constexpr (FP8) { u32x2 w; w.x = pk4_fp8(r[0], r[1], r[2], r[3]); w.y = pk4_fp8(r[4], r[5], r[6], r[7]);
                    *(u32x2*)((unsigned char*)act + (size_t)(row0 + ai * HALF + m * 16) * DFF + cc) = w; }
                else { u32x4 w; w.x = cvt_pk_bf16(r[0], r[1]); w.y = cvt_pk_bf16(r[2], r[3]); w.z = cvt_pk_bf16(r[4], r[5]); w.w = cvt_pk_bf16(r[6], r[7]);
                    *(u32x4*)((bf16_t*)act + (size_t)(row0 + ai * HALF + m * 16) * DFF + cc) = w; } }
    }
};
struct EpiDown {
    unsigned char* y; const float* bd; float ascale;
    __device__ __forceinline__ void operator()(const f32x4 (&acc)[2][2][4][2], const Unit& u, int wr, int wc, int fr, int fq) const {
        const int row0 = u.pm * BM + wr * 64 + fr, col0 = u.pn * BM + wc * 32 + 8 * fq;
        const float* bp = bd + (size_t)u.e * D + col0;
        f32x4 bv[2][2];
#pragma unroll
        for (int bj = 0; bj < 2; ++bj)
#pragma unroll
            for (int n = 0; n < 2; ++n) bv[bj][n] = *(const f32x4*)(bp + bj * HALF + 4 * n);
#pragma unroll
        for (int ai = 0; ai < 2; ++ai)
#pragma unroll
            for (int m = 0; m < 4; ++m) { unsigned char* rowp = y + (size_t)(row0 + ai * HALF + m * 16) * D + col0;
#pragma unroll
                for (int bj = 0; bj < 2; ++bj) { const f32x4 v0 = acc[ai][bj][m][0] * ascale + bv[bj][0], v1 = acc[ai][bj][m][1] * ascale + bv[bj][1];
                    u32x2 w; w.x = pk4_fp8(v0[0], v0[1], v0[2], v0[3]); w.y = pk4_fp8(v1[0], v1[1], v1[2], v1[3]);
                    *(u32x2*)(rowp + bj * HALF) = w; } }
    }
};
}

constexpr size_t MiB = 1u << 20;
constexpr size_t WS_CTL = 0, WS_MOD = 1 * MiB, WS_TOPW = 2 * MiB, WS_ASG = 3 * MiB, WS_WRT = 3 * MiB + 512 * 1024, WS_LIST = 4 * MiB, WS_WIN = 8 * MiB, WS_WOUT = 13 * MiB,
                 WS_WGU = 16 * MiB, WS_WD = 80 * MiB, WS_HN1 = 112 * MiB, WS_HN2 = 112 * MiB,
                 WS_KB = 184 * MiB, WS_VB = 202 * MiB, WS_RB = 238 * MiB, WS_QB = 243 * MiB, WS_GB = 259 * MiB, WS_PB = 291 * MiB,
                 WS_OF = 323 * MiB, WS_OB = 387 * MiB, WS_MIX = 451 * MiB, WS_ACT = 184 * MiB, WS_Y = 515 * MiB, WS_END = 787 * MiB;
static_assert(WS_ACT + (size_t)NPADROWS * DFF <= WS_Y && WS_Y + (size_t)NPADROWS * D * 2 <= WS_END, "ws map");


constexpr int CW_CNT = 0;
constexpr int CW_BAR = 4096;

constexpr int RING_BYTES = 131072;
constexpr int LDSCTL_OFF = 155648;
constexpr int LDS_BYTES = 163840;
constexpr int LC_BAR = 0, LC_TST = 16, LC_CNT = 64;

#define XB_TMO      128
#define XB_XCNT(j)  (256  + 64 * (j))
#define XB_XSUB(j)  (1280 + 64 * (j))
#define XB_XGEN(j)  (2304 + 64 * (j))
#define XB_TOP      3328
#define XB_TOPGEN   3392
#define XCD_BAR_WORDS 3456
#define XB_SPIN_CAP (1u << 18)
__device__ __forceinline__ unsigned xb_ld(unsigned* p)              { return __hip_atomic_load(p, __ATOMIC_RELAXED, __HIP_MEMORY_SCOPE_AGENT); }
__device__ __forceinline__ unsigned xb_add(unsigned* p, unsigned v) { return __hip_atomic_fetch_add(p, v, __ATOMIC_RELAXED, __HIP_MEMORY_SCOPE_AGENT); }
__device__ __forceinline__ unsigned xb_xcc_id() { return (unsigned)__builtin_amdgcn_s_getreg((3 << 11) | 20) & 0xFu; }
#define XB_SPIN(cond, bar) do { unsigned _sp = 0; while (cond) { __builtin_amdgcn_s_sleep(1); \
    if ((++_sp & 255u) == 0u) { if (xb_ld(&(bar)[XB_TMO])) break; if (_sp > XB_SPIN_CAP) { atomicAdd(&(bar)[XB_TMO], 1u); break; } } } } while (0)
struct XcdBarrier { unsigned* bar; unsigned x; volatile LAS unsigned* st; };
__device__ __forceinline__ XcdBarrier xcd_barrier_post(unsigned* bar, volatile LAS unsigned* st) {
    XcdBarrier b; b.bar = bar; b.x = xb_xcc_id(); b.st = st;
    if (threadIdx.x == 0) (void)xb_add(&bar[XB_XCNT(b.x)], 1u);
    return b;
}
__device__ __forceinline__ void xcd_barrier_complete(unsigned* bar, unsigned x, unsigned& nloc, unsigned& nx) {
    const unsigned G = gridDim.x * gridDim.y * gridDim.z;
    unsigned sum, cnt, mine, sp = 0u;
    for (;;) {
        sum = 0u; cnt = 0u; mine = 0u;
#pragma unroll
        for (unsigned j = 0; j < 16; ++j) { const unsigned c = xb_ld(&bar[XB_XCNT(j)]); sum += c; cnt += (c > 0u) ? 1u : 0u; mine = (j == x) ? c : mine; }
        if (sum == G) break;
        __builtin_amdgcn_s_sleep(1);
        if ((++sp & 255u) == 0u) { if (xb_ld(&bar[XB_TMO])) break; if (sp > XB_SPIN_CAP) { atomicAdd(&bar[XB_TMO], 1u); break; } }
    }
    nloc = mine > 0u ? mine : 1u; nx = cnt > 0u ? cnt : 1u;
}
__device__ __forceinline__ void xcd_barrier(const XcdBarrier& b) {
    asm volatile("s_waitcnt vmcnt(0)" ::: "memory");
    __syncthreads();
    if (threadIdx.x == 0) {
        unsigned* bar = b.bar;
        __builtin_amdgcn_s_waitcnt(0);
        unsigned nloc = b.st[0], nx = b.st[1];
        if (nloc == 0u) { xcd_barrier_complete(bar, b.x, nloc, nx); b.st[0] = nloc; b.st[1] = nx; }
        const unsigned old = xb_add(&bar[XB_XSUB(b.x)], 1u);
        const unsigned gen = old / nloc;
        if (old + 1u == (gen + 1u) * nloc) {
            __builtin_amdgcn_fence(__ATOMIC_RELEASE, "agent");
            asm volatile("s_waitcnt vmcnt(0)" ::: "memory");
            const unsigned og = xb_add(&bar[XB_TOP], 1u);
            const unsigned tg = og / nx;
            if (og + 1u == (tg + 1u) * nx) xb_add(&bar[XB_TOPGEN], 1u);
            else XB_SPIN(xb_ld(&bar[XB_TOPGEN]) == tg, bar);
            __builtin_amdgcn_fence(__ATOMIC_ACQUIRE, "agent");
            xb_add(&bar[XB_XGEN(b.x)], 1u);
            asm volatile("s_waitcnt vmcnt(0)" ::: "memory");
        } else {
            XB_SPIN(xb_ld(&bar[XB_XGEN(b.x)]) == gen, bar);
            __builtin_amdgcn_fence(__ATOMIC_ACQUIRE, "agent");
            asm volatile("s_waitcnt vmcnt(0)" ::: "memory");
        }
    }
    __syncthreads();
}

struct Args { const float* in[24]; float* out; unsigned char* ws; int ph_lo, ph_hi; };
struct Frame {
    LAS unsigned char* lds;
    int tid, lane, wave, vcu, G;
    const float* const* in; float* out; unsigned char* ws;
};
#define IN_X 0
#define IN_C 1
#define IN_CTX 2
#define IN_CCTX 3
#define IN_WADA 4
#define IN_BADA 5
#define IN_NMIX 6
#define IN_NMLP 7
#define IN_WIN 8
#define IN_WGKF 9
#define IN_BGKF 10
#define IN_WGKB 11
#define IN_BGKB 12
#define IN_GLANW 13
#define IN_WPOOL 14
#define IN_PSCALE 15
#define IN_WOUT 16
#define IN_WROUTER 17
#define IN_BROUTER 18
#define IN_WGU 19
#define IN_BGU 20
#define IN_WDOWN 21
#define IN_BDOWN 22
#define IN_FNW 23

__device__ __forceinline__ void p0_transpose_item(const float* W, int ldw, int k0, int n0, bf16_t* WT, int ldd, int drow, int dk0, LAS float* scr, int lane) {
#pragma unroll 8
    for (int i = 0; i < 32; ++i) { const int kk = 2 * i + (lane >> 5); scr[kk * 33 + (lane & 31)] = W[(size_t)(k0 + kk) * ldw + n0 + (lane & 31)]; }
    LDS_WAIT(); asm volatile("" ::: "memory");
    const int c = lane & 7;
#pragma unroll
    for (int j = 0; j < 4; ++j) { const int n = (lane >> 3) + 8 * j; const LAS float* s = scr + (8 * c) * 33 + n;
        u32x4 o; o.x = pk2(s[0 * 33], s[1 * 33]); o.y = pk2(s[2 * 33], s[3 * 33]); o.z = pk2(s[4 * 33], s[5 * 33]); o.w = pk2(s[6 * 33], s[7 * 33]);
        *(u32x4*)(WT + (size_t)(drow + n) * ldd + dk0 + k0 + 8 * c) = o; }
    LDS_WAIT(); asm volatile("" ::: "memory");
}
__device__ __forceinline__ int win_drow(int n0) {
    if (n0 < 256) return 4 * 256 + n0;
    if (n0 < 512) return n0 - 256;
    if (n0 < 1024) return 256 + (n0 - 512);
    if (n0 < 1536) return 5 * 256 + (n0 - 1024);
    if (n0 < 1568) return 3 * 256 + (n0 - 1536);
    return 7 * 256 + (n0 - 1568);
}
__device__ __forceinline__ void p0_mod_item(Frame& F, int item, const LAS float* SL, float* mod) {
    const float* w_ada = F.in[IN_WADA]; const float* b_ada = F.in[IN_BADA];
    const int j = item * 8 + (F.lane & 7), kp = F.lane >> 3;
    float acc[17];
#pragma unroll
    for (int r = 0; r < 17; ++r) acc[r] = 0.f;
#pragma unroll 4
    for (int i = 0; i < 128; ++i) { const int k = kp + 8 * i; const float w = w_ada[(size_t)k * NMOD + j];
#pragma unroll
        for (int r = 0; r < 17; ++r) acc[r] += SL[r * 1024 + k] * w; }
#pragma unroll
    for (int r = 0; r < 17; ++r) { float a = acc[r]; a += __shfl_xor(a, 8); a += __shfl_xor(a, 16); a += __shfl_xor(a, 32); if (kp == 0) mod[r * NMOD + j] = a + b_ada[j]; }
}
__device__ __forceinline__ void p0_weff_item(Frame& F, int item, LAS float* scr, bf16_t* Wout_t) {
    const float* w_pool = F.in[IN_WPOOL]; const float* pscale = F.in[IN_PSCALE]; const float* w_out = F.in[IN_WOUT];
    const int g = item >> 6, n0 = (item & 63) * 16, lane = F.lane;
#pragma unroll 4
    for (int q = 0; q < 32; ++q) { const int idx = lane + 64 * q, j = idx >> 4, nn = idx & 15; scr[idx] = w_out[(size_t)(512 + g * 128 + j) * D + n0 + nn] * pscale[g * 128 + j]; }
    LDS_WAIT(); asm volatile("" ::: "memory");
    float a0[16], a1[16];
#pragma unroll
    for (int nn = 0; nn < 16; ++nn) { a0[nn] = 0.f; a1[nn] = 0.f; }
    const float* wp0 = w_pool + (size_t)(g * 128 + lane) * 128; const float* wp1 = wp0 + 64 * 128;
    for (int j = 0; j < 128; ++j) { const float p0 = wp0[j], p1 = wp1[j];
#pragma unroll
        for (int q = 0; q < 4; ++q) { const f32x4 t = *(const LAS f32x4*)(scr + j * 16 + 4 * q);
#pragma unroll
            for (int z = 0; z < 4; ++z) { a0[4 * q + z] += p0 * t[z]; a1[4 * q + z] += p1 * t[z]; } } }
#pragma unroll
    for (int nn = 0; nn < 16; ++nn) { bf16_t* o = Wout_t + (size_t)(n0 + nn) * D + 512 + g * 128 + lane; o[0] = (bf16_t)f2bf(a0[nn]); o[64] = (bf16_t)f2bf(a1[nn]); }
    LDS_WAIT(); asm volatile("" ::: "memory");
}
constexpr int P0_CVT_E = 0;
constexpr float WSCALE = 32.f;
constexpr int CVP = 260;
__device__ __forceinline__ unsigned pk4_fp8s(float a, float b, float c, float d) { int w = 0; w = __builtin_amdgcn_cvt_pk_fp8_f32(a * WSCALE, b * WSCALE, w, false); w = __builtin_amdgcn_cvt_pk_fp8_f32(c * WSCALE, d * WSCALE, w, true); return (unsigned)w; }
struct CvtItem { const float* src; int ldw, k0, n0, e; bool gu; };
__device__ __forceinline__ CvtItem cvt_decode(Frame& F, int item) {
    CvtItem c;
    if (item < 2048) { c.gu = true; c.e = item >> 6; c.k0 = ((item >> 3) & 7) * 128; c.n0 = (item & 7) * 256; c.src = F.in[IN_WGU] + (size_t)c.e * D * 2048; c.ldw = 2048; }
    else { const int r = item - 2048 + P0_CVT_E * 32; c.gu = false; c.e = r >> 5; c.k0 = ((r >> 2) & 7) * 128; c.n0 = (r & 3) * 256; c.src = F.in[IN_WDOWN] + (size_t)c.e * DFF * D; c.ldw = D; }
    return c;
}
template <int MODE>
__device__ __forceinline__ void cvt_expert_items(Frame& F, int first, int stride, int nitems) {
    if (first >= nitems) return;
    LAS float* T = (LAS float*)F.lds;
    int tid = F.tid; asm volatile("" : "+v"(tid));
    f32x4 R[16];
    { const CvtItem c = cvt_decode(F, first);
#pragma unroll
      for (int i = 0; i < 16; ++i) { const int idx = tid + NTHR * i, kk = idx >> 6, n4 = idx & 63; R[i] = __builtin_nontemporal_load((const f32x4*)(c.src + (size_t)(c.k0 + kk) * c.ldw + c.n0 + 4 * n4)); } }
    for (int item = first; item < nitems; item += stride) {
        const CvtItem c = cvt_decode(F, item);
#pragma unroll
        for (int i = 0; i < 16; ++i) { const int idx = tid + NTHR * i, kk = idx >> 6, n4 = idx & 63; *(LAS f32x4*)(T + kk * CVP + 4 * n4) = R[i]; }
        __syncthreads();
        if (MODE != 1 && item + stride < nitems) { const CvtItem cn = cvt_decode(F, item + stride);
#pragma unroll
            for (int i = 0; i < 16; ++i) { const int idx = tid + NTHR * i, kk = idx >> 6, n4 = idx & 63; R[i] = __builtin_nontemporal_load((const f32x4*)(cn.src + (size_t)(cn.k0 + kk) * cn.ldw + cn.n0 + 4 * n4)); } }
        u32x4 o[4];
        { const int n = F.wave * 32 + (F.lane & 31), half = F.lane >> 5;
          const LAS float* col = T + (64 * half) * CVP + n;
#pragma unroll
          for (int q = 0; q < 4; ++q) { unsigned w4[4];
#pragma unroll
              for (int z = 0; z < 4; ++z) { const LAS float* p = col + (16 * q + 4 * z) * CVP; w4[z] = pk4_fp8s(p[0], p[CVP], p[2 * CVP], p[3 * CVP]); }
              o[q] = (u32x4){w4[0], w4[1], w4[2], w4[3]}; }
          __syncthreads();
          LAS unsigned char* OUTL = (LAS unsigned char*)F.lds;
#pragma unroll
          for (int q = 0; q < 4; ++q) *(LAS u32x4*)(OUTL + n * 144 + half * 64 + q * 16) = o[q]; }
        __syncthreads();
#pragma unroll
        for (int i = 0; i < 4; ++i) { const int idx = tid + NTHR * i, n = idx >> 3, ch = idx & 7;
            const u32x4 v = *(const LAS u32x4*)((const LAS unsigned char*)F.lds + n * 144 + ch * 16);
            size_t drow;
            if (c.gu) { const int jn = (c.n0 + n) & 1023; drow = (size_t)c.e * 2048 + (jn >> 7) * 256 + ((c.n0 + n) >= 1024 ? 128 : 0) + (jn & 127); }
            else drow = (size_t)c.e * D + c.n0 + n;
            if (MODE != 2 || v.x == 0x12345678u) *(u32x4*)((unsigned char*)(F.ws + (c.gu ? WS_WGU : WS_WD)) + drow * 1024 + c.k0 + ch * 16) = v; }
        __syncthreads();
    }
}


__device__ __forceinline__ void p0_prologue(Frame& F, bool do_experts) {
    { bf16_t* WRT = (bf16_t*)(F.ws + WS_WRT); const float* wr = F.in[IN_WROUTER];
      for (int idx = F.vcu * NTHR + F.tid; idx < D * NE; idx += F.G * NTHR) { const int k = idx >> 5, e = idx & 31; const float v = wr[idx]; const unsigned hi = f2bf(v);
          WRT[e * D + k] = (bf16_t)hi; WRT[NE * D + e * D + k] = (bf16_t)f2bf(v - bf2f(hi)); } }
    LAS float* SL = (LAS float*)F.lds;
    for (int idx = F.tid; idx < 17 * 1024; idx += NTHR) { const int r = idx >> 10, k = idx & 1023; const float v = r < NB ? F.in[IN_C][r * D + k] : F.in[IN_CCTX][k]; SL[idx] = silu_f(v); }
    __syncthreads();
    LAS float* scr = (LAS float*)(F.lds + 69632 + F.wave * 8448);
    bf16_t* Win_t = (bf16_t*)(F.ws + WS_WIN); bf16_t* Wout_t = (bf16_t*)(F.ws + WS_WOUT); bf16_t* Wgu_t = (bf16_t*)(F.ws + WS_WGU); bf16_t* Wd_t = (bf16_t*)(F.ws + WS_WD);
    float* mod = (float*)(F.ws + WS_MOD);
    constexpr int I_MOD = NMOD / 8, I_WEFF = 4 * 64, I_WIN = 16 * (DIN / 32), I_ZERO = 224, I_WOUT = 8 * 32, I_GU = NE * 16 * 64, I_DN = NE * 16 * 32;
    const int nitems = I_MOD + I_WEFF + I_WIN + I_ZERO + I_WOUT + (do_experts ? I_GU + I_DN : 0);
    const int gw = F.wave * F.G + F.vcu, NGW = F.G * NWAVES;
    for (int it = gw; it < nitems; it += NGW) {
        int r = it;
        if (r < I_MOD) { p0_mod_item(F, r, SL, mod); continue; } r -= I_MOD;
        if (r < I_WEFF) { p0_weff_item(F, r, scr, Wout_t); continue; } r -= I_WEFF;
        if (r < I_WIN) { const int kb = r / (DIN / 32), nb = r % (DIN / 32); p0_transpose_item(F.in[IN_WIN], DIN, 64 * kb, 32 * nb, Win_t, D, win_drow(32 * nb), 0, scr, F.lane); continue; } r -= I_WIN;
        if (r < I_ZERO) { u32x4* o = (u32x4*)(Win_t + (size_t)(3 * 256 + 32 + r) * D) + F.lane * 2; o[0] = (u32x4){0u, 0u, 0u, 0u}; o[1] = (u32x4){0u, 0u, 0u, 0u}; continue; } r -= I_ZERO;
        if (r < I_WOUT) { const int kb = r / 32, nb = r % 32; p0_transpose_item(F.in[IN_WOUT], D, 64 * kb, 32 * nb, Wout_t, D, 32 * nb, 0, scr, F.lane); continue; } r -= I_WOUT;
        if (r < I_GU) { const int e = r / (16 * 64), q = r % (16 * 64), kb = q / 64, nb = q % 64, n0 = 32 * nb, jn = n0 & 1023;
            const int drow = e * 2048 + (jn >> 7) * 256 + (n0 >= 1024 ? 128 : 0) + (jn & 127);
            p0_transpose_item(F.in[IN_WGU] + (size_t)e * D * 2048, 2048, 64 * kb, n0, Wgu_t, D, drow, 0, scr, F.lane); continue; } r -= I_GU;
        { const int e = r / (16 * 32), q = r % (16 * 32), kb = q / 32, nb = q % 32;
            p0_transpose_item(F.in[IN_WDOWN] + (size_t)e * DFF * D, D, 64 * kb, 32 * nb, Wd_t, DFF, e * D + 32 * nb, 0, scr, F.lane); }
    }}

__device__ __forceinline__ void norm_row_bf16(const float* src, const float* wn, const float* sh, const float* sc, bf16_t* dst, int lane) {
    const f32x4* xr = (const f32x4*)src + lane;
    f32x4 v[4]; float s = 0.f;
#pragma unroll
    for (int j = 0; j < 4; ++j) { v[j] = xr[64 * j]; s += (v[j].x * v[j].x + v[j].y * v[j].y) + (v[j].z * v[j].z + v[j].w * v[j].w); }
    const float rstd = rsqrtf(wave_sum(s) * (1.f / D) + EPS);
    u32x2* o8 = (u32x2*)dst + lane;
#pragma unroll
    for (int j = 0; j < 4; ++j) { const f32x4 w = ((const f32x4*)wn)[lane + 64 * j], a = ((const f32x4*)sc)[lane + 64 * j], b = ((const f32x4*)sh)[lane + 64 * j];
        const f32x4 y = v[j] * rstd * w * (a + 1.f) + b; u32x2 p; p.x = pk2(y.x, y.y); p.y = pk2(y.z, y.w); o8[64 * j] = p; }
}
__device__ __forceinline__ void p1_norm1(Frame& F) {
    const float* mod = (const float*)(F.ws + WS_MOD); bf16_t* HN = (bf16_t*)(F.ws + WS_HN1);
    constexpr int RPB = NROW / 256;
    for (int blk = F.vcu; blk < 256; blk += F.G)
        for (int r = F.wave; r < RPB; r += NWAVES) { const int row = blk * RPB + r;
            const float* src = row < NTOK ? F.in[IN_X] + (size_t)row * D : F.in[IN_CTX] + (size_t)(row - NTOK) * D;
            const float* mr = mod + (size_t)(row < NTOK ? row / SEQ : NB) * NMOD;
            norm_row_bf16(src, F.in[IN_NMIX], mr, mr + 1024, HN + (size_t)row * D, F.lane); }
}

typedef __bf16 bf16x2n __attribute__((ext_vector_type(2)));
__device__ __forceinline__ unsigned pkbf(float lo, float hi) { f32x2 v = {lo, hi}; return __builtin_bit_cast(unsigned, __builtin_convertvector(v, bf16x2n)); }
#define MFMA32(a, b, c) __builtin_amdgcn_mfma_f32_32x32x16_bf16((a), (b), (c), 0, 0, 0)
constexpr int GP = 72;
constexpr int GL_QP = 0, GL_KP = 9216, GL_QQ = 18432, GL_KKT = 27648, GL_VT = 36864, GL_DEC = 55296, GL_GSUM = 55552, GL_R = 57600, GL_END = 61696;

__device__ __forceinline__ bf16x8 pack8(const f32x16& x, int s) {
    u32x4 p; p.x = pkbf(x[8 * s + 0], x[8 * s + 1]); p.y = pkbf(x[8 * s + 2], x[8 * s + 3]); p.z = pkbf(x[8 * s + 4], x[8 * s + 5]); p.w = pkbf(x[8 * s + 6], x[8 * s + 7]);
    return __builtin_bit_cast(bf16x8, p);
}
__device__ __forceinline__ bf16x8 ld_perm8(const LAS bf16_t* p) {
    const u32x2 a = *(const LAS u32x2*)p, b = *(const LAS u32x2*)(p + 8); u32x4 r; r.x = a.x; r.y = a.y; r.z = b.x; r.w = b.y; return __builtin_bit_cast(bf16x8, r);
}
__device__ __forceinline__ bf16x8 ld_nat8(const LAS bf16_t* p) { return *(const LAS bf16x8*)p; }

template <int GM>
__device__ __forceinline__ void gla_unit(Frame& F, const int unit) {
    const int b = unit >> 3, h = (unit >> 1) & 3, dir = unit & 1;
    const int w = F.wave, lane = F.lane, tid = F.tid;
    LAS unsigned char* L = F.lds;
    LAS bf16_t* QP = (LAS bf16_t*)(L + GL_QP); LAS bf16_t* KP = (LAS bf16_t*)(L + GL_KP); LAS bf16_t* QQ = (LAS bf16_t*)(L + GL_QQ);
    LAS bf16_t* KKT = (LAS bf16_t*)(L + GL_KKT); LAS bf16_t* VT = (LAS bf16_t*)(L + GL_VT);
    LAS float* DEC = (LAS float*)(L + GL_DEC); LAS float* GSUM = (LAS float*)(L + GL_GSUM); LAS float* RL = (LAS float*)(L + GL_R);
    const bf16_t* QB = (const bf16_t*)(F.ws + WS_QB); const bf16_t* KB = (const bf16_t*)(F.ws + WS_KB); const bf16_t* VB = (const bf16_t*)(F.ws + WS_VB);
    const float* RB = (const float*)(F.ws + WS_RB);
    bf16_t* OD = (bf16_t*)(F.ws + (GM >= 3 ? (dir ? 870 * MiB : 830 * MiB) : (dir ? WS_OB : WS_OF)));
    const float* wgk = F.in[dir ? IN_WGKB : IN_WGKF]; const float* bgk = F.in[dir ? IN_BGKB : IN_BGKF];
    float wg[16];
#pragma unroll
    for (int j = 0; j < 16; ++j) wg[j] = wgk[j * 256 + h * 64 + lane];
    const float bg = bgk[h * 64 + lane];
    f32x16 S0, S1;
#pragma unroll
    for (int i = 0; i < 16; ++i) { S0[i] = 0.f; S1[i] = 0.f; }
    const int tb = w >> 2, vb = w & 3, c = lane & 31, hh = lane >> 5;
    const int vs = tid >> 3, vc = tid & 7;
    unsigned pq[8], pk[8]; u32x4 pv0, pv1; f32x2 pr;
#define GLA_LOAD(step) do { const int _s = (step); const bool _ctx = _s < 4; const int _ci = _ctx ? _s : _s - 4; const int _ch = dir ? ((_ctx ? 3 : 31) - _ci) : _ci; \
        const int _row0 = _ctx ? NTOK + b * CTX + _ch * 64 : b * SEQ + _ch * 64; \
        _Pragma("unroll") for (int _i = 0; _i < 8; ++_i) { const int _t = 8 * w + _i; const size_t _row = (size_t)(_row0 + (dir ? 63 - _t : _t)); \
            pk[_i] = KB[_row * 256 + h * 64 + lane]; pq[_i] = _ctx ? 0u : (unsigned)QB[_row * 256 + h * 64 + lane]; } \
        { const size_t _row = (size_t)(_row0 + (dir ? 63 - vs : vs)); const u32x4* _vp = (const u32x4*)(VB + _row * 512 + h * 128 + vc * 16); pv0 = _vp[0]; pv1 = _vp[1]; \
          pr = *(const f32x2*)(RB + _row * 32 + dir * 16 + vc * 2); } } while (0)
    GLA_LOAD(0);
    for (int step = 0; step < 36; ++step) {
        const bool isctx = step < 4; const int ci = isctx ? step : step - 4; const int chunk = dir ? ((isctx ? 3 : 31) - ci) : ci;
        const int row0 = isctx ? NTOK + b * CTX + chunk * 64 : b * SEQ + chunk * 64;
        unsigned cq[8], ck[8]; u32x4 cv0 = pv0, cv1 = pv1;
#pragma unroll
        for (int i = 0; i < 8; ++i) { cq[i] = pq[i]; ck[i] = pk[i]; }
        *(LAS f32x2*)(RL + vs * 16 + vc * 2) = pr;
        __syncthreads();
        float cs[8];
        { float run = 0.f;
#pragma unroll
          for (int i = 0; i < 8; ++i) { const LAS f32x4* rp = (const LAS f32x4*)(RL + (8 * w + i) * 16); float x = bg;
#pragma unroll
              for (int q4 = 0; q4 < ((GM == 3) ? 1 : 4); ++q4) { const f32x4 rv = rp[q4]; x += rv[0] * wg[4 * q4 + 0] + rv[1] * wg[4 * q4 + 1] + rv[2] * wg[4 * q4 + 2] + rv[3] * wg[4 * q4 + 3]; }
              const float gk = (GM == 3) ? x * 1e-3f : (fminf(x, 0.f) - __logf(1.f + __expf(-fabsf(x)))) * (1.f / 16.f); run += gk; cs[i] = run; }
          GSUM[w * 64 + lane] = run; }
        __syncthreads();
        { float pre = 0.f, mid = 0.f, tot = 0.f;
#pragma unroll
          for (int g = 0; g < 8; ++g) { const float gsum = GSUM[g * 64 + lane]; if (g < w) pre += gsum; if (g < 4) mid += gsum; tot += gsum; }
          if (w == 0) DEC[lane] = __expf(tot);
          const float em = __expf(mid), etm = __expf(tot - mid);
          u32x4 kk4;
          float kkf[8];
#pragma unroll
          for (int i = 0; i < ((GM == 4) ? 1 : 8); ++i) { const int t = 8 * w + i; const float bc = pre + cs[i]; const float kv = bf2f(ck[i]);
              const float e2 = __expf(mid - bc); kkf[i] = kv * (e2 * etm);
              if (!isctx) { const float qv = bf2f(cq[i]) * 0.125f; const float e1 = __expf(bc - mid), e3 = e1 * em;
                  const unsigned w1 = pkbf(qv * e1, kv * e2), w2 = pkbf(qv * e3, 0.f);
                  QP[t * GP + lane] = (bf16_t)(w1 & 0xffffu); KP[t * GP + lane] = (bf16_t)(w1 >> 16); QQ[t * GP + lane] = (bf16_t)(w2 & 0xffffu); } }
          kk4.x = pkbf(kkf[0], kkf[1]); kk4.y = pkbf(kkf[2], kkf[3]); kk4.z = pkbf(kkf[4], kkf[5]); kk4.w = pkbf(kkf[6], kkf[7]);
          *(LAS u32x4*)(KKT + lane * GP + 8 * w) = kk4;
          const unsigned vw[8] = {cv0.x, cv0.y, cv0.z, cv0.w, cv1.x, cv1.y, cv1.z, cv1.w};
#pragma unroll
          for (int e = 0; e < ((GM == 4) ? 1 : 8); ++e) { VT[(vc * 16 + 2 * e) * GP + vs] = (bf16_t)(vw[e] & 0xffffu); VT[(vc * 16 + 2 * e + 1) * GP + vs] = (bf16_t)(vw[e] >> 16); } }
        if (step + 1 < 36) GLA_LOAD(step + 1);
        __syncthreads();
        if (!isctx && GM != 1) {
            f32x16 O;
#pragma unroll
            for (int i = 0; i < 16; ++i) O[i] = 0.f;
#pragma unroll
            for (int s = 0; s < 2; ++s) { O = MFMA32(ld_perm8(QQ + (32 * tb + c) * GP + 16 * s + 4 * hh), pack8(S0, s), O);
                                          O = MFMA32(ld_perm8(QQ + (32 * tb + c) * GP + 32 + 16 * s + 4 * hh), pack8(S1, s), O); }
#pragma unroll
            for (int sb = 0; sb < 2; ++sb) { if (sb > tb) continue;
                f32x16 X;
#pragma unroll
                for (int i = 0; i < 16; ++i) X[i] = 0.f;
#pragma unroll
                for (int s = 0; s < 4; ++s) X = MFMA32(ld_nat8(KP + (32 * sb + c) * GP + 16 * s + 8 * hh), ld_nat8(QP + (32 * tb + c) * GP + 16 * s + 8 * hh), X);
                if (sb == tb) {
#pragma unroll
                    for (int r = 0; r < 16; ++r) { const int sl = (r & 3) + 8 * (r >> 2) + 4 * hh; X[r] = (sl <= c) ? X[r] : 0.f; } }
#pragma unroll
                for (int s = 0; s < 2; ++s) O = MFMA32(pack8(X, s), ld_perm8(VT + (32 * vb + c) * GP + 32 * sb + 16 * s + 4 * hh), O);
            }
#pragma unroll
            for (int r = 0; r < ((GM == 2) ? 1 : 16); ++r) { const int t = 32 * tb + (r & 3) + 8 * (r >> 2) + 4 * hh; const size_t row = (size_t)(row0 + (dir ? 63 - t : t));
                OD[row * 512 + h * 128 + 32 * vb + c] = (bf16_t)(pkbf(O[r], 0.f) & 0xffffu); }
        }
        if (GM != 1) {
#pragma unroll
            for (int g4 = 0; g4 < 4; ++g4) { const f32x4 d0 = *(const LAS f32x4*)(DEC + 8 * g4 + 4 * hh), d1 = *(const LAS f32x4*)(DEC + 32 + 8 * g4 + 4 * hh);
#pragma unroll
                for (int z = 0; z < 4; ++z) { S0[4 * g4 + z] *= d0[z]; S1[4 * g4 + z] *= d1[z]; } }
#pragma unroll
            for (int s = 0; s < 4; ++s) { const bf16x8 vf = ld_nat8(VT + (32 * vb + c) * GP + 16 * s + 8 * hh);
                S0 = MFMA32(ld_nat8(KKT + c * GP + 16 * s + 8 * hh), vf, S0);
                S1 = MFMA32(ld_nat8(KKT + (32 + c) * GP + 16 * s + 8 * hh), vf, S1); }
        }
    }
#undef GLA_LOAD
    __syncthreads();
}

constexpr int PRS = 72 * 2;
__device__ __forceinline__ int pslot(int x) { return 2 * (x + (x >> 3)); }
template <int G_>
__device__ __forceinline__ void pool_unit_g(Frame& F, const int cblk, const int b) {
    constexpr int g = G_, wdw = 2 << g, lo = wdw >> 1, hi = wdw - 1 - lo;
    LAS f32x4* X = (LAS f32x4*)F.lds;
    LAS f32x4* H = (LAS f32x4*)(F.lds + 73728);
    const bf16_t* PB = (const bf16_t*)(F.ws + WS_PB) + ((size_t)((b * 4 + g) * 16 + cblk) * 2048) * 8;
    bf16_t* MIX = (bf16_t*)(F.ws + WS_MIX);
    int tid = F.tid; asm volatile("" : "+v"(tid));
#pragma unroll
    for (int i = 0; i < 4; ++i) { const int tok = tid + 512 * i, r = tok >> 6, x = tok & 63; const u32x4 v = *(const u32x4*)(PB + (size_t)tok * 8);
        LAS f32x4* p = X + r * PRS + pslot(x);
        p[0] = (f32x4){bflo(v.x), bfhi(v.x), bflo(v.y), bfhi(v.y)}; p[1] = (f32x4){bflo(v.z), bfhi(v.z), bflo(v.w), bfhi(v.w)}; }
    __syncthreads();
    { const int q = tid & 1, cs = (tid >> 1) & 7, r = tid >> 4; const LAS f32x4* xr = X + r * PRS + q; LAS f32x4* hr = H + r * PRS + q;
      const int c0 = 8 * cs; f32x4 s = {0.f, 0.f, 0.f, 0.f};
#pragma unroll
      for (int d = -lo; d <= hi; ++d) { const int x = c0 + d; const bool ok = (x >= 0) && (x < GW); const int xc = x < 0 ? 0 : (x > GW - 1 ? GW - 1 : x); const f32x4 v = xr[pslot(xc)]; s += ok ? v : (f32x4){0.f, 0.f, 0.f, 0.f}; if (((d + lo) & 3) == 3) asm volatile("" ::: "memory"); }
      hr[pslot(c0)] = s;
#pragma unroll
      for (int j = 1; j < 8; ++j) { const int xin = c0 + j + hi, xout = c0 + j - 1 - lo; const bool oki = xin < GW, oko = xout >= 0;
          const f32x4 vi = xr[pslot(oki ? xin : GW - 1)], vo = xr[pslot(oko ? xout : 0)];
          s += oki ? vi : (f32x4){0.f, 0.f, 0.f, 0.f}; s -= oko ? vo : (f32x4){0.f, 0.f, 0.f, 0.f}; hr[pslot(c0 + j)] = s; } }
    __syncthreads();
    { const int q = tid & 1, cc = (tid >> 1) & 63, rs = tid >> 7; const int col = pslot(cc) + q; const int r0s = 8 * rs;
      const int c0 = max(cc - lo, 0), c1 = min(cc + hi + 1, GW); const float ncol = (float)(c1 - c0);
      f32x4 s = {0.f, 0.f, 0.f, 0.f};
#pragma unroll
      for (int d = -lo; d <= hi; ++d) { const int y = r0s + d; const bool ok = (y >= 0) && (y < GROWS); const int yc = y < 0 ? 0 : (y > GROWS - 1 ? GROWS - 1 : y); const f32x4 v = H[yc * PRS + col]; s += ok ? v : (f32x4){0.f, 0.f, 0.f, 0.f}; if (((d + lo) & 3) == 3) asm volatile("" ::: "memory"); }
#pragma unroll
      for (int j = 0; j < 8; ++j) { const int r = r0s + j;
          if (j > 0) { const int yin = r + hi, yout = r - 1 - lo; const bool oki = yin < GROWS, oko = yout >= 0;
              const f32x4 vi = H[(oki ? yin : GROWS - 1) * PRS + col], vo = H[(oko ? yout : 0) * PRS + col];
              s += oki ? vi : (f32x4){0.f, 0.f, 0.f, 0.f}; s -= oko ? vo : (f32x4){0.f, 0.f, 0.f, 0.f}; }
          const int ra = max(r - lo, 0), rb = min(r + hi + 1, GROWS);
          const float inv = 1.f / ((float)(rb - ra) * ncol);
          const f32x4 o = s * inv - X[r * PRS + col];
          u32x2 pw; pw.x = pkbf(o[0], o[1]); pw.y = pkbf(o[2], o[3]);
          *(u32x2*)(MIX + (size_t)(b * SEQ + r * GW + cc) * D + 512 + g * 128 + cblk * 8 + q * 4) = pw; } }
    __syncthreads();
}
__device__ __forceinline__ void pool_unit(Frame& F, const int unit) {
    const int g = unit & 3, cblk = (unit >> 2) & 15, b = unit >> 6;
    if (g == 0) pool_unit_g<0>(F, cblk, b); else if (g == 1) pool_unit_g<1>(F, cblk, b); else if (g == 2) pool_unit_g<2>(F, cblk, b); else pool_unit_g<3>(F, cblk, b);
}

__device__ __forceinline__ void p4_gla_out(Frame& F) {
    const bf16_t* OFp = (const bf16_t*)(F.ws + WS_OF); const bf16_t* OBp = (const bf16_t*)(F.ws + WS_OB); const bf16_t* GB = (const bf16_t*)(F.ws + WS_GB);
    bf16_t* MIX = (bf16_t*)(F.ws + WS_MIX); const float* wn = F.in[IN_GLANW];
    const int lane = F.lane, gw = F.vcu * NWAVES + F.wave, NGW = F.G * NWAVES;
    const f32x4 w0 = *(const f32x4*)(wn + (lane & 15) * 8), w1 = *(const f32x4*)(wn + (lane & 15) * 8 + 4);
    for (int tok = gw; tok < NTOK; tok += NGW) {
        const u32x4 fa = *((const u32x4*)(OFp + (size_t)tok * 512) + lane), fb = *((const u32x4*)(OBp + (size_t)tok * 512) + lane);
        const f32x4 o0 = (f32x4){bflo(fa.x) + bflo(fb.x), bfhi(fa.x) + bfhi(fb.x), bflo(fa.y) + bflo(fb.y), bfhi(fa.y) + bfhi(fb.y)};
        const f32x4 o1 = (f32x4){bflo(fa.z) + bflo(fb.z), bfhi(fa.z) + bfhi(fb.z), bflo(fa.w) + bflo(fb.w), bfhi(fa.w) + bfhi(fb.w)};
        const u32x4 gv = *((const u32x4*)(GB + (size_t)tok * 512) + lane);
        float ss = (o0[0] * o0[0] + o0[1] * o0[1]) + (o0[2] * o0[2] + o0[3] * o0[3]) + (o1[0] * o1[0] + o1[1] * o1[1]) + (o1[2] * o1[2] + o1[3] * o1[3]);
        ss += __shfl_xor(ss, 1); ss += __shfl_xor(ss, 2); ss += __shfl_xor(ss, 4); ss += __shfl_xor(ss, 8);
        const float rstd = rsqrtf(ss * (1.f / 128.f) + EPS);
        const float gg[8] = {bflo(gv.x), bfhi(gv.x), bflo(gv.y), bfhi(gv.y), bflo(gv.z), bfhi(gv.z), bflo(gv.w), bfhi(gv.w)};
        float y[8];
#pragma unroll
        for (int j = 0; j < 4; ++j) { y[j] = o0[j] * rstd * w0[j] * silu_f(gg[j]); y[4 + j] = o1[j] * rstd * w1[j] * silu_f(gg[4 + j]); }
        u32x4 pw; pw.x = pkbf(y[0], y[1]); pw.y = pkbf(y[2], y[3]); pw.z = pkbf(y[4], y[5]); pw.w = pkbf(y[6], y[7]);
        *((u32x4*)(MIX + (size_t)tok * D) + lane) = pw;
    }
}

constexpr int P6_AP = 1032;
constexpr int L6_AH = 0, L6_AL = 32 * P6_AP * 2, L6_LG = 2 * L6_AL;
constexpr int L6_REC = L6_LG + 128 * 33 * 4;
constexpr int L6_RED = 0;
static_assert(L6_REC + 4096 <= LDSCTL_OFF && 8 * 32 * 33 * 4 <= L6_LG, "P6 LDS map");
__device__ __forceinline__ void p6_router(Frame& F) {
    LAS bf16_t* AH = (LAS bf16_t*)(F.lds + L6_AH); LAS bf16_t* AL = (LAS bf16_t*)(F.lds + L6_AL); LAS float* LG = (LAS float*)(F.lds + L6_LG); LAS float* RED = (LAS float*)(F.lds + L6_RED);
    LAS unsigned* REC = (LAS unsigned*)(F.lds + L6_REC); LAS float* RECW = (LAS float*)(F.lds + L6_REC + 2048);
    LAS int* LCNT = (LAS int*)(F.lds + LDSCTL_OFF) + LC_CNT; LAS int* GBASE = LCNT + 32;
    const float* b_router = F.in[IN_BROUTER]; const float* wn = F.in[IN_NMLP];
    const float* mod = (const float*)(F.ws + WS_MOD); const float* h1 = F.out;
    unsigned char* HN2 = (unsigned char*)(F.ws + WS_HN2);
    int* gcnt = (int*)(F.ws + WS_CTL) + CW_CNT; int* list = (int*)(F.ws + WS_LIST); unsigned* ASG = (unsigned*)(F.ws + WS_ASG); float* TOPW = (float*)(F.ws + WS_TOPW);
    const int lane = F.lane, w = F.wave, tid = F.tid, c = lane & 31, hh = lane >> 5;
    bf16x8 bh[8], bl[8];
    { const bf16_t* WRT = (const bf16_t*)(F.ws + WS_WRT);
#pragma unroll
      for (int s = 0; s < 8; ++s) { bh[s] = *(const bf16x8*)(WRT + c * D + 128 * w + 16 * s + 8 * hh); bl[s] = *(const bf16x8*)(WRT + NE * D + c * D + 128 * w + 16 * s + 8 * hh); } }
    const f32x4 wn4[4] = {((const f32x4*)wn)[lane], ((const f32x4*)wn)[lane + 64], ((const f32x4*)wn)[lane + 128], ((const f32x4*)wn)[lane + 192]};
    for (int tblk = F.vcu; tblk < NTOK / 128; tblk += F.G) {
        if (tid < 32) LCNT[tid] = 0;
        const float* mrow = mod + (size_t)((tblk * 128) >> 11) * NMOD;
        f32x4 sc4[4], sh4[4];
#pragma unroll
        for (int j = 0; j < 4; ++j) { sc4[j] = ((const f32x4*)(mrow + 4096))[lane + 64 * j] + 1.f; sh4[j] = ((const f32x4*)(mrow + 3072))[lane + 64 * j]; }
        f32x4 hn[4];
        { const f32x4* xr = (const f32x4*)(h1 + (size_t)(tblk * 128 + 4 * w) * D) + lane;
#pragma unroll
          for (int j = 0; j < 4; ++j) hn[j] = xr[64 * j]; }
        for (int tile = 0; tile < 4; ++tile) {
#pragma unroll 1
            for (int q = 0; q < 4; ++q) { const int tl = 4 * w + q, tok = tblk * 128 + tile * 32 + tl;
                f32x4 hv[4]; float s = 0.f;
#pragma unroll
                for (int j = 0; j < 4; ++j) { hv[j] = hn[j]; s += (hv[j].x * hv[j].x + hv[j].y * hv[j].y) + (hv[j].z * hv[j].z + hv[j].w * hv[j].w); }
                { const int nq = tile * 4 + q + 1; if (nq < 16) { const int ntok = tblk * 128 + (nq >> 2) * 32 + 4 * w + (nq & 3); const f32x4* xr = (const f32x4*)(h1 + (size_t)ntok * D) + lane;
#pragma unroll
                    for (int j = 0; j < 4; ++j) hn[j] = xr[64 * j]; } }
                const float rstd = rsqrtf(wave_sum(s) * (1.f / D) + EPS);
                unsigned* o4 = (unsigned*)(HN2 + (size_t)tok * D) + lane;
#pragma unroll
                for (int j = 0; j < 4; ++j) { const f32x4 y = hv[j] * rstd * wn4[j] * sc4[j] + sh4[j];
                    o4[64 * j] = pg8::pk4_fp8(y.x, y.y, y.z, y.w);
                    u32x2 hi2; hi2.x = pkbf(y.x, y.y); hi2.y = pkbf(y.z, y.w);
                    u32x2 lo2; lo2.x = pkbf(y.x - bflo(hi2.x), y.y - bfhi(hi2.x)); lo2.y = pkbf(y.z - bflo(hi2.y), y.w - bfhi(hi2.y));
                    *(LAS u32x2*)(AH + tl * P6_AP + 4 * lane + 256 * j) = hi2; *(LAS u32x2*)(AL + tl * P6_AP + 4 * lane + 256 * j) = lo2; } }
            __syncthreads();
            f32x16 Dp;
#pragma unroll
            for (int i = 0; i < 16; ++i) Dp[i] = 0.f;
#pragma unroll
            for (int s = 0; s < 8; ++s) { const bf16x8 ah = *(const LAS bf16x8*)(AH + c * P6_AP + 128 * w + 16 * s + 8 * hh), al = *(const LAS bf16x8*)(AL + c * P6_AP + 128 * w + 16 * s + 8 * hh);
                Dp = MFMA32(ah, bh[s], Dp); Dp = MFMA32(ah, bl[s], Dp); Dp = MFMA32(al, bh[s], Dp); }
            __syncthreads();
#pragma unroll
            for (int r = 0; r < 16; ++r) RED[w * (32 * 33) + ((r & 3) + 8 * (r >> 2) + 4 * hh) * 33 + c] = Dp[r];
            __syncthreads();
            { const int tl = tid >> 4, e0 = tid & 15; float a0 = 0.f, a1 = 0.f;
#pragma unroll
              for (int ww = 0; ww < 8; ++ww) { a0 += RED[ww * (32 * 33) + tl * 33 + e0]; a1 += RED[ww * (32 * 33) + tl * 33 + e0 + 16]; }
              LG[(tile * 32 + tl) * 33 + e0] = a0 + b_router[e0]; LG[(tile * 32 + tl) * 33 + e0 + 16] = a1 + b_router[e0 + 16]; }
            __syncthreads();
        }
        if (tid < 128) { float lgv[32];
#pragma unroll
            for (int e = 0; e < 32; ++e) lgv[e] = LG[tid * 33 + e];
            int se[4]; float sv[4];
#pragma unroll
            for (int r = 0; r < 4; ++r) { float bv = -3.0e38f; int bi = 0;
#pragma unroll
                for (int e = 0; e < 32; ++e) { bool ok = lgv[e] > bv;
#pragma unroll
                    for (int q = 0; q < r; ++q) ok = ok && (se[q] != e);
                    bv = ok ? lgv[e] : bv; bi = ok ? e : bi; }
                se[r] = bi; sv[r] = bv; }
            float ex[4], den = 0.f;
#pragma unroll
            for (int r = 0; r < 4; ++r) { ex[r] = __expf(sv[r] - sv[0]); den += ex[r]; }
            const float inv = 1.f / den;
#pragma unroll
            for (int r = 0; r < 4; ++r) { const int lp = __hip_atomic_fetch_add(&LCNT[se[r]], 1, __ATOMIC_RELAXED, __HIP_MEMORY_SCOPE_WORKGROUP);
                REC[tid * 4 + r] = ((unsigned)se[r] << 16) | (unsigned)lp; RECW[tid * 4 + r] = ex[r] * inv; } }
        __syncthreads();
        { int t2 = tid; asm volatile("" : "+v"(t2)); if (t2 < 32) GBASE[t2] = atomicAdd(&gcnt[64 * t2], LCNT[t2]); }
        __syncthreads();
        { const unsigned rec = REC[tid]; const int e = rec >> 16, pos = GBASE[e] + (int)(rec & 0xffffu), aid = tblk * 512 + tid;
          list[e * NTOK + pos] = aid; ASG[aid] = ((unsigned)e << 16) | (unsigned)pos; TOPW[aid] = RECW[tid]; }
        __syncthreads();
    }
}
__device__ __forceinline__ void moe_tables(Frame& F) {
    LAS int* TST = (LAS int*)(F.lds + LDSCTL_OFF) + LC_TST; LAS int* LCNT = (LAS int*)(F.lds + LDSCTL_OFF) + LC_CNT;
    const int* gcnt = (const int*)(F.ws + WS_CTL) + CW_CNT;
    if (F.tid < 64) {
        const int lane = F.lane; const int c = lane < NE ? gcnt[64 * lane] : 0; const int mt = (c + 255) >> 8; int inc = mt;
#pragma unroll
        for (int o = 1; o < 32; o <<= 1) { const int up = __shfl_up(inc, o); if (lane >= o) inc += up; }
        if (lane < NE) { LCNT[lane] = c; TST[lane] = inc - mt; }
        if (lane == NE - 1) TST[NE] = inc;
    }
    __syncthreads();
}
__device__ __forceinline__ f32x4 fp8x4_to_f32(unsigned w) { const f32x2 lo = __builtin_amdgcn_cvt_pk_f32_fp8((int)w, false), hi = __builtin_amdgcn_cvt_pk_f32_fp8((int)w, true); return (f32x4){lo.x, lo.y, hi.x, hi.y}; }
__device__ __forceinline__ void p9_final(Frame& F) {
    const LAS int* TST = (const LAS int*)(F.lds + LDSCTL_OFF) + LC_TST;
    const unsigned* ASG = (const unsigned*)(F.ws + WS_ASG); const float* TOPW = (const float*)(F.ws + WS_TOPW); const unsigned char* Y = (const unsigned char*)(F.ws + WS_Y);
    const float* mod = (const float*)(F.ws + WS_MOD); const float* fw = F.in[IN_FNW]; float* out = F.out;
    const int lane = F.lane, gw = F.vcu * NWAVES + F.wave, NGW = F.G * NWAVES;
    f32x4 fwv[4];
#pragma unroll
    for (int j = 0; j < 4; ++j) fwv[j] = ((const f32x4*)fw)[lane + 64 * j];
    for (int tok0 = gw; tok0 < NTOK; tok0 += 2 * NGW) {
        int tk[2]; tk[0] = tok0; tk[1] = (tok0 + NGW < NTOK) ? tok0 + NGW : tok0;
        unsigned yv[2][4][4]; float wg[2][4]; f32x4 xv[2][4], gv[2][4];
#pragma unroll
        for (int u = 0; u < 2; ++u) { const u32x4 a4 = *(const u32x4*)(ASG + (size_t)tk[u] * 4); const f32x4 w4 = *(const f32x4*)(TOPW + (size_t)tk[u] * 4);
            const unsigned aa[4] = {a4.x, a4.y, a4.z, a4.w};
#pragma unroll
            for (int r = 0; r < 4; ++r) { const unsigned a = (unsigned)__builtin_amdgcn_readfirstlane((int)aa[r]); wg[u][r] = w4[r];
                const size_t row = (size_t)TST[a >> 16] * 256 + (a & 0xffffu); const unsigned* yp = (const unsigned*)(Y + row * D) + lane;
#pragma unroll
                for (int j = 0; j < 4; ++j) yv[u][r][j] = yp[64 * j]; }
            const f32x4* xr = (const f32x4*)(out + (size_t)tk[u] * D) + lane; const f32x4* g2 = (const f32x4*)(mod + (size_t)(tk[u] >> 11) * NMOD + 5120) + lane;
#pragma unroll
            for (int j = 0; j < 4; ++j) { xv[u][j] = xr[64 * j]; gv[u][j] = g2[64 * j]; } }
#pragma unroll
        for (int u = 0; u < 2; ++u) { f32x4 v[4]; float s = 0.f;
#pragma unroll
            for (int j = 0; j < 4; ++j) { f32x4 acc = fp8x4_to_f32(yv[u][0][j]) * wg[u][0];
#pragma unroll
                for (int r = 1; r < 4; ++r) acc += fp8x4_to_f32(yv[u][r][j]) * wg[u][r];
                v[j] = xv[u][j] + gv[u][j] * acc; s += (v[j].x * v[j].x + v[j].y * v[j].y) + (v[j].z * v[j].z + v[j].w * v[j].w); }
            const float rstd = rsqrtf(wave_sum(s) * (1.f / D) + EPS);
            if (u == 0 || tk[1] != tk[0]) { f32x4* xo = (f32x4*)(out + (size_t)tk[u] * D) + lane;
#pragma unroll
                for (int j = 0; j < 4; ++j) xo[64 * j] = v[j] * rstd * fwv[j]; } }
    }
}

#ifndef MK_N_LAUNCHES
#define MK_N_LAUNCHES 1
#endif
constexpr int N_PHASES = 10;
__global__ void __launch_bounds__(NTHR, 2) mk_fwd(Args args) {
    extern __shared__ __attribute__((aligned(16))) unsigned char lds_raw[];
    Frame F;
    F.lds = (LAS unsigned char*)lds_raw;
    F.tid = threadIdx.x; F.lane = F.tid & 63; F.wave = __builtin_amdgcn_readfirstlane(F.tid >> 6);
    F.G = gridDim.x; { const int bx = blockIdx.x; F.vcu = (F.G % 8 == 0) ? (bx % 8) * (F.G / 8) + bx / 8 : bx; }
    F.in = args.in; F.out = args.out; F.ws = args.ws;
    for (int u = F.tid; u < (LDS_BYTES - LDSCTL_OFF) / 4; u += NTHR) ((LAS unsigned*)(F.lds + LDSCTL_OFF))[u] = 0u;
    __syncthreads();
    const int lo = args.ph_lo, hi = args.ph_hi;
    XcdBarrier bar; bar.bar = (unsigned*)(F.ws + WS_CTL) + CW_BAR; bar.x = 0; bar.st = nullptr;
    if (hi - lo > 1) bar = xcd_barrier_post((unsigned*)(F.ws + WS_CTL) + CW_BAR, (volatile LAS unsigned*)(F.lds + LDSCTL_OFF) + LC_BAR);
#define IN(k) (lo <= (k) && (k) < hi)
#define SEAM(k) do { if (IN(k) && IN((k) + 1)) xcd_barrier(bar); } while (0)
    if (IN(0)) { p0_prologue(F, false); } SEAM(0);
    if (IN(1)) { p1_norm1(F); } SEAM(1);
    if (IN(2)) {
        pg8::SchedInProj S{F.G, (int)blockIdx.x};
        pg8::EpiInProj E{(bf16_t*)(F.ws + WS_KB), (bf16_t*)(F.ws + WS_VB), (bf16_t*)(F.ws + WS_QB), (bf16_t*)(F.ws + WS_GB), (bf16_t*)(F.ws + WS_PB), (float*)(F.ws + WS_RB)};
        pg8::gemm_phase<pg8::EpiInProj, pg8::SchedInProj, true, false>(F.lds, (const char*)(F.ws + WS_HN1), (const char*)(F.ws + WS_WIN), D * 2, S, E);
    } SEAM(2);
    if (IN(3)) {
        const int bx = blockIdx.x, nG = (F.G + 1) >> 1, nP = F.G - nG;
        constexpr int CVT_N = 2048 + 1024, CVT_ODD = 2944;
        if ((bx & 1) == 0) { for (int u = bx >> 1; u < NB * 8; u += nG) gla_unit<0>(F, u);
                             cvt_expert_items<0>(F, CVT_ODD + (bx >> 1), nG, CVT_N); }
        else { for (int u = bx >> 1; u < NB * 64; u += nP) pool_unit(F, u);
               cvt_expert_items<0>(F, bx >> 1, nP, CVT_ODD); }
    } SEAM(3);
    if (IN(4)) { p4_gla_out(F); } SEAM(4);
    if (IN(5)) {
        pg8::SchedPlain S{F.G, (int)blockIdx.x, NTOK / 256, D / 256};
        pg8::EpiResid E{F.in[IN_X], (const float*)(F.ws + WS_MOD), F.out};
        pg8::gemm_phase<pg8::EpiResid, pg8::SchedPlain, true, false>(F.lds, (const char*)(F.ws + WS_MIX), (const char*)(F.ws + WS_WOUT), D * 2, S, E);
    } SEAM(5);
    if (IN(6)) { p6_router(F); } SEAM(6);
    const LAS int* TST = (const LAS int*)(F.lds + LDSCTL_OFF) + LC_TST; const LAS int* LCN = (const LAS int*)(F.lds + LDSCTL_OFF) + LC_CNT;
    if (IN(7)) {
        moe_tables(F);
        pg8::SchedMoE<8, true> S{F.G, (int)blockIdx.x, TST, LCN, (const int*)(F.ws + WS_LIST)};
        pg8::EpiSwiglu<true> E{(void*)(F.ws + WS_ACT), F.in[IN_BGU], 1.f / WSCALE};
        pg8::gemm_phase<pg8::EpiSwiglu<true>, pg8::SchedMoE<8, true>, true, true>(F.lds, (const char*)(F.ws + WS_HN2), (const char*)(F.ws + WS_WGU), D, S, E);
    } SEAM(7);
    if (IN(8)) {
        moe_tables(F);
        pg8::SchedMoE<4, false> S{F.G, (int)blockIdx.x, TST, LCN, nullptr};
        pg8::EpiDown E{(unsigned char*)(F.ws + WS_Y), F.in[IN_BDOWN], 1.f / WSCALE};
        pg8::gemm_phase<pg8::EpiDown, pg8::SchedMoE<4, false>, true, true>(F.lds, (const char*)(F.ws + WS_ACT), (const char*)(F.ws + WS_WD), DFF, S, E);
    } SEAM(8);
    if (IN(9)) { moe_tables(F); p9_final(F); }
#undef IN
#undef SEAM
}

extern "C" void kernel_launch(void* const* d_in, const int* in_sizes, int n_in, void* d_out, int out_size, void* d_ws, size_t ws_size, hipStream_t stream) {
    static int grid = 0;
    if (grid == 0) {
        if (n_in != 24 || ws_size < WS_END || out_size != NTOK * D) { fprintf(stderr, "kernel_launch: unexpected n_in %d / ws_size %zu / out %d\n", n_in, ws_size, out_size); grid = -1; return; }
        int dev = 0, cus = 0, per_cu = 0;
        if (hipGetDevice(&dev) != hipSuccess || hipDeviceGetAttribute(&cus, hipDeviceAttributeMultiprocessorCount, dev) != hipSuccess) { grid = -1; return; }
        if (hipFuncSetAttribute((const void*)mk_fwd, hipFuncAttributeMaxDynamicSharedMemorySize, LDS_BYTES) != hipSuccess) { fprintf(stderr, "kernel_launch: hipFuncSetAttribute failed\n"); grid = -1; return; }
        if (hipOccupancyMaxActiveBlocksPerMultiprocessor(&per_cu, (const void*)mk_fwd, NTHR, LDS_BYTES) != hipSuccess || per_cu < 1) { fprintf(stderr, "kernel_launch: occupancy query says %d workgroups per CU\n", per_cu); (void)hipGetLastError(); grid = -1; return; }
        (void)hipGetLastError();
        grid = cus;
    }
    if (grid < 0) return;
    (void)hipMemsetAsync((char*)d_ws + WS_CTL, 0, 1 * MiB, stream);
    Args a{};
    for (int i = 0; i < 24; ++i) a.in[i] = (const float*)d_in[i];
    a.out = (float*)d_out; a.ws = (unsigned char*)d_ws;
    if (MK_N_LAUNCHES == 1) {
        a.ph_lo = 0; a.ph_hi = N_PHASES;
        void* kargs[] = {&a};
        const hipError_t e = hipLaunchCooperativeKernel((const void*)mk_fwd, dim3(grid), dim3(NTHR), kargs, LDS_BYTES, stream);
        if (e != hipSuccess) fprintf(stderr, "kernel_launch: cooperative launch failed: %s (grid %d)\n", hipGetErrorString(e), grid);
    } else {
        for (int ph = 0; ph < N_PHASES; ++ph) { a.ph_lo = ph; a.ph_hi = ph + 1; hipLaunchKernelGGL(mk_fwd, dim3(grid), dim3(NTHR), LDS_BYTES, stream, a); }
    }
}
```

```cpp
#include <hip/hip_runtime.h>
#include <stdint.h>
#include <stdio.h>

#define LAS __attribute__((address_space(3)))
#define GAS __attribute__((address_space(1)))
typedef unsigned short bf16_t;
typedef short bf16x8 __attribute__((ext_vector_type(8)));
typedef float f32x4 __attribute__((ext_vector_type(4)));
typedef float f32x2 __attribute__((ext_vector_type(2)));
typedef float f32x16 __attribute__((ext_vector_type(16)));
typedef unsigned u32x4 __attribute__((ext_vector_type(4)));
typedef unsigned u32x2 __attribute__((ext_vector_type(2)));

constexpr int D = 1024, NB = 16, SEQ = 2048, CTX = 256;
constexpr int NTOK = NB * SEQ, NCTX = NB * CTX, NROW = NTOK + NCTX;
constexpr int DIN = 2080, NE = 32, DFF = 1024;
constexpr int GW = 64, GROWS = 32;
constexpr int NMOD = 6144;
constexpr float EPS = 1e-6f;
constexpr int NWAVES = 8, NTHR = 512;
constexpr int WIN_N = 2304;
constexpr int NPADROWS = NTOK * 4 + NE * 256;

__device__ __forceinline__ unsigned f2bf(float f) { unsigned u = __builtin_bit_cast(unsigned, f); return (u + 0x7fffu + ((u >> 16) & 1u)) >> 16; }
__device__ __forceinline__ unsigned pk2(float lo, float hi) { return f2bf(lo) | (f2bf(hi) << 16); }
__device__ __forceinline__ float bf2f(unsigned v) { return __builtin_bit_cast(float, v << 16); }
__device__ __forceinline__ float bflo(unsigned w) { return __builtin_bit_cast(float, w << 16); }
__device__ __forceinline__ float bfhi(unsigned w) { return __builtin_bit_cast(float, w & 0xffff0000u); }
__device__ __forceinline__ unsigned cvt_pk_bf16(float lo, float hi) { unsigned r; asm volatile("v_cvt_pk_bf16_f32 %0, %1, %2" : "=v"(r) : "v"(lo), "v"(hi)); return r; }
__device__ __forceinline__ float wave_sum(float v) {
#pragma unroll
    for (int o = 1; o < 64; o <<= 1) v += __shfl_xor(v, o);
    return v;
}
__device__ __forceinline__ float silu_f(float x) { return x / (1.f + __expf(-x)); }
__device__ __forceinline__ float logsigmoid_f(float x) { return fminf(x, 0.f) - log1pf(expf(-fabsf(x))); }
#define LDS_WAIT() asm volatile("s_waitcnt lgkmcnt(0)" ::: "memory")
#define VM_WAIT() asm volatile("s_waitcnt vmcnt(0)" ::: "memory")

namespace pg8 {
constexpr int BM = 256, BK = 64, HALF = 128, HTB = HALF * BK * 2  , STAGE_BYTES = 8 * HTB, NXCD = 8, WGM = 8;
__host__ __device__ __forceinline__ int lds_byte(int r, int c) { const int st = (r >> 4) * 2 + (c >> 5), rr = r & 15, cc = c & 31, ob = rr * 64 + cc * 2; return st * 1024 + (ob ^ (((ob >> 9) & 1) << 5)); }
__host__ __device__ __forceinline__ void stage_rc(int b, int& R, int& C) { const int st = b / 1024, sb = b % 1024, swz = sb ^ (((sb >> 9) & 1) << 5); R = (st >> 1) * 16 + swz / 64; C = (st & 1) * 32 + (swz % 64) / 2; }
__host__ __device__ __forceinline__ int perm32(int rho) { const int n = rho >> 4, i = rho & 15; return 8 * (i >> 2) + 4 * n + (i & 3); }

struct Unit { int pm, pn, arow, bt, nvalid, e; };

typedef int i32x8 __attribute__((ext_vector_type(8)));
typedef int i32x4v __attribute__((ext_vector_type(4)));
__device__ __forceinline__ i32x8 cat8(const bf16x8 a, const bf16x8 b) { const i32x4v x = __builtin_bit_cast(i32x4v, a), y = __builtin_bit_cast(i32x4v, b); return __builtin_shufflevector(x, y, 0, 1, 2, 3, 4, 5, 6, 7); }
__device__ __forceinline__ bf16x8 lo8(const i32x8 v) { return __builtin_bit_cast(bf16x8, (i32x4v)__builtin_shufflevector(v, v, 0, 1, 2, 3)); }
__device__ __forceinline__ bf16x8 hi8(const i32x8 v) { return __builtin_bit_cast(bf16x8, (i32x4v)__builtin_shufflevector(v, v, 4, 5, 6, 7)); }
template <class Epi, class Sched, bool ALIGN_EPI, bool FP8>
__device__ __forceinline__ void gemm_phase(LAS unsigned char* lds, const char* Abase, const char* Bbase, const int pitch, const Sched& S, const Epi& E) {
    const int tid = threadIdx.x, wid = __builtin_amdgcn_readfirstlane(tid >> 6), lane = tid & 63, wr = wid >> 2, wc = wid & 3, fr = lane & 15, fq = lane >> 4;
    const int nt = pitch / 128;
    unsigned voffB[2];
#pragma unroll
    for (int i = 0; i < 2; ++i) { int R, C; stage_rc(tid * 16 + i * 8192, R, C); const int Rb = (R & ~31) + perm32(R & 31);
        voffB[i] = (unsigned)(Rb * pitch) + (unsigned)C * 2u; }
    const size_t kstep = (size_t)(BK * 2);
    const size_t hstep = (size_t)HALF * pitch;
    const unsigned ldsw = (unsigned)wid * 1024u;
    const int aoff = lds_byte(wr * 64 + fr, fq * 8), boff = lds_byte(wc * 32 + fr, fq * 8);
#define PG8_SA(b, h) (((b) * 2 + (h)) * HTB)
#define PG8_SB(b, h) ((4 + (b) * 2 + (h)) * HTB)
#define PG8_STAGE_B(bufoff, gbase) do { _Pragma("unroll") for (int _i = 0; _i < 2; ++_i) \
        __builtin_amdgcn_global_load_lds((const unsigned*)((const char*)(gbase) + voffB[_i]), (LAS unsigned*)(lds + (bufoff) + ldsw + _i * 8192), 16, 0, 0); } while (0)
#define PG8_STAGE_A(bufoff, ao, kb) do { _Pragma("unroll") for (int _i = 0; _i < 2; ++_i) \
        __builtin_amdgcn_global_load_lds((const unsigned*)(Abase + (size_t)(ao)[_i] + (size_t)(kb)), (LAS unsigned*)(lds + (bufoff) + ldsw + _i * 8192), 16, 0, 0); } while (0)
#define PG8_LDA(dst, b, h) do { _Pragma("unroll") for (int m = 0; m < 4; ++m) dst[m] = cat8(*(const LAS bf16x8*)(lds + PG8_SA(b, h) + aoff + m * 2048), *(const LAS bf16x8*)(lds + PG8_SA(b, h) + aoff + m * 2048 + 1024)); } while (0)
#define PG8_LDB(dst, b, h) do { _Pragma("unroll") for (int n = 0; n < 2; ++n) dst[n] = cat8(*(const LAS bf16x8*)(lds + PG8_SB(b, h) + boff + n * 2048), *(const LAS bf16x8*)(lds + PG8_SB(b, h) + boff + n * 2048 + 1024)); } while (0)
#define PG8_MMA(ai, bj, At, Bt) do { __builtin_amdgcn_s_setprio(1); _Pragma("unroll") for (int m = 0; m < 4; ++m) _Pragma("unroll") for (int n = 0; n < 2; ++n) { \
        if constexpr (FP8) { acc[ai][bj][m][n] = __builtin_amdgcn_mfma_scale_f32_16x16x128_f8f6f4(Bt[n], At[m], acc[ai][bj][m][n], 0, 0, 0, 0x7f7f7f7f, 0, 0x7f7f7f7f); } \
        else { acc[ai][bj][m][n] = __builtin_amdgcn_mfma_f32_16x16x32_bf16(lo8(Bt[n]), lo8(At[m]), acc[ai][bj][m][n], 0, 0, 0); \
               acc[ai][bj][m][n] = __builtin_amdgcn_mfma_f32_16x16x32_bf16(hi8(Bt[n]), hi8(At[m]), acc[ai][bj][m][n], 0, 0, 0); } } \
        __builtin_amdgcn_s_setprio(0); } while (0)
#define PG8_WAIT_V(n) asm volatile("s_waitcnt vmcnt(" #n ")" ::: "memory")
#define PG8_WAIT_L(n) asm volatile("s_waitcnt lgkmcnt(" #n ")" ::: "memory")
#define PG8_BAR __builtin_amdgcn_s_barrier()
#define PG8_SCHED __builtin_amdgcn_sched_barrier(0)
    Unit cur, nxt; int ui = 0;
    if (!S.next(0, cur)) return;
    f32x4 acc[2][2][4][2];
#pragma unroll
    for (int a = 0; a < 2; ++a)
#pragma unroll
        for (int b = 0; b < 2; ++b)
#pragma unroll
            for (int m = 0; m < 4; ++m)
#pragma unroll
                for (int n = 0; n < 2; ++n) acc[a][b][m][n] = (f32x4){0.f, 0.f, 0.f, 0.f};
    i32x8 At[4], B0[2], B1[2];
    unsigned aoc[2][2];
    LAS u32x4* nxslot = (LAS u32x4*)(lds + STAGE_BYTES) + tid;
#pragma unroll
    for (int h = 0; h < 2; ++h)
#pragma unroll
        for (int i = 0; i < 2; ++i) { int R2, C2; stage_rc(tid * 16 + i * 8192, R2, C2); aoc[h][i] = S.arow(cur, h * HALF + R2) * (unsigned)pitch + (unsigned)C2 * 2u; }
    const char* cB = Bbase + (size_t)cur.bt * pitch;
    PG8_STAGE_B(PG8_SB(0, 0), cB); PG8_STAGE_B(PG8_SB(0, 1), cB + hstep); PG8_STAGE_A(PG8_SA(0, 0), aoc[0], 0); PG8_STAGE_A(PG8_SA(0, 1), aoc[1], 0);
    if (wr == 1) PG8_BAR;
    PG8_WAIT_V(2); PG8_BAR;
    PG8_STAGE_B(PG8_SB(1, 0), cB + kstep); PG8_STAGE_A(PG8_SA(1, 0), aoc[0], kstep); PG8_STAGE_B(PG8_SB(1, 1), cB + hstep + kstep);
    PG8_WAIT_V(6); PG8_BAR;
    for (;;) {
        const bool has_next = S.next(ui + 1, nxt);
        int tq = tid; asm volatile("" : "+v"(tq));
        { unsigned nx4[4];
#pragma unroll
          for (int h = 0; h < 2; ++h)
#pragma unroll
              for (int i = 0; i < 2; ++i) { int R2, C2; stage_rc(tq * 16 + i * 8192, R2, C2); nx4[h * 2 + i] = has_next ? S.arow(nxt, h * HALF + R2) * (unsigned)pitch + (unsigned)C2 * 2u : aoc[h][i]; }
          *nxslot = (u32x4){nx4[0], nx4[1], nx4[2], nx4[3]}; }
        const char* nB = has_next ? Bbase + (size_t)nxt.bt * pitch : cB;
#pragma nounroll
        for (int t = 0; t < nt; t += 2) {
            const bool last = (t == nt - 2);
            const size_t k1 = (size_t)(t + 1) * kstep;
            const size_t k2 = last ? (size_t)0 : (size_t)(t + 2) * kstep, k3 = k2 + kstep;
            const char* b2 = last ? nB : cB + (size_t)(t + 2) * kstep; const char* b3 = b2 + kstep;
            PG8_LDB(B0, 0, 0); PG8_LDB(B1, 0, 1); PG8_SCHED; PG8_LDA(At, 0, 0); PG8_STAGE_A(PG8_SA(1, 1), aoc[1], k1);
            if (last) { const u32x4 nx = *nxslot; aoc[0][0] = nx.x; aoc[0][1] = nx.y; aoc[1][0] = nx.z; aoc[1][1] = nx.w; }
            PG8_WAIT_V(8); PG8_WAIT_L(0); PG8_BAR; PG8_MMA(0, 0, At, B0); PG8_MMA(0, 1, At, B1); PG8_BAR; PG8_SCHED;
            PG8_LDA(At, 0, 1); PG8_STAGE_B(PG8_SB(0, 0), b2); PG8_STAGE_B(PG8_SB(0, 1), b2 + hstep); PG8_STAGE_A(PG8_SA(0, 0), aoc[0], k2);
            PG8_WAIT_V(8); PG8_WAIT_L(0); PG8_BAR; PG8_MMA(1, 0, At, B0); PG8_MMA(1, 1, At, B1); PG8_BAR; PG8_SCHED;
            PG8_LDB(B0, 1, 0); PG8_LDB(B1, 1, 1); PG8_SCHED; PG8_LDA(At, 1, 0); PG8_STAGE_A(PG8_SA(0, 1), aoc[1], k2);
            PG8_WAIT_V(8); PG8_WAIT_L(0); PG8_BAR; PG8_MMA(0, 0, At, B0); PG8_MMA(0, 1, At, B1); PG8_BAR; PG8_SCHED;
            PG8_LDA(At, 1, 1); PG8_STAGE_B(PG8_SB(1, 0), b3); PG8_STAGE_B(PG8_SB(1, 1), b3 + hstep); PG8_STAGE_A(PG8_SA(1, 0), aoc[0], k3);
            PG8_WAIT_V(8); PG8_WAIT_L(0); PG8_BAR; PG8_MMA(1, 0, At, B0); PG8_MMA(1, 1, At, B1); PG8_BAR; PG8_SCHED;
        }
        if constexpr (ALIGN_EPI) { if (wr == 0) PG8_BAR; }
        E(acc, cur, wr, wc, fr, fq);
        if (!has_next) break;
#pragma unroll
        for (int a = 0; a < 2; ++a)
#pragma unroll
            for (int b = 0; b < 2; ++b)
#pragma unroll
                for (int m = 0; m < 4; ++m)
#pragma unroll
                    for (int n = 0; n < 2; ++n) acc[a][b][m][n] = (f32x4){0.f, 0.f, 0.f, 0.f};
        cur = nxt; cB = nB; ++ui;
        if constexpr (ALIGN_EPI) { if (wr == 1) PG8_BAR; }
    }
    PG8_WAIT_V(0);
    if constexpr (!ALIGN_EPI) { if (wr == 0) PG8_BAR; }
    PG8_BAR;
#undef PG8_SA
#undef PG8_SB
#undef PG8_STAGE_A
#undef PG8_STAGE_B
#undef PG8_LDA
#undef PG8_LDB
#undef PG8_MMA
#undef PG8_WAIT_V
#undef PG8_WAIT_L
#undef PG8_BAR
#undef PG8_SCHED
}

__device__ __forceinline__ int xcd_remap(int L, int nwg) { const int q = nwg / NXCD, r = nwg % NXCD, xcd = L % NXCD, off = L / NXCD; return (xcd < r ? xcd * (q + 1) : r * (q + 1) + (xcd - r) * q) + off; }

constexpr int NG2 = 64;
struct SchedInProj {
    int G, c;
    __device__ __forceinline__ bool next(int i, Unit& u) const {
        constexpr int NLAT = 128 * 7, NCTX = 16 * 4, NWG = NLAT + NCTX + NG2;
        const int L = i * G + c; if (L >= NWG) return false;
        const int wgid = xcd_remap(L, NWG); int pm, pn;
        if (wgid < NLAT) { const int nig = WGM * 7, gid = wgid / nig, j = (wgid % nig) / WGM; pm = gid * WGM + (wgid % nig) % WGM; pn = j < 5 ? j : j + 2; }
        else if (wgid < NLAT + NCTX) { const int w = wgid - NLAT, nig = WGM * 4, gid = w / nig; pm = 128 + gid * WGM + (w % nig) % WGM; pn = (w % nig) / WGM; }
        else { const int w = wgid - NLAT - NCTX; pm = w >> 1; pn = 5 + (w & 1); }
        u.pm = pm; u.pn = pn; u.arow = pm * BM; u.bt = pn * BM; u.nvalid = BM; u.e = 0; return true;
    }
    __device__ __forceinline__ unsigned arow(const Unit& u, int rloc) const { return (unsigned)(u.arow + rloc); }
};
struct SchedInProjG {
    int nwg, c;
    __device__ __forceinline__ bool next(int i, Unit& u) const {
        const int L = NG2 + i * nwg + c; if (L >= 256) return false;
        u.pm = L >> 1; u.pn = 5 + (L & 1); u.arow = u.pm * BM; u.bt = u.pn * BM; u.nvalid = BM; u.e = 0; return true;
    }
    __device__ __forceinline__ unsigned arow(const Unit& u, int rloc) const { return (unsigned)(u.arow + rloc); }
};
struct SchedPlain {
    int G, c, nM, nN;
    __device__ __forceinline__ bool next(int i, Unit& u) const {
        const int nwg = nM * nN, L = i * G + c; if (L >= nwg) return false;
        const int wgid = xcd_remap(L, nwg), nig = WGM * nN, gid = wgid / nig, fm = gid * WGM, gsz = (nM - fm) < WGM ? (nM - fm) : WGM;
        u.pm = fm + ((wgid % nig) % gsz); u.pn = (wgid % nig) / gsz; u.arow = u.pm * BM; u.bt = u.pn * BM; u.nvalid = BM; u.e = 0; return true;
    }
    __device__ __forceinline__ unsigned arow(const Unit& u, int rloc) const { return (unsigned)(u.arow + rloc); }
};
template <int NT, bool GATHER>
struct SchedMoE {
    int G, c; const LAS int* tst; const LAS int* cnt; const int* list;
    __device__ __forceinline__ bool next(int i, Unit& u) const {
        const int nwg = tst[NE] * NT, L = i * G + c; if (L >= nwg) return false;
        const int wgid = xcd_remap(L, nwg);
        int e = 0;
#pragma unroll
        for (int s = 16; s >= 1; s >>= 1) { if (tst[e + s] * NT <= wgid) e += s; }
        const int t0 = tst[e], mt = tst[e + 1] - t0, w = wgid - t0 * NT, nig = WGM * NT, gid = w / nig, fm = gid * WGM, gsz = (mt - fm) < WGM ? (mt - fm) : WGM;
        const int m = fm + ((w % nig) % gsz), n = (w % nig) / gsz;
        u.pm = t0 + m; u.pn = n; u.e = e; u.bt = (e * NT + n) * BM;
        if (GATHER) { u.arow = e * NTOK + m * BM; const int left = cnt[e] - m * BM; u.nvalid = left < BM ? left : BM; }
        else { u.arow = u.pm * BM; u.nvalid = BM; }
        return true;
    }
    __device__ __forceinline__ unsigned arow(const Unit& u, int rloc) const {
        if (GATHER) { const int tok = (rloc < u.nvalid) ? (list[u.arow + rloc] >> 2) : 0; return (unsigned)tok; }
        return (unsigned)(u.arow + rloc);
    }
};

struct EpiInProj {
    bf16_t *KB, *VB, *QB, *GB, *PB; float* RB;
    __device__ __forceinline__ void operator()(const f32x4 (&acc)[2][2][4][2], const Unit& u, int wr, int wc, int fr, int fq) const {
        const int pn = u.pn, row0 = u.pm * BM + wr * 64 + fr;
        if (pn == 3) {
            if (wc != 0) return;
#pragma unroll
            for (int ai = 0; ai < 2; ++ai)
#pragma unroll
                for (int m = 0; m < 4; ++m) { float* rp = RB + (size_t)(row0 + ai * HALF + m * 16) * 32 + 8 * fq;
                    *(f32x4*)rp = acc[ai][0][m][0]; *(f32x4*)(rp + 4) = acc[ai][0][m][1]; }
            return;
        }
        if (pn >= 7) {
#pragma unroll
            for (int ai = 0; ai < 2; ++ai)
#pragma unroll
                for (int m = 0; m < 4; ++m) { const int row = row0 + ai * HALF + m * 16, b = row >> 11, t = row & 2047;
#pragma unroll
                    for (int bj = 0; bj < 2; ++bj) { const int g = (pn - 7) * 2 + bj, cblk = wc * 4 + fq;
                        const f32x4 v0 = acc[ai][bj][m][0], v1 = acc[ai][bj][m][1]; u32x4 w; w.x = cvt_pk_bf16(v0[0], v0[1]); w.y = cvt_pk_bf16(v0[2], v0[3]); w.z = cvt_pk_bf16(v1[0], v1[1]); w.w = cvt_pk_bf16(v1[2], v1[3]);
                        *(u32x4*)(PB + ((((size_t)(b * 4 + g) * 16 + cblk) * 2048 + t) * 8)) = w; } }
            return;
        }
        bf16_t* base; int ldc, coff;
        if (pn == 0) { base = KB; ldc = 256; coff = 0; } else if (pn <= 2) { base = VB; ldc = 512; coff = (pn - 1) * 256; }
        else if (pn == 4) { base = QB; ldc = 256; coff = 0; } else { base = GB; ldc = 512; coff = (pn - 5) * 256; }
        const int col0 = coff + wc * 32 + 8 * fq;
#pragma unroll
        for (int ai = 0; ai < 2; ++ai)
#pragma unroll
            for (int m = 0; m < 4; ++m) { bf16_t* rowp = base + (size_t)(row0 + ai * HALF + m * 16) * ldc + col0;
#pragma unroll
                for (int bj = 0; bj < 2; ++bj) { const f32x4 v0 = acc[ai][bj][m][0], v1 = acc[ai][bj][m][1];
                    u32x4 w; w.x = cvt_pk_bf16(v0[0], v0[1]); w.y = cvt_pk_bf16(v0[2], v0[3]); w.z = cvt_pk_bf16(v1[0], v1[1]); w.w = cvt_pk_bf16(v1[2], v1[3]);
                    *(u32x4*)(rowp + bj * HALF) = w; } }
    }
};
struct EpiResid {
    const float* x; const float* mod; float* out;
    __device__ __forceinline__ void operator()(const f32x4 (&acc)[2][2][4][2], const Unit& u, int wr, int wc, int fr, int fq) const {
        const int row0 = u.pm * BM + wr * 64 + fr, col0 = u.pn * BM + wc * 32 + 8 * fq;
        const float* g1 = mod + (size_t)(row0 >> 11) * NMOD + 2048 + col0;
        f32x4 gv[2][2];
#pragma unroll
        for (int bj = 0; bj < 2; ++bj)
#pragma unroll
            for (int n = 0; n < 2; ++n) gv[bj][n] = *(const f32x4*)(g1 + bj * HALF + 4 * n);
        f32x4 xa[2][2], xb[2][2];
#define RES_LOAD(dst, g_) do { const size_t _o = (size_t)(row0 + ((g_) >> 2) * HALF + ((g_) & 3) * 16) * D + col0; \
            _Pragma("unroll") for (int bj = 0; bj < 2; ++bj) _Pragma("unroll") for (int n = 0; n < 2; ++n) dst[bj][n] = *(const f32x4*)(x + _o + bj * HALF + 4 * n); } while (0)
#define RES_STORE(src, g_) do { const size_t _o = (size_t)(row0 + ((g_) >> 2) * HALF + ((g_) & 3) * 16) * D + col0; \
            _Pragma("unroll") for (int bj = 0; bj < 2; ++bj) _Pragma("unroll") for (int n = 0; n < 2; ++n) *(f32x4*)(out + _o + bj * HALF + 4 * n) = src[bj][n] + gv[bj][n] * acc[(g_) >> 2][bj][(g_) & 3][n]; } while (0)
        RES_LOAD(xa, 0);
#pragma unroll
        for (int g2 = 0; g2 < 8; g2 += 2) { RES_LOAD(xb, g2 + 1); RES_STORE(xa, g2); if (g2 + 2 < 8) RES_LOAD(xa, g2 + 2); RES_STORE(xb, g2 + 1); }
#undef RES_LOAD
#undef RES_STORE
    }
};
__device__ __forceinline__ unsigned pk4_fp8(float a, float b, float c, float d) { int w = 0; w = __builtin_amdgcn_cvt_pk_fp8_f32(a, b, w, false); w = __builtin_amdgcn_cvt_pk_fp8_f32(c, d, w, true); return (unsigned)w; }
template <bool FP8>
struct EpiSwiglu {
    void* act; const float* bgu; float ascale;
    __device__ __forceinline__ void operator()(const f32x4 (&acc)[2][2][4][2], const Unit& u, int wr, int wc, int fr, int fq) const {
        const int row0 = u.pm * BM + wr * 64 + fr, cc = u.pn * HALF + wc * 32 + 8 * fq;
        const float* bg = bgu + (size_t)u.e * 2048 + cc;
        f32x4 bgv[2], buv[2];
#pragma unroll
        for (int n = 0; n < 2; ++n) { bgv[n] = *(const f32x4*)(bg + 4 * n); buv[n] = *(const f32x4*)(bg + 1024 + 4 * n); }
#pragma unroll
        for (int ai = 0; ai < 2; ++ai)
#pragma unroll
            for (int m = 0; m < 4; ++m) { float r[8];
#pragma unroll
                for (int n = 0; n < 2; ++n) { const f32x4 gq = acc[ai][0][m][n] * ascale + bgv[n], uq = acc[ai][1][m][n] * ascale + buv[n];
#pragma unroll
                    for (int j = 0; j < 4; ++j) { const float gt = fminf(gq[j], 7.f), up = fminf(fmaxf(uq[j], -7.f), 7.f);
                        r[4 * n + j] = (up + 1.f) * gt * __builtin_amdgcn_rcpf(1.f + __expf(-1.702f * gt)); } }
                if constexpr (FP8) { u32x2 w; w.x = pk4_fp8(r[0], r[1], r[2], r[3]); w.y = pk4_fp8(r[4], r[5], r[6], r[7]);
                    *(u32x2*)((unsigned char*)act + (size_t)(row0 + ai * HALF + m * 16) * DFF + cc) = w; }
                else { u32x4 w; w.x = cvt_pk_bf16(r[0], r[1]); w.y = cvt_pk_bf16(r[2], r[3]); w.z = cvt_pk_bf16(r[4], r[5]); w.w = cvt_pk_bf16(r[6], r[7]);
                    *(u32x4*)((bf16_t*)act + (size_t)(row0 + ai * HALF + m * 16) * DFF + cc) = w; } }
    }
};
struct EpiDown {
    unsigned char* y; const float* bd; float ascale;
    __device__ __forceinline__ void operator()(const f32x4 (&acc)[2][2][4][2], const Unit& u, int wr, int wc, int fr, int fq) const {
        const int row0 = u.pm * BM + wr * 64 + fr, col0 = u.pn * BM + wc * 32 + 8 * fq;
        const float* bp = bd + (size_t)u.e * D + col0;
        f32x4 bv[2][2];
#pragma unroll
        for (int bj = 0; bj < 2; ++bj)
#pragma unroll
            for (int n = 0; n < 2; ++n) bv[bj][n] = *(const f32x4*)(bp + bj * HALF + 4 * n);
#pragma unroll
        for (int ai = 0; ai < 2; ++ai)
#pragma unroll
            for (int m = 0; m < 4; ++m) { unsigned char* rowp = y + (size_t)(row0 + ai * HALF + m * 16) * D + col0;
#pragma unroll
                for (int bj = 0; bj < 2; ++bj) { const f32x4 v0 = acc[ai][bj][m][0] * ascale + bv[bj][0], v1 = acc[ai][bj][m][1] * ascale + bv[bj][1];
                    u32x2 w; w.x = pk4_fp8(v0[0], v0[1], v0[2], v0[3]); w.y = pk4_fp8(v1[0], v1[1], v1[2], v1[3]);
                    *(u32x2*)(rowp + bj * HALF) = w; } }
    }
};
}

constexpr size_t MiB = 1u << 20;
constexpr size_t WS_CTL = 0, WS_MOD = 1 * MiB, WS_TOPW = 2 * MiB, WS_ASG = 3 * MiB, WS_WRT = 3 * MiB + 512 * 1024, WS_LIST = 4 * MiB, WS_WIN = 8 * MiB, WS_WOUT = 13 * MiB,
                 WS_WGU = 16 * MiB, WS_WD = 80 * MiB, WS_HN1 = 112 * MiB, WS_HN2 = 112 * MiB,
                 WS_KB = 184 * MiB, WS_VB = 202 * MiB, WS_RB = 238 * MiB, WS_QB = 243 * MiB, WS_GB = 259 * MiB, WS_PB = 291 * MiB,
                 WS_OF = 323 * MiB, WS_OB = 387 * MiB, WS_MIX = 451 * MiB, WS_ACT = 184 * MiB, WS_Y = 515 * MiB, WS_END = 787 * MiB;
static_assert(WS_ACT + (size_t)NPADROWS * DFF <= WS_Y && WS_Y + (size_t)NPADROWS * D * 2 <= WS_END, "ws map");


constexpr int CW_CNT = 0;
constexpr int CW_BAR = 4096;

constexpr int RING_BYTES = 131072;
constexpr int LDSCTL_OFF = 155648;
constexpr int LDS_BYTES = 163840;
constexpr int LC_BAR = 0, LC_TST = 16, LC_CNT = 64;

#define XB_TMO      128
#define XB_XCNT(j)  (256  + 64 * (j))
#define XB_XSUB(j)  (1280 + 64 * (j))
#define XB_XGEN(j)  (2304 + 64 * (j))
#define XB_TOP      3328
#define XB_TOPGEN   3392
#define XCD_BAR_WORDS 3456
#define XB_SPIN_CAP (1u << 18)
__device__ __forceinline__ unsigned xb_ld(unsigned* p)              { return __hip_atomic_load(p, __ATOMIC_RELAXED, __HIP_MEMORY_SCOPE_AGENT); }
__device__ __forceinline__ unsigned xb_add(unsigned* p, unsigned v) { return __hip_atomic_fetch_add(p, v, __ATOMIC_RELAXED, __HIP_MEMORY_SCOPE_AGENT); }
__device__ __forceinline__ unsigned xb_xcc_id() { return (unsigned)__builtin_amdgcn_s_getreg((3 << 11) | 20) & 0xFu; }
#define XB_SPIN(cond, bar) do { unsigned _sp = 0; while (cond) { __builtin_amdgcn_s_sleep(1); \
    if ((++_sp & 255u) == 0u) { if (xb_ld(&(bar)[XB_TMO])) break; if (_sp > XB_SPIN_CAP) { atomicAdd(&(bar)[XB_TMO], 1u); break; } } } } while (0)
struct XcdBarrier { unsigned* bar; unsigned x; volatile LAS unsigned* st; };
__device__ __forceinline__ XcdBarrier xcd_barrier_post(unsigned* bar, volatile LAS unsigned* st) {
    XcdBarrier b; b.bar = bar; b.x = xb_xcc_id(); b.st = st;
    if (threadIdx.x == 0) (void)xb_add(&bar[XB_XCNT(b.x)], 1u);
    return b;
}
__device__ __forceinline__ void xcd_barrier_complete(unsigned* bar, unsigned x, unsigned& nloc, unsigned& nx) {
    const unsigned G = gridDim.x * gridDim.y * gridDim.z;
    unsigned sum, cnt, mine, sp = 0u;
    for (;;) {
        sum = 0u; cnt = 0u; mine = 0u;
#pragma unroll
        for (unsigned j = 0; j < 16; ++j) { const unsigned c = xb_ld(&bar[XB_XCNT(j)]); sum += c; cnt += (c > 0u) ? 1u : 0u; mine = (j == x) ? c : mine; }
        if (sum == G) break;
        __builtin_amdgcn_s_sleep(1);
        if ((++sp & 255u) == 0u) { if (xb_ld(&bar[XB_TMO])) break; if (sp > XB_SPIN_CAP) { atomicAdd(&bar[XB_TMO], 1u); break; } }
    }
    nloc = mine > 0u ? mine : 1u; nx = cnt > 0u ? cnt : 1u;
}
__device__ __forceinline__ void xcd_barrier(const XcdBarrier& b) {
    asm volatile("s_waitcnt vmcnt(0)" ::: "memory");
    __syncthreads();
    if (threadIdx.x == 0) {
        unsigned* bar = b.bar;
        __builtin_amdgcn_s_waitcnt(0);
        unsigned nloc = b.st[0], nx = b.st[1];
        if (nloc == 0u) { xcd_barrier_complete(bar, b.x, nloc, nx); b.st[0] = nloc; b.st[1] = nx; }
        const unsigned old = xb_add(&bar[XB_XSUB(b.x)], 1u);
        const unsigned gen = old / nloc;
        if (old + 1u == (gen + 1u) * nloc) {
            __builtin_amdgcn_fence(__ATOMIC_RELEASE, "agent");
            asm volatile("s_waitcnt vmcnt(0)" ::: "memory");
            const unsigned og = xb_add(&bar[XB_TOP], 1u);
            const unsigned tg = og / nx;
            if (og + 1u == (tg + 1u) * nx) xb_add(&bar[XB_TOPGEN], 1u);
            else XB_SPIN(xb_ld(&bar[XB_TOPGEN]) == tg, bar);
            __builtin_amdgcn_fence(__ATOMIC_ACQUIRE, "agent");
            xb_add(&bar[XB_XGEN(b.x)], 1u);
            asm volatile("s_waitcnt vmcnt(0)" ::: "memory");
        } else {
            XB_SPIN(xb_ld(&bar[XB_XGEN(b.x)]) == gen, bar);
            __builtin_amdgcn_fence(__ATOMIC_ACQUIRE, "agent");
            asm volatile("s_waitcnt vmcnt(0)" ::: "memory");
        }
    }
    __syncthreads();
}

struct Args { const float* in[24]; float* out; unsigned char* ws; int ph_lo, ph_hi; };
struct Frame {
    LAS unsigned char* lds;
    int tid, lane, wave, vcu, G;
    const float* const* in; float* out; unsigned char* ws;
};
#define IN_X 0
#define IN_C 1
#define IN_CTX 2
#define IN_CCTX 3
#define IN_WADA 4
#define IN_BADA 5
#define IN_NMIX 6
#define IN_NMLP 7
#define IN_WIN 8
#define IN_WGKF 9
#define IN_BGKF 10
#define IN_WGKB 11
#define IN_BGKB 12
#define IN_GLANW 13
#define IN_WPOOL 14
#define IN_PSCALE 15
#define IN_WOUT 16
#define IN_WROUTER 17
#define IN_BROUTER 18
#define IN_WGU 19
#define IN_BGU 20
#define IN_WDOWN 21
#define IN_BDOWN 22
#define IN_FNW 23

__device__ __forceinline__ void p0_transpose_item(const float* W, int ldw, int k0, int n0, bf16_t* WT, int ldd, int drow, int dk0, LAS float* scr, int lane) {
#pragma unroll 8
    for (int i = 0; i < 32; ++i) { const int kk = 2 * i + (lane >> 5); scr[kk * 33 + (lane & 31)] = W[(size_t)(k0 + kk) * ldw + n0 + (lane & 31)]; }
    LDS_WAIT(); asm volatile("" ::: "memory");
    const int c = lane & 7;
#pragma unroll
    for (int j = 0; j < 4; ++j) { const int n = (lane >> 3) + 8 * j; const LAS float* s = scr + (8 * c) * 33 + n;
        u32x4 o; o.x = pk2(s[0 * 33], s[1 * 33]); o.y = pk2(s[2 * 33], s[3 * 33]); o.z = pk2(s[4 * 33], s[5 * 33]); o.w = pk2(s[6 * 33], s[7 * 33]);
        *(u32x4*)(WT + (size_t)(drow + n) * ldd + dk0 + k0 + 8 * c) = o; }
    LDS_WAIT(); asm volatile("" ::: "memory");
}
__device__ __forceinline__ int win_drow(int n0) {
    if (n0 < 256) return 4 * 256 + n0;
    if (n0 < 512) return n0 - 256;
    if (n0 < 1024) return 256 + (n0 - 512);
    if (n0 < 1536) return 5 * 256 + (n0 - 1024);
    if (n0 < 1568) return 3 * 256 + (n0 - 1536);
    return 7 * 256 + (n0 - 1568);
}
__device__ __forceinline__ void p0_mod_item(Frame& F, int item, const LAS float* SL, float* mod) {
    const float* w_ada = F.in[IN_WADA]; const float* b_ada = F.in[IN_BADA];
    const int j = item * 8 + (F.lane & 7), kp = F.lane >> 3;
    float acc[17];
#pragma unroll
    for (int r = 0; r < 17; ++r) acc[r] = 0.f;
#pragma unroll 4
    for (int i = 0; i < 128; ++i) { const int k = kp + 8 * i; const float w = w_ada[(size_t)k * NMOD + j];
#pragma unroll
        for (int r = 0; r < 17; ++r) acc[r] += SL[r * 1024 + k] * w; }
#pragma unroll
    for (int r = 0; r < 17; ++r) { float a = acc[r]; a += __shfl_xor(a, 8); a += __shfl_xor(a, 16); a += __shfl_xor(a, 32); if (kp == 0) mod[r * NMOD + j] = a + b_ada[j]; }
}
__device__ __forceinline__ void p0_weff_item(Frame& F, int item, LAS float* scr, bf16_t* Wout_t) {
    const float* w_pool = F.in[IN_WPOOL]; const float* pscale = F.in[IN_PSCALE]; const float* w_out = F.in[IN_WOUT];
    const int g = item >> 6, n0 = (item & 63) * 16, lane = F.lane;
#pragma unroll 4
    for (int q = 0; q < 32; ++q) { const int idx = lane + 64 * q, j = idx >> 4, nn = idx & 15; scr[idx] = w_out[(size_t)(512 + g * 128 + j) * D + n0 + nn] * pscale[g * 128 + j]; }
    LDS_WAIT(); asm volatile("" ::: "memory");
    float a0[16], a1[16];
#pragma unroll
    for (int nn = 0; nn < 16; ++nn) { a0[nn] = 0.f; a1[nn] = 0.f; }
    const float* wp0 = w_pool + (size_t)(g * 128 + lane) * 128; const float* wp1 = wp0 + 64 * 128;
    for (int j = 0; j < 128; ++j) { const float p0 = wp0[j], p1 = wp1[j];
#pragma unroll
        for (int q = 0; q < 4; ++q) { const f32x4 t = *(const LAS f32x4*)(scr + j * 16 + 4 * q);
#pragma unroll
            for (int z = 0; z < 4; ++z) { a0[4 * q + z] += p0 * t[z]; a1[4 * q + z] += p1 * t[z]; } } }
#pragma unroll
    for (int nn = 0; nn < 16; ++nn) { bf16_t* o = Wout_t + (size_t)(n0 + nn) * D + 512 + g * 128 + lane; o[0] = (bf16_t)f2bf(a0[nn]); o[64] = (bf16_t)f2bf(a1[nn]); }
    LDS_WAIT(); asm volatile("" ::: "memory");
}
constexpr int P0_CVT_E = 0;
constexpr float WSCALE = 32.f;
constexpr int CVP = 260;
__device__ __forceinline__ unsigned pk4_fp8s(float a, float b, float c, float d) { int w = 0; w = __builtin_amdgcn_cvt_pk_fp8_f32(a * WSCALE, b * WSCALE, w, false); w = __builtin_amdgcn_cvt_pk_fp8_f32(c * WSCALE, d * WSCALE, w, true); return (unsigned)w; }
struct CvtItem { const float* src; int ldw, k0, n0, e; bool gu; };
__device__ __forceinline__ CvtItem cvt_decode(Frame& F, int item) {
    CvtItem c;
    if (item < 2048) { c.gu = true; c.e = item >> 6; c.k0 = ((item >> 3) & 7) * 128; c.n0 = (item & 7) * 256; c.src = F.in[IN_WGU] + (size_t)c.e * D * 2048; c.ldw = 2048; }
    else { const int r = item - 2048 + P0_CVT_E * 32; c.gu = false; c.e = r >> 5; c.k0 = ((r >> 2) & 7) * 128; c.n0 = (r & 3) * 256; c.src = F.in[IN_WDOWN] + (size_t)c.e * DFF * D; c.ldw = D; }
    return c;
}
template <int MODE>
__device__ __forceinline__ void cvt_expert_items(Frame& F, int first, int stride, int nitems) {
    if (first >= nitems) return;
    LAS float* T = (LAS float*)F.lds;
    int tid = F.tid; asm volatile("" : "+v"(tid));
    f32x4 R[16];
    { const CvtItem c = cvt_decode(F, first);
#pragma unroll
      for (int i = 0; i < 16; ++i) { const int idx = tid + NTHR * i, kk = idx >> 6, n4 = idx & 63; R[i] = __builtin_nontemporal_load((const f32x4*)(c.src + (size_t)(c.k0 + kk) * c.ldw + c.n0 + 4 * n4)); } }
    for (int item = first; item < nitems; item += stride) {
        const CvtItem c = cvt_decode(F, item);
#pragma unroll
        for (int i = 0; i < 16; ++i) { const int idx = tid + NTHR * i, kk = idx >> 6, n4 = idx & 63; *(LAS f32x4*)(T + kk * CVP + 4 * n4) = R[i]; }
        __syncthreads();
        if (MODE != 1 && item + stride < nitems) { const CvtItem cn = cvt_decode(F, item + stride);
#pragma unroll
            for (int i = 0; i < 16; ++i) { const int idx = tid + NTHR * i, kk = idx >> 6, n4 = idx & 63; R[i] = __builtin_nontemporal_load((const f32x4*)(cn.src + (size_t)(cn.k0 + kk) * cn.ldw + cn.n0 + 4 * n4)); } }
        u32x4 o[4];
        { const int n = F.wave * 32 + (F.lane & 31), half = F.lane >> 5;
          const LAS float* col = T + (64 * half) * CVP + n;
#pragma unroll
          for (int q = 0; q < 4; ++q) { unsigned w4[4];
#pragma unroll
              for (int z = 0; z < 4; ++z) { const LAS float* p = col + (16 * q + 4 * z) * CVP; w4[z] = pk4_fp8s(p[0], p[CVP], p[2 * CVP], p[3 * CVP]); }
              o[q] = (u32x4){w4[0], w4[1], w4[2], w4[3]}; }
          __syncthreads();
          LAS unsigned char* OUTL = (LAS unsigned char*)F.lds;
#pragma unroll
          for (int q = 0; q < 4; ++q) *(LAS u32x4*)(OUTL + n * 144 + half * 64 + q * 16) = o[q]; }
        __syncthreads();
#pragma unroll
        for (int i = 0; i < 4; ++i) { const int idx = tid + NTHR * i, n = idx >> 3, ch = idx & 7;
            const u32x4 v = *(const LAS u32x4*)((const LAS unsigned char*)F.lds + n * 144 + ch * 16);
            size_t drow;
            if (c.gu) { const int jn = (c.n0 + n) & 1023; drow = (size_t)c.e * 2048 + (jn >> 7) * 256 + ((c.n0 + n) >= 1024 ? 128 : 0) + (jn & 127); }
            else drow = (size_t)c.e * D + c.n0 + n;
            if (MODE != 2 || v.x == 0x12345678u) *(u32x4*)((unsigned char*)(F.ws + (c.gu ? WS_WGU : WS_WD)) + drow * 1024 + c.k0 + ch * 16) = v; }
        __syncthreads();
    }
}

constexpr int CVH = 64 * CVP * 4;
__device__ __forceinline__ void cvt_dma_issue(Frame& F, int first, int stride, int t) {
    const CvtItem c = cvt_decode(F, first + (t >> 1) * stride); const int half = t & 1;
    LAS unsigned char* buf = F.lds + (t & 1) * CVH;
#pragma unroll
    for (int i = 0; i < 8; ++i) { const int row = 8 * F.wave + i;
        __builtin_amdgcn_global_load_lds((const unsigned*)(c.src + (size_t)(c.k0 + 64 * half + row) * c.ldw + c.n0 + 4 * F.lane), (LAS unsigned*)(buf + row * (CVP * 4)), 16, 0, 2); }
}
#define CVT_LW() asm volatile("s_waitcnt lgkmcnt(0)" ::: "memory")
#define CVT_BAR() do { __builtin_amdgcn_s_barrier(); asm volatile("" ::: "memory"); } while (0)
__device__ __forceinline__ void cvt_expert_items_dma(Frame& F, int first, int stride, int nitems) {
    if (first >= nitems) return;
    const int nh = 2 * ((nitems - first + stride - 1) / stride);
    int tid = F.tid; asm volatile("" : "+v"(tid));
    cvt_dma_issue(F, first, stride, 0); cvt_dma_issue(F, first, stride, 1);
    for (int t = 0; t < nh; ++t) {
        const CvtItem c = cvt_decode(F, first + (t >> 1) * stride); const int half = t & 1;
        LAS unsigned char* buf = F.lds + (t & 1) * CVH; const LAS float* T = (const LAS float*)buf;
        if (t + 1 < nh) asm volatile("s_waitcnt vmcnt(8)" ::: "memory"); else asm volatile("s_waitcnt vmcnt(0)" ::: "memory");
        CVT_BAR();
        u32x4 o0, o1;
        { const int n = F.wave * 32 + (F.lane & 31), kq = F.lane >> 5;
          const LAS float* col = T + (32 * kq) * CVP + n; unsigned w8[8];
#pragma unroll
          for (int z = 0; z < 8; ++z) { const LAS float* p = col + (4 * z) * CVP; w8[z] = pk4_fp8s(p[0], p[CVP], p[2 * CVP], p[3 * CVP]); }
          o0 = (u32x4){w8[0], w8[1], w8[2], w8[3]}; o1 = (u32x4){w8[4], w8[5], w8[6], w8[7]};
          CVT_LW(); CVT_BAR();
          *(LAS u32x4*)(buf + n * 80 + kq * 32) = o0; *(LAS u32x4*)(buf + n * 80 + kq * 32 + 16) = o1; }
        CVT_LW(); CVT_BAR();
#pragma unroll
        for (int i = 0; i < 2; ++i) { const int idx = tid + NTHR * i, n = idx >> 2, ch = idx & 3;
            const u32x4 v = *(const LAS u32x4*)(buf + n * 80 + ch * 16);
            size_t drow;
            if (c.gu) { const int jn = (c.n0 + n) & 1023; drow = (size_t)c.e * 2048 + (jn >> 7) * 256 + ((c.n0 + n) >= 1024 ? 128 : 0) + (jn & 127); }
            else drow = (size_t)c.e * D + c.n0 + n;
            *(u32x4*)((unsigned char*)(F.ws + (c.gu ? WS_WGU : WS_WD)) + drow * 1024 + c.k0 + 64 * half + ch * 16) = v; }
        CVT_LW(); CVT_BAR();
        if (t + 2 < nh) cvt_dma_issue(F, first, stride, t + 2);
    }
}
#undef CVT_LW
#undef CVT_BAR


__device__ __forceinline__ void p0_prologue(Frame& F, bool do_experts) {
    { bf16_t* WRT = (bf16_t*)(F.ws + WS_WRT); const float* wr = F.in[IN_WROUTER];
      for (int idx = F.vcu * NTHR + F.tid; idx < D * NE; idx += F.G * NTHR) { const int k = idx >> 5, e = idx & 31; const float v = wr[idx]; const unsigned hi = f2bf(v);
          WRT[e * D + k] = (bf16_t)hi; WRT[NE * D + e * D + k] = (bf16_t)f2bf(v - bf2f(hi)); } }
    LAS float* SL = (LAS float*)F.lds;
    for (int idx = F.tid; idx < 17 * 1024; idx += NTHR) { const int r = idx >> 10, k = idx & 1023; const float v = r < NB ? F.in[IN_C][r * D + k] : F.in[IN_CCTX][k]; SL[idx] = silu_f(v); }
    __syncthreads();
    LAS float* scr = (LAS float*)(F.lds + 69632 + F.wave * 8448);
    bf16_t* Win_t = (bf16_t*)(F.ws + WS_WIN); bf16_t* Wout_t = (bf16_t*)(F.ws + WS_WOUT); bf16_t* Wgu_t = (bf16_t*)(F.ws + WS_WGU); bf16_t* Wd_t = (bf16_t*)(F.ws + WS_WD);
    float* mod = (float*)(F.ws + WS_MOD);
    constexpr int I_MOD = NMOD / 8, I_WEFF = 4 * 64, I_WIN = 16 * (DIN / 32), I_ZERO = 224, I_WOUT = 8 * 32, I_GU = NE * 16 * 64, I_DN = NE * 16 * 32;
    const int nitems = I_MOD + I_WEFF + I_WIN + I_ZERO + I_WOUT + (do_experts ? I_GU + I_DN : 0);
    const int gw = F.wave * F.G + F.vcu, NGW = F.G * NWAVES;
    for (int it = gw; it < nitems; it += NGW) {
        int r = it;
        if (r < I_MOD) { p0_mod_item(F, r, SL, mod); continue; } r -= I_MOD;
        if (r < I_WEFF) { p0_weff_item(F, r, scr, Wout_t); continue; } r -= I_WEFF;
        if (r < I_WIN) { const int kb = r / (DIN / 32), nb = r % (DIN / 32); p0_transpose_item(F.in[IN_WIN], DIN, 64 * kb, 32 * nb, Win_t, D, win_drow(32 * nb), 0, scr, F.lane); continue; } r -= I_WIN;
        if (r < I_ZERO) { u32x4* o = (u32x4*)(Win_t + (size_t)(3 * 256 + 32 + r) * D) + F.lane * 2; o[0] = (u32x4){0u, 0u, 0u, 0u}; o[1] = (u32x4){0u, 0u, 0u, 0u}; continue; } r -= I_ZERO;
        if (r < I_WOUT) { const int kb = r / 32, nb = r % 32; p0_transpose_item(F.in[IN_WOUT], D, 64 * kb, 32 * nb, Wout_t, D, 32 * nb, 0, scr, F.lane); continue; } r -= I_WOUT;
        if (r < I_GU) { const int e = r / (16 * 64), q = r % (16 * 64), kb = q / 64, nb = q % 64, n0 = 32 * nb, jn = n0 & 1023;
            const int drow = e * 2048 + (jn >> 7) * 256 + (n0 >= 1024 ? 128 : 0) + (jn & 127);
            p0_transpose_item(F.in[IN_WGU] + (size_t)e * D * 2048, 2048, 64 * kb, n0, Wgu_t, D, drow, 0, scr, F.lane); continue; } r -= I_GU;
        { const int e = r / (16 * 32), q = r % (16 * 32), kb = q / 32, nb = q % 32;
            p0_transpose_item(F.in[IN_WDOWN] + (size_t)e * DFF * D, D, 64 * kb, 32 * nb, Wd_t, DFF, e * D + 32 * nb, 0, scr, F.lane); }
    }}

__device__ __forceinline__ void norm_row_bf16(const float* src, const float* wn, const float* sh, const float* sc, bf16_t* dst, int lane) {
    const f32x4* xr = (const f32x4*)src + lane;
    f32x4 v[4]; float s = 0.f;
#pragma unroll
    for (int j = 0; j < 4; ++j) { v[j] = xr[64 * j]; s += (v[j].x * v[j].x + v[j].y * v[j].y) + (v[j].z * v[j].z + v[j].w * v[j].w); }
    const float rstd = rsqrtf(wave_sum(s) * (1.f / D) + EPS);
    u32x2* o8 = (u32x2*)dst + lane;
#pragma unroll
    for (int j = 0; j < 4; ++j) { const f32x4 w = ((const f32x4*)wn)[lane + 64 * j], a = ((const f32x4*)sc)[lane + 64 * j], b = ((const f32x4*)sh)[lane + 64 * j];
        const f32x4 y = v[j] * rstd * w * (a + 1.f) + b; u32x2 p; p.x = pk2(y.x, y.y); p.y = pk2(y.z, y.w); o8[64 * j] = p; }
}
__device__ __forceinline__ void p1_norm1(Frame& F) {
    const float* mod = (const float*)(F.ws + WS_MOD); bf16_t* HN = (bf16_t*)(F.ws + WS_HN1);
    constexpr int RPB = NROW / 256;
    for (int blk = F.vcu; blk < 256; blk += F.G)
        for (int r = F.wave; r < RPB; r += NWAVES) { const int row = blk * RPB + r;
            const float* src = row < NTOK ? F.in[IN_X] + (size_t)row * D : F.in[IN_CTX] + (size_t)(row - NTOK) * D;
            const float* mr = mod + (size_t)(row < NTOK ? row / SEQ : NB) * NMOD;
            norm_row_bf16(src, F.in[IN_NMIX], mr, mr + 1024, HN + (size_t)row * D, F.lane); }
}

typedef __bf16 bf16x2n __attribute__((ext_vector_type(2)));
__device__ __forceinline__ unsigned pkbf(float lo, float hi) { f32x2 v = {lo, hi}; return __builtin_bit_cast(unsigned, __builtin_convertvector(v, bf16x2n)); }
#define MFMA32(a, b, c) __builtin_amdgcn_mfma_f32_32x32x16_bf16((a), (b), (c), 0, 0, 0)
constexpr int GP = 72;
constexpr int GL_QP = 0, GL_KP = 9216, GL_QQ = 18432, GL_KKT = 27648, GL_VT = 36864, GL_DEC = 55296, GL_GSUM = 55552, GL_R = 57600, GL_END = 61696;

__device__ __forceinline__ bf16x8 pack8(const f32x16& x, int s) {
    u32x4 p; p.x = pkbf(x[8 * s + 0], x[8 * s + 1]); p.y = pkbf(x[8 * s + 2], x[8 * s + 3]); p.z = pkbf(x[8 * s + 4], x[8 * s + 5]); p.w = pkbf(x[8 * s + 6], x[8 * s + 7]);
    return __builtin_bit_cast(bf16x8, p);
}
__device__ __forceinline__ bf16x8 ld_perm8(const LAS bf16_t* p) {
    const u32x2 a = *(const LAS u32x2*)p, b = *(const LAS u32x2*)(p + 8); u32x4 r; r.x = a.x; r.y = a.y; r.z = b.x; r.w = b.y; return __builtin_bit_cast(bf16x8, r);
}
__device__ __forceinline__ bf16x8 ld_nat8(const LAS bf16_t* p) { return *(const LAS bf16x8*)p; }

template <int GM>
__device__ __forceinline__ void gla_unit(Frame& F, const int unit) {
    const int b = unit >> 3, h = (unit >> 1) & 3, dir = unit & 1;
    const int w = F.wave, lane = F.lane, tid = F.tid;
    LAS unsigned char* L = F.lds;
    LAS bf16_t* QP = (LAS bf16_t*)(L + GL_QP); LAS bf16_t* KP = (LAS bf16_t*)(L + GL_KP); LAS bf16_t* QQ = (LAS bf16_t*)(L + GL_QQ);
    LAS bf16_t* KKT = (LAS bf16_t*)(L + GL_KKT); LAS bf16_t* VT = (LAS bf16_t*)(L + GL_VT);
    LAS float* DEC = (LAS float*)(L + GL_DEC); LAS float* GSUM = (LAS float*)(L + GL_GSUM); LAS float* RL = (LAS float*)(L + GL_R);
    const bf16_t* QB = (const bf16_t*)(F.ws + WS_QB); const bf16_t* KB = (const bf16_t*)(F.ws + WS_KB); const bf16_t* VB = (const bf16_t*)(F.ws + WS_VB);
    const float* RB = (const float*)(F.ws + WS_RB);
    bf16_t* OD = (bf16_t*)(F.ws + (GM >= 3 ? (dir ? 870 * MiB : 830 * MiB) : (dir ? WS_OB : WS_OF)));
    const float* wgk = F.in[dir ? IN_WGKB : IN_WGKF]; const float* bgk = F.in[dir ? IN_BGKB : IN_BGKF];
    float wg[16];
#pragma unroll
    for (int j = 0; j < 16; ++j) wg[j] = wgk[j * 256 + h * 64 + lane];
    const float bg = bgk[h * 64 + lane];
    f32x16 S0, S1;
#pragma unroll
    for (int i = 0; i < 16; ++i) { S0[i] = 0.f; S1[i] = 0.f; }
    const int tb = w >> 2, vb = w & 3, c = lane & 31, hh = lane >> 5;
    const int vs = tid >> 3, vc = tid & 7;
    unsigned pq[8], pk[8]; u32x4 pv0, pv1; f32x2 pr;
#define GLA_LOAD(step) do { const int _s = (step); const bool _ctx = _s < 4; const int _ci = _ctx ? _s : _s - 4; const int _ch = dir ? ((_ctx ? 3 : 31) - _ci) : _ci; \
        const int _row0 = _ctx ? NTOK + b * CTX + _ch * 64 : b * SEQ + _ch * 64; \
        _Pragma("unroll") for (int _i = 0; _i < 8; ++_i) { const int _t = 8 * w + _i; const size_t _row = (size_t)(_row0 + (dir ? 63 - _t : _t)); \
            pk[_i] = KB[_row * 256 + h * 64 + lane]; pq[_i] = _ctx ? 0u : (unsigned)QB[_row * 256 + h * 64 + lane]; } \
        { const size_t _row = (size_t)(_row0 + (dir ? 63 - vs : vs)); const u32x4* _vp = (const u32x4*)(VB + _row * 512 + h * 128 + vc * 16); pv0 = _vp[0]; pv1 = _vp[1]; \
          pr = *(const f32x2*)(RB + _row * 32 + dir * 16 + vc * 2); } } while (0)
    GLA_LOAD(0);
    for (int step = 0; step < 36; ++step) {
        const bool isctx = step < 4; const int ci = isctx ? step : step - 4; const int chunk = dir ? ((isctx ? 3 : 31) - ci) : ci;
        const int row0 = isctx ? NTOK + b * CTX + chunk * 64 : b * SEQ + chunk * 64;
        unsigned cq[8], ck[8]; u32x4 cv0 = pv0, cv1 = pv1;
#pragma unroll
        for (int i = 0; i < 8; ++i) { cq[i] = pq[i]; ck[i] = pk[i]; }
        *(LAS f32x2*)(RL + vs * 16 + vc * 2) = pr;
        __syncthreads();
        float cs[8];
        { float run = 0.f;
#pragma unroll
          for (int i = 0; i < 8; ++i) { const LAS f32x4* rp = (const LAS f32x4*)(RL + (8 * w + i) * 16); float x = bg;
#pragma unroll
              for (int q4 = 0; q4 < ((GM == 3) ? 1 : 4); ++q4) { const f32x4 rv = rp[q4]; x += rv[0] * wg[4 * q4 + 0] + rv[1] * wg[4 * q4 + 1] + rv[2] * wg[4 * q4 + 2] + rv[3] * wg[4 * q4 + 3]; }
              const float gk = (GM == 3) ? x * 1e-3f : (fminf(x, 0.f) - __logf(1.f + __expf(-fabsf(x)))) * (1.f / 16.f); run += gk; cs[i] = run; }
          GSUM[w * 64 + lane] = run; }
        __syncthreads();
        { float pre = 0.f, mid = 0.f, tot = 0.f;
#pragma unroll
          for (int g = 0; g < 8; ++g) { const float gsum = GSUM[g * 64 + lane]; if (g < w) pre += gsum; if (g < 4) mid += gsum; tot += gsum; }
          if (w == 0) DEC[lane] = __expf(tot);
          const float em = __expf(mid), etm = __expf(tot - mid);
          u32x4 kk4;
          float kkf[8];
#pragma unroll
          for (int i = 0; i < ((GM == 4) ? 1 : 8); ++i) { const int t = 8 * w + i; const float bc = pre + cs[i]; const float kv = bf2f(ck[i]);
              const float e2 = __expf(mid - bc); kkf[i] = kv * (e2 * etm);
              if (!isctx) { const float qv = bf2f(cq[i]) * 0.125f; const float e1 = __expf(bc - mid), e3 = e1 * em;
                  const unsigned w1 = pkbf(qv * e1, kv * e2), w2 = pkbf(qv * e3, 0.f);
                  QP[t * GP + lane] = (bf16_t)(w1 & 0xffffu); KP[t * GP + lane] = (bf16_t)(w1 >> 16); QQ[t * GP + lane] = (bf16_t)(w2 & 0xffffu); } }
          kk4.x = pkbf(kkf[0], kkf[1]); kk4.y = pkbf(kkf[2], kkf[3]); kk4.z = pkbf(kkf[4], kkf[5]); kk4.w = pkbf(kkf[6], kkf[7]);
          *(LAS u32x4*)(KKT + lane * GP + 8 * w) = kk4;
          const unsigned vw[8] = {cv0.x, cv0.y, cv0.z, cv0.w, cv1.x, cv1.y, cv1.z, cv1.w};
#pragma unroll
          for (int e = 0; e < ((GM == 4) ? 1 : 8); ++e) { VT[(vc * 16 + 2 * e) * GP + vs] = (bf16_t)(vw[e] & 0xffffu); VT[(vc * 16 + 2 * e + 1) * GP + vs] = (bf16_t)(vw[e] >> 16); } }
        if (step + 1 < 36) GLA_LOAD(step + 1);
        __syncthreads();
        if (!isctx && GM != 1) {
            f32x16 O;
#pragma unroll
            for (int i = 0; i < 16; ++i) O[i] = 0.f;
#pragma unroll
            for (int s = 0; s < 2; ++s) { O = MFMA32(ld_perm8(QQ + (32 * tb + c) * GP + 16 * s + 4 * hh), pack8(S0, s), O);
                                          O = MFMA32(ld_perm8(QQ + (32 * tb + c) * GP + 32 + 16 * s + 4 * hh), pack8(S1, s), O); }
#pragma unroll
            for (int sb = 0; sb < 2; ++sb) { if (sb > tb) continue;
                f32x16 X;
#pragma unroll
                for (int i = 0; i < 16; ++i) X[i] = 0.f;
#pragma unroll
                for (int s = 0; s < 4; ++s) X = MFMA32(ld_nat8(KP + (32 * sb + c) * GP + 16 * s + 8 * hh), ld_nat8(QP + (32 * tb + c) * GP + 16 * s + 8 * hh), X);
                if (sb == tb) {
#pragma unroll
                    for (int r = 0; r < 16; ++r) { const int sl = (r & 3) + 8 * (r >> 2) + 4 * hh; X[r] = (sl <= c) ? X[r] : 0.f; } }
#pragma unroll
                for (int s = 0; s < 2; ++s) O = MFMA32(pack8(X, s), ld_perm8(VT + (32 * vb + c) * GP + 32 * sb + 16 * s + 4 * hh), O);
            }
#pragma unroll
            for (int r = 0; r < ((GM == 2) ? 1 : 16); ++r) { const int t = 32 * tb + (r & 3) + 8 * (r >> 2) + 4 * hh; const size_t row = (size_t)(row0 + (dir ? 63 - t : t));
                OD[row * 512 + h * 128 + 32 * vb + c] = (bf16_t)(pkbf(O[r], 0.f) & 0xffffu); }
        }
        if (GM != 1) {
#pragma unroll
            for (int g4 = 0; g4 < 4; ++g4) { const f32x4 d0 = *(const LAS f32x4*)(DEC + 8 * g4 + 4 * hh), d1 = *(const LAS f32x4*)(DEC + 32 + 8 * g4 + 4 * hh);
#pragma unroll
                for (int z = 0; z < 4; ++z) { S0[4 * g4 + z] *= d0[z]; S1[4 * g4 + z] *= d1[z]; } }
#pragma unroll
            for (int s = 0; s < 4; ++s) { const bf16x8 vf = ld_nat8(VT + (32 * vb + c) * GP + 16 * s + 8 * hh);
                S0 = MFMA32(ld_nat8(KKT + c * GP + 16 * s + 8 * hh), vf, S0);
                S1 = MFMA32(ld_nat8(KKT + (32 + c) * GP + 16 * s + 8 * hh), vf, S1); }
        }
    }
#undef GLA_LOAD
    __syncthreads();
}

constexpr int PRS = 72 * 2;
__device__ __forceinline__ int pslot(int x) { return 2 * (x + (x >> 3)); }
template <int G_>
__device__ __forceinline__ void pool_unit_g(Frame& F, const int cblk, const int b) {
    constexpr int g = G_, wdw = 2 << g, lo = wdw >> 1, hi = wdw - 1 - lo;
    LAS f32x4* X = (LAS f32x4*)F.lds;
    LAS f32x4* H = (LAS f32x4*)(F.lds + 73728);
    const bf16_t* PB = (const bf16_t*)(F.ws + WS_PB) + ((size_t)((b * 4 + g) * 16 + cblk) * 2048) * 8;
    bf16_t* MIX = (bf16_t*)(F.ws + WS_MIX);
    int tid = F.tid; asm volatile("" : "+v"(tid));
#pragma unroll
    for (int i = 0; i < 4; ++i) { const int tok = tid + 512 * i, r = tok >> 6, x = tok & 63; const u32x4 v = *(const u32x4*)(PB + (size_t)tok * 8);
        LAS f32x4* p = X + r * PRS + pslot(x);
        p[0] = (f32x4){bflo(v.x), bfhi(v.x), bflo(v.y), bfhi(v.y)}; p[1] = (f32x4){bflo(v.z), bfhi(v.z), bflo(v.w), bfhi(v.w)}; }
    __syncthreads();
    { const int q = tid & 1, cs = (tid >> 1) & 7, r = tid >> 4; const LAS f32x4* xr = X + r * PRS + q; LAS f32x4* hr = H + r * PRS + q;
      const int c0 = 8 * cs; f32x4 s = {0.f, 0.f, 0.f, 0.f};
#pragma unroll
      for (int d = -lo; d <= hi; ++d) { const int x = c0 + d; const bool ok = (x >= 0) && (x < GW); const int xc = x < 0 ? 0 : (x > GW - 1 ? GW - 1 : x); const f32x4 v = xr[pslot(xc)]; s += ok ? v : (f32x4){0.f, 0.f, 0.f, 0.f}; if (((d + lo) & 3) == 3) asm volatile("" ::: "memory"); }
      hr[pslot(c0)] = s;
#pragma unroll
      for (int j = 1; j < 8; ++j) { const int xin = c0 + j + hi, xout = c0 + j - 1 - lo; const bool oki = xin < GW, oko = xout >= 0;
          const f32x4 vi = xr[pslot(oki ? xin : GW - 1)], vo = xr[pslot(oko ? xout : 0)];
          s += oki ? vi : (f32x4){0.f, 0.f, 0.f, 0.f}; s -= oko ? vo : (f32x4){0.f, 0.f, 0.f, 0.f}; hr[pslot(c0 + j)] = s; } }
    __syncthreads();
    { const int q = tid & 1, cc = (tid >> 1) & 63, rs = tid >> 7; const int col = pslot(cc) + q; const int r0s = 8 * rs;
      const int c0 = max(cc - lo, 0), c1 = min(cc + hi + 1, GW); const float ncol = (float)(c1 - c0);
      f32x4 s = {0.f, 0.f, 0.f, 0.f};
#pragma unroll
      for (int d = -lo; d <= hi; ++d) { const int y = r0s + d; const bool ok = (y >= 0) && (y < GROWS); const int yc = y < 0 ? 0 : (y > GROWS - 1 ? GROWS - 1 : y); const f32x4 v = H[yc * PRS + col]; s += ok ? v : (f32x4){0.f, 0.f, 0.f, 0.f}; if (((d + lo) & 3) == 3) asm volatile("" ::: "memory"); }
#pragma unroll
      for (int j = 0; j < 8; ++j) { const int r = r0s + j;
          if (j > 0) { const int yin = r + hi, yout = r - 1 - lo; const bool oki = yin < GROWS, oko = yout >= 0;
              const f32x4 vi = H[(oki ? yin : GROWS - 1) * PRS + col], vo = H[(oko ? yout : 0) * PRS + col];
              s += oki ? vi : (f32x4){0.f, 0.f, 0.f, 0.f}; s -= oko ? vo : (f32x4){0.f, 0.f, 0.f, 0.f}; }
          const int ra = max(r - lo, 0), rb = min(r + hi + 1, GROWS);
          const float inv = 1.f / ((float)(rb - ra) * ncol);
          const f32x4 o = s * inv - X[r * PRS + col];
          u32x2 pw; pw.x = pkbf(o[0], o[1]); pw.y = pkbf(o[2], o[3]);
          *(u32x2*)(MIX + (size_t)(b * SEQ + r * GW + cc) * D + 512 + g * 128 + cblk * 8 + q * 4) = pw; } }
    __syncthreads();
}
__device__ __forceinline__ void pool_unit(Frame& F, const int unit) {
    const int g = unit & 3, cblk = (unit >> 2) & 15, b = unit >> 6;
    if (g == 0) pool_unit_g<0>(F, cblk, b); else if (g == 1) pool_unit_g<1>(F, cblk, b); else if (g == 2) pool_unit_g<2>(F, cblk, b); else pool_unit_g<3>(F, cblk, b);
}

__device__ __forceinline__ void p4_gla_out(Frame& F) {
    const bf16_t* OFp = (const bf16_t*)(F.ws + WS_OF); const bf16_t* OBp = (const bf16_t*)(F.ws + WS_OB); const bf16_t* GB = (const bf16_t*)(F.ws + WS_GB);
    bf16_t* MIX = (bf16_t*)(F.ws + WS_MIX); const float* wn = F.in[IN_GLANW];
    const int lane = F.lane, gw = F.vcu * NWAVES + F.wave, NGW = F.G * NWAVES;
    const f32x4 w0 = *(const f32x4*)(wn + (lane & 15) * 8), w1 = *(const f32x4*)(wn + (lane & 15) * 8 + 4);
    for (int tok = gw; tok < NTOK; tok += NGW) {
        const u32x4 fa = *((const u32x4*)(OFp + (size_t)tok * 512) + lane), fb = *((const u32x4*)(OBp + (size_t)tok * 512) + lane);
        const f32x4 o0 = (f32x4){bflo(fa.x) + bflo(fb.x), bfhi(fa.x) + bfhi(fb.x), bflo(fa.y) + bflo(fb.y), bfhi(fa.y) + bfhi(fb.y)};
        const f32x4 o1 = (f32x4){bflo(fa.z) + bflo(fb.z), bfhi(fa.z) + bfhi(fb.z), bflo(fa.w) + bflo(fb.w), bfhi(fa.w) + bfhi(fb.w)};
        const u32x4 gv = *((const u32x4*)(GB + (size_t)tok * 512) + lane);
        float ss = (o0[0] * o0[0] + o0[1] * o0[1]) + (o0[2] * o0[2] + o0[3] * o0[3]) + (o1[0] * o1[0] + o1[1] * o1[1]) + (o1[2] * o1[2] + o1[3] * o1[3]);
        ss += __shfl_xor(ss, 1); ss += __shfl_xor(ss, 2); ss += __shfl_xor(ss, 4); ss += __shfl_xor(ss, 8);
        const float rstd = rsqrtf(ss * (1.f / 128.f) + EPS);
        const float gg[8] = {bflo(gv.x), bfhi(gv.x), bflo(gv.y), bfhi(gv.y), bflo(gv.z), bfhi(gv.z), bflo(gv.w), bfhi(gv.w)};
        float y[8];
#pragma unroll
        for (int j = 0; j < 4; ++j) { y[j] = o0[j] * rstd * w0[j] * silu_f(gg[j]); y[4 + j] = o1[j] * rstd * w1[j] * silu_f(gg[4 + j]); }
        u32x4 pw; pw.x = pkbf(y[0], y[1]); pw.y = pkbf(y[2], y[3]); pw.z = pkbf(y[4], y[5]); pw.w = pkbf(y[6], y[7]);
        *((u32x4*)(MIX + (size_t)tok * D) + lane) = pw;
    }
}

constexpr int P6_AP = 1032;
constexpr int L6_AH = 0, L6_AL = 32 * P6_AP * 2, L6_LG = 2 * L6_AL;
constexpr int L6_REC = L6_LG + 128 * 33 * 4;
constexpr int L6_RED = 0;
static_assert(L6_REC + 4096 <= LDSCTL_OFF && 8 * 32 * 33 * 4 <= L6_LG, "P6 LDS map");
__device__ __forceinline__ void p6_router(Frame& F) {
    LAS bf16_t* AH = (LAS bf16_t*)(F.lds + L6_AH); LAS bf16_t* AL = (LAS bf16_t*)(F.lds + L6_AL); LAS float* LG = (LAS float*)(F.lds + L6_LG); LAS float* RED = (LAS float*)(F.lds + L6_RED);
    LAS unsigned* REC = (LAS unsigned*)(F.lds + L6_REC); LAS float* RECW = (LAS float*)(F.lds + L6_REC + 2048);
    LAS int* LCNT = (LAS int*)(F.lds + LDSCTL_OFF) + LC_CNT; LAS int* GBASE = LCNT + 32;
    const float* b_router = F.in[IN_BROUTER]; const float* wn = F.in[IN_NMLP];
    const float* mod = (const float*)(F.ws + WS_MOD); const float* h1 = F.out;
    unsigned char* HN2 = (unsigned char*)(F.ws + WS_HN2);
    int* gcnt = (int*)(F.ws + WS_CTL) + CW_CNT; int* list = (int*)(F.ws + WS_LIST); unsigned* ASG = (unsigned*)(F.ws + WS_ASG); float* TOPW = (float*)(F.ws + WS_TOPW);
    const int lane = F.lane, w = F.wave, tid = F.tid, c = lane & 31, hh = lane >> 5;
    bf16x8 bh[8], bl[8];
    { const bf16_t* WRT = (const bf16_t*)(F.ws + WS_WRT);
#pragma unroll
      for (int s = 0; s < 8; ++s) { bh[s] = *(const bf16x8*)(WRT + c * D + 128 * w + 16 * s + 8 * hh); bl[s] = *(const bf16x8*)(WRT + NE * D + c * D + 128 * w + 16 * s + 8 * hh); } }
    const f32x4 wn4[4] = {((const f32x4*)wn)[lane], ((const f32x4*)wn)[lane + 64], ((const f32x4*)wn)[lane + 128], ((const f32x4*)wn)[lane + 192]};
    for (int tblk = F.vcu; tblk < NTOK / 128; tblk += F.G) {
        if (tid < 32) LCNT[tid] = 0;
        const float* mrow = mod + (size_t)((tblk * 128) >> 11) * NMOD;
        f32x4 sc4[4], sh4[4];
#pragma unroll
        for (int j = 0; j < 4; ++j) { sc4[j] = ((const f32x4*)(mrow + 4096))[lane + 64 * j] + 1.f; sh4[j] = ((const f32x4*)(mrow + 3072))[lane + 64 * j]; }
        f32x4 hn[4];
        { const f32x4* xr = (const f32x4*)(h1 + (size_t)(tblk * 128 + 4 * w) * D) + lane;
#pragma unroll
          for (int j = 0; j < 4; ++j) hn[j] = xr[64 * j]; }
        for (int tile = 0; tile < 4; ++tile) {
#pragma unroll 1
            for (int q = 0; q < 4; ++q) { const int tl = 4 * w + q, tok = tblk * 128 + tile * 32 + tl;
                f32x4 hv[4]; float s = 0.f;
#pragma unroll
                for (int j = 0; j < 4; ++j) { hv[j] = hn[j]; s += (hv[j].x * hv[j].x + hv[j].y * hv[j].y) + (hv[j].z * hv[j].z + hv[j].w * hv[j].w); }
                { const int nq = tile * 4 + q + 1; if (nq < 16) { const int ntok = tblk * 128 + (nq >> 2) * 32 + 4 * w + (nq & 3); const f32x4* xr = (const f32x4*)(h1 + (size_t)ntok * D) + lane;
#pragma unroll
                    for (int j = 0; j < 4; ++j) hn[j] = xr[64 * j]; } }
                const float rstd = rsqrtf(wave_sum(s) * (1.f / D) + EPS);
                unsigned* o4 = (unsigned*)(HN2 + (size_t)tok * D) + lane;
#pragma unroll
                for (int j = 0; j < 4; ++j) { const f32x4 y = hv[j] * rstd * wn4[j] * sc4[j] + sh4[j];
                    o4[64 * j] = pg8::pk4_fp8(y.x, y.y, y.z, y.w);
                    u32x2 hi2; hi2.x = pkbf(y.x, y.y); hi2.y = pkbf(y.z, y.w);
                    u32x2 lo2; lo2.x = pkbf(y.x - bflo(hi2.x), y.y - bfhi(hi2.x)); lo2.y = pkbf(y.z - bflo(hi2.y), y.w - bfhi(hi2.y));
                    *(LAS u32x2*)(AH + tl * P6_AP + 4 * lane + 256 * j) = hi2; *(LAS u32x2*)(AL + tl * P6_AP + 4 * lane + 256 * j) = lo2; } }
            __syncthreads();
            f32x16 Dp;
#pragma unroll
            for (int i = 0; i < 16; ++i) Dp[i] = 0.f;
#pragma unroll
            for (int s = 0; s < 8; ++s) { const bf16x8 ah = *(const LAS bf16x8*)(AH + c * P6_AP + 128 * w + 16 * s + 8 * hh), al = *(const LAS bf16x8*)(AL + c * P6_AP + 128 * w + 16 * s + 8 * hh);
                Dp = MFMA32(ah, bh[s], Dp); Dp = MFMA32(ah, bl[s], Dp); Dp = MFMA32(al, bh[s], Dp); }
            __syncthreads();
#pragma unroll
            for (int r = 0; r < 16; ++r) RED[w * (32 * 33) + ((r & 3) + 8 * (r >> 2) + 4 * hh) * 33 + c] = Dp[r];
            __syncthreads();
            { const int tl = tid >> 4, e0 = tid & 15; float a0 = 0.f, a1 = 0.f;
#pragma unroll
              for (int ww = 0; ww < 8; ++ww) { a0 += RED[ww * (32 * 33) + tl * 33 + e0]; a1 += RED[ww * (32 * 33) + tl * 33 + e0 + 16]; }
              LG[(tile * 32 + tl) * 33 + e0] = a0 + b_router[e0]; LG[(tile * 32 + tl) * 33 + e0 + 16] = a1 + b_router[e0 + 16]; }
            __syncthreads();
        }
        if (tid < 128) { float lgv[32];
#pragma unroll
            for (int e = 0; e < 32; ++e) lgv[e] = LG[tid * 33 + e];
            int se[4]; float sv[4];
#pragma unroll
            for (int r = 0; r < 4; ++r) { float bv = -3.0e38f; int bi = 0;
#pragma unroll
                for (int e = 0; e < 32; ++e) { bool ok = lgv[e] > bv;
#pragma unroll
                    for (int q = 0; q < r; ++q) ok = ok && (se[q] != e);
                    bv = ok ? lgv[e] : bv; bi = ok ? e : bi; }
                se[r] = bi; sv[r] = bv; }
            float ex[4], den = 0.f;
#pragma unroll
            for (int r = 0; r < 4; ++r) { ex[r] = __expf(sv[r] - sv[0]); den += ex[r]; }
            const float inv = 1.f / den;
#pragma unroll
            for (int r = 0; r < 4; ++r) { const int lp = __hip_atomic_fetch_add(&LCNT[se[r]], 1, __ATOMIC_RELAXED, __HIP_MEMORY_SCOPE_WORKGROUP);
                REC[tid * 4 + r] = ((unsigned)se[r] << 16) | (unsigned)lp; RECW[tid * 4 + r] = ex[r] * inv; } }
        __syncthreads();
        { int t2 = tid; asm volatile("" : "+v"(t2)); if (t2 < 32) GBASE[t2] = atomicAdd(&gcnt[64 * t2], LCNT[t2]); }
        __syncthreads();
        { const unsigned rec = REC[tid]; const int e = rec >> 16, pos = GBASE[e] + (int)(rec & 0xffffu), aid = tblk * 512 + tid;
          list[e * NTOK + pos] = aid; ASG[aid] = ((unsigned)e << 16) | (unsigned)pos; TOPW[aid] = RECW[tid]; }
        __syncthreads();
    }
}
__device__ __forceinline__ void moe_tables(Frame& F) {
    LAS int* TST = (LAS int*)(F.lds + LDSCTL_OFF) + LC_TST; LAS int* LCNT = (LAS int*)(F.lds + LDSCTL_OFF) + LC_CNT;
    const int* gcnt = (const int*)(F.ws + WS_CTL) + CW_CNT;
    if (F.tid < 64) {
        const int lane = F.lane; const int c = lane < NE ? gcnt[64 * lane] : 0; const int mt = (c + 255) >> 8; int inc = mt;
#pragma unroll
        for (int o = 1; o < 32; o <<= 1) { const int up = __shfl_up(inc, o); if (lane >= o) inc += up; }
        if (lane < NE) { LCNT[lane] = c; TST[lane] = inc - mt; }
        if (lane == NE - 1) TST[NE] = inc;
    }
    __syncthreads();
}
__device__ __forceinline__ f32x4 fp8x4_to_f32(unsigned w) { const f32x2 lo = __builtin_amdgcn_cvt_pk_f32_fp8((int)w, false), hi = __builtin_amdgcn_cvt_pk_f32_fp8((int)w, true); return (f32x4){lo.x, lo.y, hi.x, hi.y}; }
__device__ __forceinline__ void p9_final(Frame& F) {
    const LAS int* TST = (const LAS int*)(F.lds + LDSCTL_OFF) + LC_TST;
    const unsigned* ASG = (const unsigned*)(F.ws + WS_ASG); const float* TOPW = (const float*)(F.ws + WS_TOPW); const unsigned char* Y = (const unsigned char*)(F.ws + WS_Y);
    const float* mod = (const float*)(F.ws + WS_MOD); const float* fw = F.in[IN_FNW]; float* out = F.out;
    const int lane = F.lane, gw = F.vcu * NWAVES + F.wave, NGW = F.G * NWAVES;
    f32x4 fwv[4];
#pragma unroll
    for (int j = 0; j < 4; ++j) fwv[j] = ((const f32x4*)fw)[lane + 64 * j];
    for (int tok0 = gw; tok0 < NTOK; tok0 += 2 * NGW) {
        int tk[2]; tk[0] = tok0; tk[1] = (tok0 + NGW < NTOK) ? tok0 + NGW : tok0;
        unsigned yv[2][4][4]; float wg[2][4]; f32x4 xv[2][4], gv[2][4];
#pragma unroll
        for (int u = 0; u < 2; ++u) { const u32x4 a4 = *(const u32x4*)(ASG + (size_t)tk[u] * 4); const f32x4 w4 = *(const f32x4*)(TOPW + (size_t)tk[u] * 4);
            const unsigned aa[4] = {a4.x, a4.y, a4.z, a4.w};
#pragma unroll
            for (int r = 0; r < 4; ++r) { const unsigned a = (unsigned)__builtin_amdgcn_readfirstlane((int)aa[r]); wg[u][r] = w4[r];
                const size_t row = (size_t)TST[a >> 16] * 256 + (a & 0xffffu); const unsigned* yp = (const unsigned*)(Y + row * D) + lane;
#pragma unroll
                for (int j = 0; j < 4; ++j) yv[u][r][j] = yp[64 * j]; }
            const f32x4* xr = (const f32x4*)(out + (size_t)tk[u] * D) + lane; const f32x4* g2 = (const f32x4*)(mod + (size_t)(tk[u] >> 11) * NMOD + 5120) + lane;
#pragma unroll
            for (int j = 0; j < 4; ++j) { xv[u][j] = xr[64 * j]; gv[u][j] = g2[64 * j]; } }
#pragma unroll
        for (int u = 0; u < 2; ++u) { f32x4 v[4]; float s = 0.f;
#pragma unroll
            for (int j = 0; j < 4; ++j) { f32x4 acc = fp8x4_to_f32(yv[u][0][j]) * wg[u][0];
#pragma unroll
                for (int r = 1; r < 4; ++r) acc += fp8x4_to_f32(yv[u][r][j]) * wg[u][r];
                v[j] = xv[u][j] + gv[u][j] * acc; s += (v[j].x * v[j].x + v[j].y * v[j].y) + (v[j].z * v[j].z + v[j].w * v[j].w); }
            const float rstd = rsqrtf(wave_sum(s) * (1.f / D) + EPS);
            if (u == 0 || tk[1] != tk[0]) { f32x4* xo = (f32x4*)(out + (size_t)tk[u] * D) + lane;
#pragma unroll
                for (int j = 0; j < 4; ++j) xo[64 * j] = v[j] * rstd * fwv[j]; } }
    }
}

#ifndef MK_N_LAUNCHES
#define MK_N_LAUNCHES 1
#endif
constexpr int N_PHASES = 10;
#ifndef PROBE_TWICE
#define PROBE_TWICE -1
#endif
__global__ void __launch_bounds__(NTHR, 2) mk_fwd(Args args) {
    extern __shared__ __attribute__((aligned(16))) unsigned char lds_raw[];
    Frame F;
    F.lds = (LAS unsigned char*)lds_raw;
    F.tid = threadIdx.x; F.lane = F.tid & 63; F.wave = __builtin_amdgcn_readfirstlane(F.tid >> 6);
    F.G = gridDim.x; { const int bx = blockIdx.x; F.vcu = (F.G % 8 == 0) ? (bx % 8) * (F.G / 8) + bx / 8 : bx; }
    F.in = args.in; F.out = args.out; F.ws = args.ws;
    for (int u = F.tid; u < (LDS_BYTES - LDSCTL_OFF) / 4; u += NTHR) ((LAS unsigned*)(F.lds + LDSCTL_OFF))[u] = 0u;
    __syncthreads();
    const int lo = args.ph_lo, hi = args.ph_hi;
    XcdBarrier bar; bar.bar = (unsigned*)(F.ws + WS_CTL) + CW_BAR; bar.x = 0; bar.st = nullptr;
    if (hi - lo > 1) bar = xcd_barrier_post((unsigned*)(F.ws + WS_CTL) + CW_BAR, (volatile LAS unsigned*)(F.lds + LDSCTL_OFF) + LC_BAR);
#define IN(k) (lo <= (k) && (k) < hi)
#define SEAM(k) do { if (IN(k) && IN((k) + 1)) xcd_barrier(bar); } while (0)
    if (IN(0)) { p0_prologue(F, false); } SEAM(0);
    if (IN(1)) { p1_norm1(F); } SEAM(1);
    if (IN(2)) for (int rep_ = 0; rep_ < (PROBE_TWICE == 2 ? 2 : 1); ++rep_) { if (rep_) xcd_barrier(bar);
        pg8::SchedInProj S{F.G, (int)blockIdx.x};
        pg8::EpiInProj E{(bf16_t*)(F.ws + WS_KB), (bf16_t*)(F.ws + WS_VB), (bf16_t*)(F.ws + WS_QB), (bf16_t*)(F.ws + WS_GB), (bf16_t*)(F.ws + WS_PB), (float*)(F.ws + WS_RB)};
        pg8::gemm_phase<pg8::EpiInProj, pg8::SchedInProj, true, false>(F.lds, (const char*)(F.ws + WS_HN1), (const char*)(F.ws + WS_WIN), D * 2, S, E);
    } SEAM(2);
    if (IN(3)) {
        const int bx = blockIdx.x, nG = (F.G + 1) >> 1, nP = F.G - nG;
        constexpr int CVT_N = 2048 + 1024, CVT_ODD = 2560, CVT_ODD2 = CVT_ODD + 256;
        if ((bx & 1) == 0) { for (int u = bx >> 1; u < NB * 8; u += nG) gla_unit<0>(F, u);
#if PROBE_TWICE == 38
                             for (int u = bx >> 1; u < NB * 8; u += nG) gla_unit<0>(F, u);
#endif
                             cvt_expert_items_dma(F, CVT_ODD2 + (bx >> 1), nG, CVT_N); }
        else { for (int u = bx >> 1; u < NB * 64; u += nP) pool_unit(F, u);
#if PROBE_TWICE == 37
               for (int u = bx >> 1; u < NB * 64; u += nP) pool_unit(F, u);
#endif
               cvt_expert_items_dma(F, bx >> 1, nP, CVT_ODD);
               if ((bx >> 1) >= 64) cvt_expert_items_dma(F, CVT_ODD + (bx >> 1) - 64, 64, CVT_ODD2);
#if PROBE_TWICE == 36
               __syncthreads(); cvt_expert_items_dma(F, bx >> 1, nP, CVT_ODD);
#endif
               __syncthreads();
               for (int rep_ = 0; rep_ < (PROBE_TWICE == 35 ? 2 : 1); ++rep_)
               { pg8::SchedInProjG S{nP, bx >> 1};
                 pg8::EpiInProj E{(bf16_t*)(F.ws + WS_KB), (bf16_t*)(F.ws + WS_VB), (bf16_t*)(F.ws + WS_QB), (bf16_t*)(F.ws + WS_GB), (bf16_t*)(F.ws + WS_PB), (float*)(F.ws + WS_RB)};
                 pg8::gemm_phase<pg8::EpiInProj, pg8::SchedInProjG, true, false>(F.lds, (const char*)(F.ws + WS_HN1), (const char*)(F.ws + WS_WIN), D * 2, S, E); } }
    } SEAM(3);
    if (IN(4)) { p4_gla_out(F); } SEAM(4);
    if (IN(5)) {
        pg8::SchedPlain S{F.G, (int)blockIdx.x, NTOK / 256, D / 256};
        pg8::EpiResid E{F.in[IN_X], (const float*)(F.ws + WS_MOD), F.out};
        pg8::gemm_phase<pg8::EpiResid, pg8::SchedPlain, true, false>(F.lds, (const char*)(F.ws + WS_MIX), (const char*)(F.ws + WS_WOUT), D * 2, S, E);
    } SEAM(5);
    if (IN(6)) { p6_router(F); } SEAM(6);
    const LAS int* TST = (const LAS int*)(F.lds + LDSCTL_OFF) + LC_TST; const LAS int* LCN = (const LAS int*)(F.lds + LDSCTL_OFF) + LC_CNT;
    if (IN(7)) {
        moe_tables(F);
        pg8::SchedMoE<8, true> S{F.G, (int)blockIdx.x, TST, LCN, (const int*)(F.ws + WS_LIST)};
        pg8::EpiSwiglu<true> E{(void*)(F.ws + WS_ACT), F.in[IN_BGU], 1.f / WSCALE};
        pg8::gemm_phase<pg8::EpiSwiglu<true>, pg8::SchedMoE<8, true>, true, true>(F.lds, (const char*)(F.ws + WS_HN2), (const char*)(F.ws + WS_WGU), D, S, E);
    } SEAM(7);
    if (IN(8)) {
        moe_tables(F);
        pg8::SchedMoE<4, false> S{F.G, (int)blockIdx.x, TST, LCN, nullptr};
        pg8::EpiDown E{(unsigned char*)(F.ws + WS_Y), F.in[IN_BDOWN], 1.f / WSCALE};
        pg8::gemm_phase<pg8::EpiDown, pg8::SchedMoE<4, false>, true, true>(F.lds, (const char*)(F.ws + WS_ACT), (const char*)(F.ws + WS_WD), DFF, S, E);
    } SEAM(8);
    if (IN(9)) { moe_tables(F); p9_final(F); }
#undef IN
#undef SEAM
}

extern "C" void kernel_launch(void* const* d_in, const int* in_sizes, int n_in, void* d_out, int out_size, void* d_ws, size_t ws_size, hipStream_t stream) {
    static int grid = 0;
    if (grid == 0) {
        if (n_in != 24 || ws_size < WS_END || out_size != NTOK * D) { fprintf(stderr, "kernel_launch: unexpected n_in %d / ws_size %zu / out %d\n", n_in, ws_size, out_size); grid = -1; return; }
        int dev = 0, cus = 0, per_cu = 0;
        if (hipGetDevice(&dev) != hipSuccess || hipDeviceGetAttribute(&cus, hipDeviceAttributeMultiprocessorCount, dev) != hipSuccess) { grid = -1; return; }
        if (hipFuncSetAttribute((const void*)mk_fwd, hipFuncAttributeMaxDynamicSharedMemorySize, LDS_BYTES) != hipSuccess) { fprintf(stderr, "kernel_launch: hipFuncSetAttribute failed\n"); grid = -1; return; }
        if (hipOccupancyMaxActiveBlocksPerMultiprocessor(&per_cu, (const void*)mk_fwd, NTHR, LDS_BYTES) != hipSuccess || per_cu < 1) { fprintf(stderr, "kernel_launch: occupancy query says %d workgroups per CU\n", per_cu); (void)hipGetLastError(); grid = -1; return; }
        (void)hipGetLastError();
        grid = cus;
    }
    if (grid < 0) return;
    (void)hipMemsetAsync((char*)d_ws + WS_CTL, 0, 1 * MiB, stream);
    Args a{};
    for (int i = 0; i < 24; ++i) a.in[i] = (const float*)d_in[i];
    a.out = (float*)d_out; a.ws = (unsigned char*)d_ws;
    if (MK_N_LAUNCHES == 1) {
        a.ph_lo = 0; a.ph_hi = N_PHASES;
        void* kargs[] = {&a};
        const hipError_t e = hipLaunchCooperativeKernel((const void*)mk_fwd, dim3(grid), dim3(NTHR), kargs, LDS_BYTES, stream);
        if (e != hipSuccess) fprintf(stderr, "kernel_launch: cooperative launch failed: %s (grid %d)\n", hipGetErrorString(e), grid);
    } else {
        for (int ph = 0; ph < N_PHASES; ++ph) { a.ph_lo = ph; a.ph_hi = ph + 1; hipLaunchKernelGGL(mk_fwd, dim3(grid), dim3(NTHR), LDS_BYTES, stream, a); }
    }
}
```

```cpp
#include <hip/hip_runtime.h>
#include <stdint.h>
#include <stdio.h>

#define LAS __attribute__((address_space(3)))
#define GAS __attribute__((address_space(1)))
typedef unsigned short bf16_t;
typedef short bf16x8 __attribute__((ext_vector_type(8)));
typedef float f32x4 __attribute__((ext_vector_type(4)));
typedef float f32x2 __attribute__((ext_vector_type(2)));
typedef float f32x16 __attribute__((ext_vector_type(16)));
typedef unsigned u32x4 __attribute__((ext_vector_type(4)));
typedef unsigned u32x2 __attribute__((ext_vector_type(2)));

constexpr int D = 1024, NB = 16, SEQ = 2048, CTX = 256;
constexpr int NTOK = NB * SEQ, NCTX = NB * CTX, NROW = NTOK + NCTX;
constexpr int DIN = 2080, NE = 32, DFF = 1024;
constexpr int GW = 64, GROWS = 32;
constexpr int NMOD = 6144;
constexpr float EPS = 1e-6f;
constexpr int NWAVES = 8, NTHR = 512;
constexpr int WIN_N = 2304;
constexpr int NPADROWS = NTOK * 4 + NE * 256;

__device__ __forceinline__ unsigned f2bf(float f) { unsigned u = __builtin_bit_cast(unsigned, f); return (u + 0x7fffu + ((u >> 16) & 1u)) >> 16; }
__device__ __forceinline__ unsigned pk2(float lo, float hi) { return f2bf(lo) | (f2bf(hi) << 16); }
__device__ __forceinline__ float bf2f(unsigned v) { return __builtin_bit_cast(float, v << 16); }
__device__ __forceinline__ float bflo(unsigned w) { return __builtin_bit_cast(float, w << 16); }
__device__ __forceinline__ float bfhi(unsigned w) { return __builtin_bit_cast(float, w & 0xffff0000u); }
__device__ __forceinline__ unsigned cvt_pk_bf16(float lo, float hi) { unsigned r; asm volatile("v_cvt_pk_bf16_f32 %0, %1, %2" : "=v"(r) : "v"(lo), "v"(hi)); return r; }
__device__ __forceinline__ float wave_sum(float v) {
#pragma unroll
    for (int o = 1; o < 64; o <<= 1) v += __shfl_xor(v, o);
    return v;
}
__device__ __forceinline__ float silu_f(float x) { return x / (1.f + __expf(-x)); }
__device__ __forceinline__ float logsigmoid_f(float x) { return fminf(x, 0.f) - log1pf(expf(-fabsf(x))); }
#define LDS_WAIT() asm volatile("s_waitcnt lgkmcnt(0)" ::: "memory")
#define VM_WAIT() asm volatile("s_waitcnt vmcnt(0)" ::: "memory")

namespace pg8 {
constexpr int BM = 256, BK = 64, HALF = 128, HTB = HALF * BK * 2  , STAGE_BYTES = 8 * HTB, NXCD = 8, WGM = 8;
__host__ __device__ __forceinline__ int lds_byte(int r, int c) { const int st = (r >> 4) * 2 + (c >> 5), rr = r & 15, cc = c & 31, ob = rr * 64 + cc * 2; return st * 1024 + (ob ^ (((ob >> 9) & 1) << 5)); }
__host__ __device__ __forceinline__ void stage_rc(int b, int& R, int& C) { const int st = b / 1024, sb = b % 1024, swz = sb ^ (((sb >> 9) & 1) << 5); R = (st >> 1) * 16 + swz / 64; C = (st & 1) * 32 + (swz % 64) / 2; }
__host__ __device__ __forceinline__ int perm32(int rho) { const int n = rho >> 4, i = rho & 15; return 8 * (i >> 2) + 4 * n + (i & 3); }

struct Unit { int pm, pn, arow, bt, nvalid, e; };

typedef int i32x8 __attribute__((ext_vector_type(8)));
typedef int i32x4v __attribute__((ext_vector_type(4)));
__device__ __forceinline__ i32x8 cat8(const bf16x8 a, const bf16x8 b) { const i32x4v x = __builtin_bit_cast(i32x4v, a), y = __builtin_bit_cast(i32x4v, b); return __builtin_shufflevector(x, y, 0, 1, 2, 3, 4, 5, 6, 7); }
__device__ __forceinline__ bf16x8 lo8(const i32x8 v) { return __builtin_bit_cast(bf16x8, (i32x4v)__builtin_shufflevector(v, v, 0, 1, 2, 3)); }
__device__ __forceinline__ bf16x8 hi8(const i32x8 v) { return __builtin_bit_cast(bf16x8, (i32x4v)__builtin_shufflevector(v, v, 4, 5, 6, 7)); }
template <class Epi, class Sched, bool ALIGN_EPI, bool FP8>
__device__ __forceinline__ void gemm_phase(LAS unsigned char* lds, const char* Abase, const char* Bbase, const int pitch, const Sched& S, const Epi& E) {
    const int tid = threadIdx.x, wid = __builtin_amdgcn_readfirstlane(tid >> 6), lane = tid & 63, wr = wid >> 2, wc = wid & 3, fr = lane & 15, fq = lane >> 4;
    const int nt = pitch / 128;
    unsigned voffB[2];
#pragma unroll
    for (int i = 0; i < 2; ++i) { int R, C; stage_rc(tid * 16 + i * 8192, R, C); const int Rb = (R & ~31) + perm32(R & 31);
        voffB[i] = (unsigned)(Rb * pitch) + (unsigned)C * 2u; }
    const size_t kstep = (size_t)(BK * 2);
    const size_t hstep = (size_t)HALF * pitch;
    const unsigned ldsw = (unsigned)wid * 1024u;
    const int aoff = lds_byte(wr * 64 + fr, fq * 8), boff = lds_byte(wc * 32 + fr, fq * 8);
#define PG8_SA(b, h) (((b) * 2 + (h)) * HTB)
#define PG8_SB(b, h) ((4 + (b) * 2 + (h)) * HTB)
#define PG8_STAGE_B(bufoff, gbase) do { _Pragma("unroll") for (int _i = 0; _i < 2; ++_i) \
        __builtin_amdgcn_global_load_lds((const unsigned*)((const char*)(gbase) + voffB[_i]), (LAS unsigned*)(lds + (bufoff) + ldsw + _i * 8192), 16, 0, 0); } while (0)
#define PG8_STAGE_A(bufoff, ao, kb) do { _Pragma("unroll") for (int _i = 0; _i < 2; ++_i) \
        __builtin_amdgcn_global_load_lds((const unsigned*)(Abase + (size_t)(ao)[_i] + (size_t)(kb)), (LAS unsigned*)(lds + (bufoff) + ldsw + _i * 8192), 16, 0, 0); } while (0)
#define PG8_LDA(dst, b, h) do { _Pragma("unroll") for (int m = 0; m < 4; ++m) dst[m] = cat8(*(const LAS bf16x8*)(lds + PG8_SA(b, h) + aoff + m * 2048), *(const LAS bf16x8*)(lds + PG8_SA(b, h) + aoff + m * 2048 + 1024)); } while (0)
#define PG8_LDB(dst, b, h) do { _Pragma("unroll") for (int n = 0; n < 2; ++n) dst[n] = cat8(*(const LAS bf16x8*)(lds + PG8_SB(b, h) + boff + n * 2048), *(const LAS bf16x8*)(lds + PG8_SB(b, h) + boff + n * 2048 + 1024)); } while (0)
#define PG8_MMA(ai, bj, At, Bt) do { __builtin_amdgcn_s_setprio(1); _Pragma("unroll") for (int m = 0; m < 4; ++m) _Pragma("unroll") for (int n = 0; n < 2; ++n) { \
        if constexpr (FP8) { acc[ai][bj][m][n] = __builtin_amdgcn_mfma_scale_f32_16x16x128_f8f6f4(Bt[n], At[m], acc[ai][bj][m][n], 0, 0, 0, 0x7f7f7f7f, 0, 0x7f7f7f7f); } \
        else { acc[ai][bj][m][n] = __builtin_amdgcn_mfma_f32_16x16x32_bf16(lo8(Bt[n]), lo8(At[m]), acc[ai][bj][m][n], 0, 0, 0); \
               acc[ai][bj][m][n] = __builtin_amdgcn_mfma_f32_16x16x32_bf16(hi8(Bt[n]), hi8(At[m]), acc[ai][bj][m][n], 0, 0, 0); } } \
        __builtin_amdgcn_s_setprio(0); } while (0)
#define PG8_WAIT_V(n) asm volatile("s_waitcnt vmcnt(" #n ")" ::: "memory")
#define PG8_WAIT_L(n) asm volatile("s_waitcnt lgkmcnt(" #n ")" ::: "memory")
#define PG8_BAR __builtin_amdgcn_s_barrier()
#define PG8_SCHED __builtin_amdgcn_sched_barrier(0)
    Unit cur, nxt; int ui = 0;
    if (!S.next(0, cur)) return;
    f32x4 acc[2][2][4][2];
#pragma unroll
    for (int a = 0; a < 2; ++a)
#pragma unroll
        for (int b = 0; b < 2; ++b)
#pragma unroll
            for (int m = 0; m < 4; ++m)
#pragma unroll
                for (int n = 0; n < 2; ++n) acc[a][b][m][n] = (f32x4){0.f, 0.f, 0.f, 0.f};
    i32x8 At[4], B0[2], B1[2];
    unsigned aoc[2][2];
    LAS u32x4* nxslot = (LAS u32x4*)(lds + STAGE_BYTES) + tid;
#pragma unroll
    for (int h = 0; h < 2; ++h)
#pragma unroll
        for (int i = 0; i < 2; ++i) { int R2, C2; stage_rc(tid * 16 + i * 8192, R2, C2); aoc[h][i] = S.arow(cur, h * HALF + R2) * (unsigned)pitch + (unsigned)C2 * 2u; }
    const char* cB = Bbase + (size_t)cur.bt * pitch;
    PG8_STAGE_B(PG8_SB(0, 0), cB); PG8_STAGE_B(PG8_SB(0, 1), cB + hstep); PG8_STAGE_A(PG8_SA(0, 0), aoc[0], 0); PG8_STAGE_A(PG8_SA(0, 1), aoc[1], 0);
    if (wr == 1) PG8_BAR;
    PG8_WAIT_V(2); PG8_BAR;
    PG8_STAGE_B(PG8_SB(1, 0), cB + kstep); PG8_STAGE_A(PG8_SA(1, 0), aoc[0], kstep); PG8_STAGE_B(PG8_SB(1, 1), cB + hstep + kstep);
    PG8_WAIT_V(6); PG8_BAR;
    for (;;) {
        const bool has_next = S.next(ui + 1, nxt);
        int tq = tid; asm volatile("" : "+v"(tq));
        { unsigned nx4[4];
#pragma unroll
          for (int h = 0; h < 2; ++h)
#pragma unroll
              for (int i = 0; i < 2; ++i) { int R2, C2; stage_rc(tq * 16 + i * 8192, R2, C2); nx4[h * 2 + i] = has_next ? S.arow(nxt, h * HALF + R2) * (unsigned)pitch + (unsigned)C2 * 2u : aoc[h][i]; }
          *nxslot = (u32x4){nx4[0], nx4[1], nx4[2], nx4[3]}; }
        const char* nB = has_next ? Bbase + (size_t)nxt.bt * pitch : cB;
#pragma nounroll
        for (int t = 0; t < nt; t += 2) {
            const bool last = (t == nt - 2);
            const size_t k1 = (size_t)(t + 1) * kstep;
            const size_t k2 = last ? (size_t)0 : (size_t)(t + 2) * kstep, k3 = k2 + kstep;
            const char* b2 = last ? nB : cB + (size_t)(t + 2) * kstep; const char* b3 = b2 + kstep;
            PG8_LDB(B0, 0, 0); PG8_LDB(B1, 0, 1); PG8_SCHED; PG8_LDA(At, 0, 0); PG8_STAGE_A(PG8_SA(1, 1), aoc[1], k1);
            if (last) { const u32x4 nx = *nxslot; aoc[0][0] = nx.x; aoc[0][1] = nx.y; aoc[1][0] = nx.z; aoc[1][1] = nx.w; }
            PG8_WAIT_V(8); PG8_WAIT_L(0); PG8_BAR; PG8_MMA(0, 0, At, B0); PG8_MMA(0, 1, At, B1); PG8_BAR; PG8_SCHED;
            PG8_LDA(At, 0, 1); PG8_STAGE_B(PG8_SB(0, 0), b2); PG8_STAGE_B(PG8_SB(0, 1), b2 + hstep); PG8_STAGE_A(PG8_SA(0, 0), aoc[0], k2);
            PG8_WAIT_V(8); PG8_WAIT_L(0); PG8_BAR; PG8_MMA(1, 0, At, B0); PG8_MMA(1, 1, At, B1); PG8_BAR; PG8_SCHED;
            PG8_LDB(B0, 1, 0); PG8_LDB(B1, 1, 1); PG8_SCHED; PG8_LDA(At, 1, 0); PG8_STAGE_A(PG8_SA(0, 1), aoc[1], k2);
            PG8_WAIT_V(8); PG8_WAIT_L(0); PG8_BAR; PG8_MMA(0, 0, At, B0); PG8_MMA(0, 1, At, B1); PG8_BAR; PG8_SCHED;
            PG8_LDA(At, 1, 1); PG8_STAGE_B(PG8_SB(1, 0), b3); PG8_STAGE_B(PG8_SB(1, 1), b3 + hstep); PG8_STAGE_A(PG8_SA(1, 0), aoc[0], k3);
            PG8_WAIT_V(8); PG8_WAIT_L(0); PG8_BAR; PG8_MMA(1, 0, At, B0); PG8_MMA(1, 1, At, B1); PG8_BAR; PG8_SCHED;
        }
        if constexpr (ALIGN_EPI) { if (wr == 0) PG8_BAR; }
        E(acc, cur, wr, wc, fr, fq);
        if (!has_next) break;
#pragma unroll
        for (int a = 0; a < 2; ++a)
#pragma unroll
            for (int b = 0; b < 2; ++b)
#pragma unroll
                for (int m = 0; m < 4; ++m)
#pragma unroll
                    for (int n = 0; n < 2; ++n) acc[a][b][m][n] = (f32x4){0.f, 0.f, 0.f, 0.f};
        cur = nxt; cB = nB; ++ui;
        if constexpr (ALIGN_EPI) { if (wr == 1) PG8_BAR; }
    }
    PG8_WAIT_V(0);
    if constexpr (!ALIGN_EPI) { if (wr == 0) PG8_BAR; }
    PG8_BAR;
#undef PG8_SA
#undef PG8_SB
#undef PG8_STAGE_A
#undef PG8_STAGE_B
#undef PG8_LDA
#undef PG8_LDB
#undef PG8_MMA
#undef PG8_WAIT_V
#undef PG8_WAIT_L
#undef PG8_BAR
#undef PG8_SCHED
}

__device__ __forceinline__ int xcd_remap(int L, int nwg) { const int q = nwg / NXCD, r = nwg % NXCD, xcd = L % NXCD, off = L / NXCD; return (xcd < r ? xcd * (q + 1) : r * (q + 1) + (xcd - r) * q) + off; }

constexpr int NG2 = 64;
struct SchedInProj {
    int G, c;
    __device__ __forceinline__ bool next(int i, Unit& u) const {
        constexpr int NLAT = 128 * 7, NCTX = 16 * 4, NWG = NLAT + NCTX + NG2;
        const int L = i * G + c; if (L >= NWG) return false;
        const int wgid = xcd_remap(L, NWG); int pm, pn;
        if (wgid < NLAT) { const int nig = WGM * 7, gid = wgid / nig, j = (wgid % nig) / WGM; pm = gid * WGM + (wgid % nig) % WGM; pn = j < 5 ? j : j + 2; }
        else if (wgid < NLAT + NCTX) { const int w = wgid - NLAT, nig = WGM * 4, gid = w / nig; pm = 128 + gid * WGM + (w % nig) % WGM; pn = (w % nig) / WGM; }
        else { const int w = wgid - NLAT - NCTX; pm = w >> 1; pn = 5 + (w & 1); }
        u.pm = pm; u.pn = pn; u.arow = pm * BM; u.bt = pn * BM; u.nvalid = BM; u.e = 0; return true;
    }
    __device__ __forceinline__ unsigned arow(const Unit& u, int rloc) const { return (unsigned)(u.arow + rloc); }
};
struct SchedInProjG {
    int nwg, c;
    __device__ __forceinline__ bool next(int i, Unit& u) const {
        const int L = NG2 + i * nwg + c; if (L >= 256) return false;
        u.pm = L >> 1; u.pn = 5 + (L & 1); u.arow = u.pm * BM; u.bt = u.pn * BM; u.nvalid = BM; u.e = 0; return true;
    }
    __device__ __forceinline__ unsigned arow(const Unit& u, int rloc) const { return (unsigned)(u.arow + rloc); }
};
struct SchedPlain {
    int G, c, nM, nN;
    __device__ __forceinline__ bool next(int i, Unit& u) const {
        const int nwg = nM * nN, L = i * G + c; if (L >= nwg) return false;
        const int wgid = xcd_remap(L, nwg), nig = WGM * nN, gid = wgid / nig, fm = gid * WGM, gsz = (nM - fm) < WGM ? (nM - fm) : WGM;
        u.pm = fm + ((wgid % nig) % gsz); u.pn = (wgid % nig) / gsz; u.arow = u.pm * BM; u.bt = u.pn * BM; u.nvalid = BM; u.e = 0; return true;
    }
    __device__ __forceinline__ unsigned arow(const Unit& u, int rloc) const { return (unsigned)(u.arow + rloc); }
};
template <int NT, bool GATHER>
struct SchedMoE {
    int G, c; const LAS int* tst; const LAS int* cnt; const int* list;
    __device__ __forceinline__ bool next(int i, Unit& u) const {
        const int nwg = tst[NE] * NT, L = i * G + c; if (L >= nwg) return false;
        const int wgid = xcd_remap(L, nwg);
        int e = 0;
#pragma unroll
        for (int s = 16; s >= 1; s >>= 1) { if (tst[e + s] * NT <= wgid) e += s; }
        const int t0 = tst[e], mt = tst[e + 1] - t0, w = wgid - t0 * NT, nig = WGM * NT, gid = w / nig, fm = gid * WGM, gsz = (mt - fm) < WGM ? (mt - fm) : WGM;
        const int m = fm + ((w % nig) % gsz), n = (w % nig) / gsz;
        u.pm = t0 + m; u.pn = n; u.e = e; u.bt = (e * NT + n) * BM;
        if (GATHER) { u.arow = e * NTOK + m * BM; const int left = cnt[e] - m * BM; u.nvalid = left < BM ? left : BM; }
        else { u.arow = u.pm * BM; u.nvalid = BM; }
        return true;
    }
    __device__ __forceinline__ unsigned arow(const Unit& u, int rloc) const {
        if (GATHER) { const int tok = (rloc < u.nvalid) ? (list[u.arow + rloc] >> 2) : 0; return (unsigned)tok; }
        return (unsigned)(u.arow + rloc);
    }
};

struct EpiInProj {
    bf16_t *KB, *VB, *QB, *GB, *PB; float* RB;
    __device__ __forceinline__ void operator()(const f32x4 (&acc)[2][2][4][2], const Unit& u, int wr, int wc, int fr, int fq) const {
        const int pn = u.pn, row0 = u.pm * BM + wr * 64 + fr;
        if (pn == 3) {
            if (wc != 0) return;
#pragma unroll
            for (int ai = 0; ai < 2; ++ai)
#pragma unroll
                for (int m = 0; m < 4; ++m) { float* rp = RB + (size_t)(row0 + ai * HALF + m * 16) * 32 + 8 * fq;
                    *(f32x4*)rp = acc[ai][0][m][0]; *(f32x4*)(rp + 4) = acc[ai][0][m][1]; }
            return;
        }
        if (pn >= 7) {
#pragma unroll
            for (int ai = 0; ai < 2; ++ai)
#pragma unroll
                for (int m = 0; m < 4; ++m) { const int row = row0 + ai * HALF + m * 16, b = row >> 11, t = row & 2047;
#pragma unroll
                    for (int bj = 0; bj < 2; ++bj) { const int g = (pn - 7) * 2 + bj, cblk = wc * 4 + fq;
                        const f32x4 v0 = acc[ai][bj][m][0], v1 = acc[ai][bj][m][1]; u32x4 w; w.x = cvt_pk_bf16(v0[0], v0[1]); w.y = cvt_pk_bf16(v0[2], v0[3]); w.z = cvt_pk_bf16(v1[0], v1[1]); w.w = cvt_pk_bf16(v1[2], v1[3]);
                        *(u32x4*)(PB + ((((size_t)(b * 4 + g) * 16 + cblk) * 2048 + t) * 8)) = w; } }
            return;
        }
        bf16_t* base; int ldc, coff;
        if (pn == 0) { base = KB; ldc = 256; coff = 0; } else if (pn <= 2) { base = VB; ldc = 512; coff = (pn - 1) * 256; }
        else if (pn == 4) { base = QB; ldc = 256; coff = 0; } else { base = GB; ldc = 512; coff = (pn - 5) * 256; }
        const int col0 = coff + wc * 32 + 8 * fq;
#pragma unroll
        for (int ai = 0; ai < 2; ++ai)
#pragma unroll
            for (int m = 0; m < 4; ++m) { bf16_t* rowp = base + (size_t)(row0 + ai * HALF + m * 16) * ldc + col0;
#pragma unroll
                for (int bj = 0; bj < 2; ++bj) { const f32x4 v0 = acc[ai][bj][m][0], v1 = acc[ai][bj][m][1];
                    u32x4 w; w.x = cvt_pk_bf16(v0[0], v0[1]); w.y = cvt_pk_bf16(v0[2], v0[3]); w.z = cvt_pk_bf16(v1[0], v1[1]); w.w = cvt_pk_bf16(v1[2], v1[3]);
                    *(u32x4*)(rowp + bj * HALF) = w; } }
    }
};
struct EpiResid {
    const float* x; const float* mod; float* out;
    __device__ __forceinline__ void operator()(const f32x4 (&acc)[2][2][4][2], const Unit& u, int wr, int wc, int fr, int fq) const {
        const int row0 = u.pm * BM + wr * 64 + fr, col0 = u.pn * BM + wc * 32 + 8 * fq;
        const float* g1 = mod + (size_t)(row0 >> 11) * NMOD + 2048 + col0;
        f32x4 gv[2][2];
#pragma unroll
        for (int bj = 0; bj < 2; ++bj)
#pragma unroll
            for (int n = 0; n < 2; ++n) gv[bj][n] = *(const f32x4*)(g1 + bj * HALF + 4 * n);
        f32x4 xa[2][2], xb[2][2];
#define RES_LOAD(dst, g_) do { const size_t _o = (size_t)(row0 + ((g_) >> 2) * HALF + ((g_) & 3) * 16) * D + col0; \
            _Pragma("unroll") for (int bj = 0; bj < 2; ++bj) _Pragma("unroll") for (int n = 0; n < 2; ++n) dst[bj][n] = *(const f32x4*)(x + _o + bj * HALF + 4 * n); } while (0)
#define RES_STORE(src, g_) do { const size_t _o = (size_t)(row0 + ((g_) >> 2) * HALF + ((g_) & 3) * 16) * D + col0; \
            _Pragma("unroll") for (int bj = 0; bj < 2; ++bj) _Pragma("unroll") for (int n = 0; n < 2; ++n) *(f32x4*)(out + _o + bj * HALF + 4 * n) = src[bj][n] + gv[bj][n] * acc[(g_) >> 2][bj][(g_) & 3][n]; } while (0)
        RES_LOAD(xa, 0);
#pragma unroll
        for (int g2 = 0; g2 < 8; g2 += 2) { RES_LOAD(xb, g2 + 1); RES_STORE(xa, g2); if (g2 + 2 < 8) RES_LOAD(xa, g2 + 2); RES_STORE(xb, g2 + 1); }
#undef RES_LOAD
#undef RES_STORE
    }
};
__device__ __forceinline__ unsigned pk4_fp8(float a, float b, float c, float d) { int w = 0; w = __builtin_amdgcn_cvt_pk_fp8_f32(a, b, w, false); w = __builtin_amdgcn_cvt_pk_fp8_f32(c, d, w, true); return (unsigned)w; }
template <bool FP8>
struct EpiSwiglu {
    void* act; const float* bgu; float ascale;
    __device__ __forceinline__ void operator()(const f32x4 (&acc)[2][2][4][2], const Unit& u, int wr, int wc, int fr, int fq) const {
        const int row0 = u.pm * BM + wr * 64 + fr, cc = u.pn * HALF + wc * 32 + 8 * fq;
        const float* bg = bgu + (size_t)u.e * 2048 + cc;
        f32x4 bgv[2], buv[2];
#pragma unroll
        for (int n = 0; n < 2; ++n) { bgv[n] = *(const f32x4*)(bg + 4 * n); buv[n] = *(const f32x4*)(bg + 1024 + 4 * n); }
#pragma unroll
        for (int ai = 0; ai < 2; ++ai)
#pragma unroll
            for (int m = 0; m < 4; ++m) { float r[8];
#pragma unroll
                for (int n = 0; n < 2; ++n) { const f32x4 gq = acc[ai][0][m][n] * ascale + bgv[n], uq = acc[ai][1][m][n] * ascale + buv[n];
#pragma unroll
                    for (int j = 0; j < 4; j += 2) { f32x2 gt = {fminf(gq[j], 7.f), fminf(gq[j + 1], 7.f)};
                        f32x2 up1 = {fminf(fmaxf(uq[j], -7.f), 7.f), fminf(fmaxf(uq[j + 1], -7.f), 7.f)}; up1 = up1 + 1.f;
                        const f32x2 z = gt * (-1.702f * 1.44269504089f);
                        f32x2 d = {__builtin_amdgcn_exp2f(z.x), __builtin_amdgcn_exp2f(z.y)}; d = d + 1.f;
                        const f32x2 rc = {__builtin_amdgcn_rcpf(d.x), __builtin_amdgcn_rcpf(d.y)};
                        const f32x2 o = (up1 * gt) * rc; r[4 * n + j] = o.x; r[4 * n + j + 1] = o.y; } }
                if constexpr (FP8) { u32x2 w; w.x = pk4_fp8(r[0], r[1], r[2], r[3]); w.y = pk4_fp8(r[4], r[5], r[6], r[7]);
                    *(u32x2*)((unsigned char*)act + (size_t)(row0 + ai * HALF + m * 16) * DFF + cc) = w; }
                else { u32x4 w; w.x = cvt_pk_bf16(r[0], r[1]); w.y = cvt_pk_bf16(r[2], r[3]); w.z = cvt_pk_bf16(r[4], r[5]); w.w = cvt_pk_bf16(r[6], r[7]);
                    *(u32x4*)((bf16_t*)act + (size_t)(row0 + ai * HALF + m * 16) * DFF + cc) = w; } }
    }
};
struct EpiDown {
    unsigned char* y; const float* bd; float ascale;
    __device__ __forceinline__ void operator()(const f32x4 (&acc)[2][2][4][2], const Unit& u, int wr, int wc, int fr, int fq) const {
        const int row0 = u.pm * BM + wr * 64 + fr, col0 = u.pn * BM + wc * 32 + 8 * fq;
        const float* bp = bd + (size_t)u.e * D + col0;
        f32x4 bv[2][2];
#pragma unroll
        for (int bj = 0; bj < 2; ++bj)
#pragma unroll
            for (int n = 0; n < 2; ++n) bv[bj][n] = *(const f32x4*)(bp + bj * HALF + 4 * n);
#pragma unroll
        for (int ai = 0; ai < 2; ++ai)
#pragma unroll
            for (int m = 0; m < 4; ++m) { unsigned char* rowp = y + (size_t)(row0 + ai * HALF + m * 16) * D + col0;
#pragma unroll
                for (int bj = 0; bj < 2; ++bj) { const f32x4 v0 = acc[ai][bj][m][0] * ascale + bv[bj][0], v1 = acc[ai][bj][m][1] * ascale + bv[bj][1];
                    u32x2 w; w.x = pk4_fp8(v0[0], v0[1], v0[2], v0[3]); w.y = pk4_fp8(v1[0], v1[1], v1[2], v1[3]);
                    *(u32x2*)(rowp + bj * HALF) = w; } }
    }
};
}

constexpr size_t MiB = 1u << 20;
constexpr size_t WS_CTL = 0, WS_MOD = 1 * MiB, WS_TOPW = 2 * MiB, WS_ASG = 3 * MiB, WS_WRT = 3 * MiB + 512 * 1024, WS_LIST = 4 * MiB, WS_WIN = 8 * MiB, WS_WOUT = 13 * MiB,
                 WS_WGU = 16 * MiB, WS_WD = 80 * MiB, WS_HN1 = 112 * MiB, WS_HN2 = 112 * MiB,
                 WS_KB = 184 * MiB, WS_VB = 202 * MiB, WS_RB = 238 * MiB, WS_QB = 243 * MiB, WS_GB = 259 * MiB, WS_PB = 291 * MiB,
                 WS_OF = 323 * MiB, WS_OB = 387 * MiB, WS_MIX = 451 * MiB, WS_ACT = 184 * MiB, WS_Y = 515 * MiB, WS_END = 787 * MiB;
static_assert(WS_ACT + (size_t)NPADROWS * DFF <= WS_Y && WS_Y + (size_t)NPADROWS * D * 2 <= WS_END, "ws map");


constexpr int CW_CNT = 0;
constexpr int CW_BAR = 4096;

constexpr int RING_BYTES = 131072;
constexpr int LDSCTL_OFF = 155648;
constexpr int LDS_BYTES = 163840;
constexpr int LC_BAR = 0, LC_TST = 16, LC_CNT = 64;

#define XB_TMO      128
#define XB_XCNT(j)  (256  + 64 * (j))
#define XB_XSUB(j)  (1280 + 64 * (j))
#define XB_XGEN(j)  (2304 + 64 * (j))
#define XB_TOP      3328
#define XB_TOPGEN   3392
#define XCD_BAR_WORDS 3456
#define XB_SPIN_CAP (1u << 18)
__device__ __forceinline__ unsigned xb_ld(unsigned* p)              { return __hip_atomic_load(p, __ATOMIC_RELAXED, __HIP_MEMORY_SCOPE_AGENT); }
__device__ __forceinline__ unsigned xb_add(unsigned* p, unsigned v) { return __hip_atomic_fetch_add(p, v, __ATOMIC_RELAXED, __HIP_MEMORY_SCOPE_AGENT); }
__device__ __forceinline__ unsigned xb_xcc_id() { return (unsigned)__builtin_amdgcn_s_getreg((3 << 11) | 20) & 0xFu; }
#define XB_SPIN(cond, bar) do { unsigned _sp = 0; while (cond) { __builtin_amdgcn_s_sleep(1); \
    if ((++_sp & 255u) == 0u) { if (xb_ld(&(bar)[XB_TMO])) break; if (_sp > XB_SPIN_CAP) { atomicAdd(&(bar)[XB_TMO], 1u); break; } } } } while (0)
struct XcdBarrier { unsigned* bar; unsigned x; volatile LAS unsigned* st; };
__device__ __forceinline__ XcdBarrier xcd_barrier_post(unsigned* bar, volatile LAS unsigned* st) {
    XcdBarrier b; b.bar = bar; b.x = xb_xcc_id(); b.st = st;
    if (threadIdx.x == 0) (void)xb_add(&bar[XB_XCNT(b.x)], 1u);
    return b;
}
__device__ __forceinline__ void xcd_barrier_complete(unsigned* bar, unsigned x, unsigned& nloc, unsigned& nx) {
    const unsigned G = gridDim.x * gridDim.y * gridDim.z;
    unsigned sum, cnt, mine, sp = 0u;
    for (;;) {
        sum = 0u; cnt = 0u; mine = 0u;
#pragma unroll
        for (unsigned j = 0; j < 16; ++j) { const unsigned c = xb_ld(&bar[XB_XCNT(j)]); sum += c; cnt += (c > 0u) ? 1u : 0u; mine = (j == x) ? c : mine; }
        if (sum == G) break;
        __builtin_amdgcn_s_sleep(1);
        if ((++sp & 255u) == 0u) { if (xb_ld(&bar[XB_TMO])) break; if (sp > XB_SPIN_CAP) { atomicAdd(&bar[XB_TMO], 1u); break; } }
    }
    nloc = mine > 0u ? mine : 1u; nx = cnt > 0u ? cnt : 1u;
}
__device__ __forceinline__ void xcd_barrier(const XcdBarrier& b) {
    asm volatile("s_waitcnt vmcnt(0)" ::: "memory");
    __syncthreads();
    if (threadIdx.x == 0) {
        unsigned* bar = b.bar;
        __builtin_amdgcn_s_waitcnt(0);
        unsigned nloc = b.st[0], nx = b.st[1];
        if (nloc == 0u) { xcd_barrier_complete(bar, b.x, nloc, nx); b.st[0] = nloc; b.st[1] = nx; }
        const unsigned old = xb_add(&bar[XB_XSUB(b.x)], 1u);
        const unsigned gen = old / nloc;
        if (old + 1u == (gen + 1u) * nloc) {
            __builtin_amdgcn_fence(__ATOMIC_RELEASE, "agent");
            asm volatile("s_waitcnt vmcnt(0)" ::: "memory");
            const unsigned og = xb_add(&bar[XB_TOP], 1u);
            const unsigned tg = og / nx;
            if (og + 1u == (tg + 1u) * nx) xb_add(&bar[XB_TOPGEN], 1u);
            else XB_SPIN(xb_ld(&bar[XB_TOPGEN]) == tg, bar);
            __builtin_amdgcn_fence(__ATOMIC_ACQUIRE, "agent");
            xb_add(&bar[XB_XGEN(b.x)], 1u);
            asm volatile("s_waitcnt vmcnt(0)" ::: "memory");
        } else {
            XB_SPIN(xb_ld(&bar[XB_XGEN(b.x)]) == gen, bar);
            __builtin_amdgcn_fence(__ATOMIC_ACQUIRE, "agent");
            asm volatile("s_waitcnt vmcnt(0)" ::: "memory");
        }
    }
    __syncthreads();
}

struct Args { const float* in[24]; float* out; unsigned char* ws; int ph_lo, ph_hi; };
struct Frame {
    LAS unsigned char* lds;
    int tid, lane, wave, vcu, G;
    const float* const* in; float* out; unsigned char* ws;
};
#define IN_X 0
#define IN_C 1
#define IN_CTX 2
#define IN_CCTX 3
#define IN_WADA 4
#define IN_BADA 5
#define IN_NMIX 6
#define IN_NMLP 7
#define IN_WIN 8
#define IN_WGKF 9
#define IN_BGKF 10
#define IN_WGKB 11
#define IN_BGKB 12
#define IN_GLANW 13
#define IN_WPOOL 14
#define IN_PSCALE 15
#define IN_WOUT 16
#define IN_WROUTER 17
#define IN_BROUTER 18
#define IN_WGU 19
#define IN_BGU 20
#define IN_WDOWN 21
#define IN_BDOWN 22
#define IN_FNW 23

__device__ __forceinline__ void p0_transpose_item(const float* W, int ldw, int k0, int n0, bf16_t* WT, int ldd, int drow, int dk0, LAS float* scr, int lane) {
#pragma unroll 8
    for (int i = 0; i < 32; ++i) { const int kk = 2 * i + (lane >> 5); scr[kk * 33 + (lane & 31)] = W[(size_t)(k0 + kk) * ldw + n0 + (lane & 31)]; }
    LDS_WAIT(); asm volatile("" ::: "memory");
    const int c = lane & 7;
#pragma unroll
    for (int j = 0; j < 4; ++j) { const int n = (lane >> 3) + 8 * j; const LAS float* s = scr + (8 * c) * 33 + n;
        u32x4 o; o.x = pk2(s[0 * 33], s[1 * 33]); o.y = pk2(s[2 * 33], s[3 * 33]); o.z = pk2(s[4 * 33], s[5 * 33]); o.w = pk2(s[6 * 33], s[7 * 33]);
        *(u32x4*)(WT + (size_t)(drow + n) * ldd + dk0 + k0 + 8 * c) = o; }
    LDS_WAIT(); asm volatile("" ::: "memory");
}
__device__ __forceinline__ int win_drow(int n0) {
    if (n0 < 256) return 4 * 256 + n0;
    if (n0 < 512) return n0 - 256;
    if (n0 < 1024) return 256 + (n0 - 512);
    if (n0 < 1536) return 5 * 256 + (n0 - 1024);
    if (n0 < 1568) return 3 * 256 + (n0 - 1536);
    return 7 * 256 + (n0 - 1568);
}
__device__ __forceinline__ void p0_mod_item(Frame& F, int item, const LAS float* SL, float* mod) {
    const float* w_ada = F.in[IN_WADA]; const float* b_ada = F.in[IN_BADA];
    const int j = item * 8 + (F.lane & 7), kp = F.lane >> 3;
    float acc[17];
#pragma unroll
    for (int r = 0; r < 17; ++r) acc[r] = 0.f;
#pragma unroll 4
    for (int i = 0; i < 128; ++i) { const int k = kp + 8 * i; const float w = w_ada[(size_t)k * NMOD + j];
#pragma unroll
        for (int r = 0; r < 17; ++r) acc[r] += SL[r * 1024 + k] * w; }
#pragma unroll
    for (int r = 0; r < 17; ++r) { float a = acc[r]; a += __shfl_xor(a, 8); a += __shfl_xor(a, 16); a += __shfl_xor(a, 32); if (kp == 0) mod[r * NMOD + j] = a + b_ada[j]; }
}
__device__ __forceinline__ void p0_weff_item(Frame& F, int item, LAS float* scr, bf16_t* Wout_t) {
    const float* w_pool = F.in[IN_WPOOL]; const float* pscale = F.in[IN_PSCALE]; const float* w_out = F.in[IN_WOUT];
    const int g = item >> 6, n0 = (item & 63) * 16, lane = F.lane;
#pragma unroll 4
    for (int q = 0; q < 32; ++q) { const int idx = lane + 64 * q, j = idx >> 4, nn = idx & 15; scr[idx] = w_out[(size_t)(512 + g * 128 + j) * D + n0 + nn] * pscale[g * 128 + j]; }
    LDS_WAIT(); asm volatile("" ::: "memory");
    float a0[16], a1[16];
#pragma unroll
    for (int nn = 0; nn < 16; ++nn) { a0[nn] = 0.f; a1[nn] = 0.f; }
    const float* wp0 = w_pool + (size_t)(g * 128 + lane) * 128; const float* wp1 = wp0 + 64 * 128;
    for (int j = 0; j < 128; ++j) { const float p0 = wp0[j], p1 = wp1[j];
#pragma unroll
        for (int q = 0; q < 4; ++q) { const f32x4 t = *(const LAS f32x4*)(scr + j * 16 + 4 * q);
#pragma unroll
            for (int z = 0; z < 4; ++z) { a0[4 * q + z] += p0 * t[z]; a1[4 * q + z] += p1 * t[z]; } } }
#pragma unroll
    for (int nn = 0; nn < 16; ++nn) { bf16_t* o = Wout_t + (size_t)(n0 + nn) * D + 512 + g * 128 + lane; o[0] = (bf16_t)f2bf(a0[nn]); o[64] = (bf16_t)f2bf(a1[nn]); }
    LDS_WAIT(); asm volatile("" ::: "memory");
}
constexpr int P0_CVT_E = 0;
constexpr float WSCALE = 32.f;
constexpr int CVP = 260;
__device__ __forceinline__ unsigned pk4_fp8s(float a, float b, float c, float d) { int w = 0; w = __builtin_amdgcn_cvt_pk_fp8_f32(a * WSCALE, b * WSCALE, w, false); w = __builtin_amdgcn_cvt_pk_fp8_f32(c * WSCALE, d * WSCALE, w, true); return (unsigned)w; }
struct CvtItem { const float* src; int ldw, k0, n0, e; bool gu; };
__device__ __forceinline__ CvtItem cvt_decode(Frame& F, int item) {
    CvtItem c;
    if (item < 2048) { c.gu = true; c.e = item >> 6; c.k0 = ((item >> 3) & 7) * 128; c.n0 = (item & 7) * 256; c.src = F.in[IN_WGU] + (size_t)c.e * D * 2048; c.ldw = 2048; }
    else { const int r = item - 2048 + P0_CVT_E * 32; c.gu = false; c.e = r >> 5; c.k0 = ((r >> 2) & 7) * 128; c.n0 = (r & 3) * 256; c.src = F.in[IN_WDOWN] + (size_t)c.e * DFF * D; c.ldw = D; }
    return c;
}
template <int MODE>
__device__ __forceinline__ void cvt_expert_items(Frame& F, int first, int stride, int nitems) {
    if (first >= nitems) return;
    LAS float* T = (LAS float*)F.lds;
    int tid = F.tid; asm volatile("" : "+v"(tid));
    f32x4 R[16];
    { const CvtItem c = cvt_decode(F, first);
#pragma unroll
      for (int i = 0; i < 16; ++i) { const int idx = tid + NTHR * i, kk = idx >> 6, n4 = idx & 63; R[i] = __builtin_nontemporal_load((const f32x4*)(c.src + (size_t)(c.k0 + kk) * c.ldw + c.n0 + 4 * n4)); } }
    for (int item = first; item < nitems; item += stride) {
        const CvtItem c = cvt_decode(F, item);
#pragma unroll
        for (int i = 0; i < 16; ++i) { const int idx = tid + NTHR * i, kk = idx >> 6, n4 = idx & 63; *(LAS f32x4*)(T + kk * CVP + 4 * n4) = R[i]; }
        __syncthreads();
        if (MODE != 1 && item + stride < nitems) { const CvtItem cn = cvt_decode(F, item + stride);
#pragma unroll
            for (int i = 0; i < 16; ++i) { const int idx = tid + NTHR * i, kk = idx >> 6, n4 = idx & 63; R[i] = __builtin_nontemporal_load((const f32x4*)(cn.src + (size_t)(cn.k0 + kk) * cn.ldw + cn.n0 + 4 * n4)); } }
        u32x4 o[4];
        { const int n = F.wave * 32 + (F.lane & 31), half = F.lane >> 5;
          const LAS float* col = T + (64 * half) * CVP + n;
#pragma unroll
          for (int q = 0; q < 4; ++q) { unsigned w4[4];
#pragma unroll
              for (int z = 0; z < 4; ++z) { const LAS float* p = col + (16 * q + 4 * z) * CVP; w4[z] = pk4_fp8s(p[0], p[CVP], p[2 * CVP], p[3 * CVP]); }
              o[q] = (u32x4){w4[0], w4[1], w4[2], w4[3]}; }
          __syncthreads();
          LAS unsigned char* OUTL = (LAS unsigned char*)F.lds;
#pragma unroll
          for (int q = 0; q < 4; ++q) *(LAS u32x4*)(OUTL + n * 144 + half * 64 + q * 16) = o[q]; }
        __syncthreads();
#pragma unroll
        for (int i = 0; i < 4; ++i) { const int idx = tid + NTHR * i, n = idx >> 3, ch = idx & 7;
            const u32x4 v = *(const LAS u32x4*)((const LAS unsigned char*)F.lds + n * 144 + ch * 16);
            size_t drow;
            if (c.gu) { const int jn = (c.n0 + n) & 1023; drow = (size_t)c.e * 2048 + (jn >> 7) * 256 + ((c.n0 + n) >= 1024 ? 128 : 0) + (jn & 127); }
            else drow = (size_t)c.e * D + c.n0 + n;
            if (MODE != 2 || v.x == 0x12345678u) *(u32x4*)((unsigned char*)(F.ws + (c.gu ? WS_WGU : WS_WD)) + drow * 1024 + c.k0 + ch * 16) = v; }
        __syncthreads();
    }
}

constexpr int CVH = 64 * CVP * 4;
__device__ __forceinline__ void cvt_dma_issue(Frame& F, int first, int stride, int t) {
    const CvtItem c = cvt_decode(F, first + (t >> 1) * stride); const int half = t & 1;
    LAS unsigned char* buf = F.lds + (t & 1) * CVH;
#pragma unroll
    for (int i = 0; i < 8; ++i) { const int row = 8 * F.wave + i;
        __builtin_amdgcn_global_load_lds((const unsigned*)(c.src + (size_t)(c.k0 + 64 * half + row) * c.ldw + c.n0 + 4 * F.lane), (LAS unsigned*)(buf + row * (CVP * 4)), 16, 0, 2); }
}
#define CVT_LW() asm volatile("s_waitcnt lgkmcnt(0)" ::: "memory")
#define CVT_BAR() do { __builtin_amdgcn_s_barrier(); asm volatile("" ::: "memory"); } while (0)
__device__ __forceinline__ void cvt_expert_items_dma(Frame& F, int first, int stride, int nitems) {
    if (first >= nitems) return;
    const int nh = 2 * ((nitems - first + stride - 1) / stride);
    int tid = F.tid; asm volatile("" : "+v"(tid));
    cvt_dma_issue(F, first, stride, 0); cvt_dma_issue(F, first, stride, 1);
    for (int t = 0; t < nh; ++t) {
        const CvtItem c = cvt_decode(F, first + (t >> 1) * stride); const int half = t & 1;
        LAS unsigned char* buf = F.lds + (t & 1) * CVH; const LAS float* T = (const LAS float*)buf;
        if (t + 1 < nh) asm volatile("s_waitcnt vmcnt(8)" ::: "memory"); else asm volatile("s_waitcnt vmcnt(0)" ::: "memory");
        CVT_BAR();
        u32x4 o0, o1;
        { const int n = F.wave * 32 + (F.lane & 31), kq = F.lane >> 5;
          const LAS float* col = T + (32 * kq) * CVP + n; unsigned w8[8];
#pragma unroll
          for (int z = 0; z < 8; ++z) { const LAS float* p = col + (4 * z) * CVP; w8[z] = pk4_fp8s(p[0], p[CVP], p[2 * CVP], p[3 * CVP]); }
          o0 = (u32x4){w8[0], w8[1], w8[2], w8[3]}; o1 = (u32x4){w8[4], w8[5], w8[6], w8[7]};
          CVT_LW(); CVT_BAR();
          *(LAS u32x4*)(buf + n * 80 + kq * 32) = o0; *(LAS u32x4*)(buf + n * 80 + kq * 32 + 16) = o1; }
        CVT_LW(); CVT_BAR();
#pragma unroll
        for (int i = 0; i < 2; ++i) { const int idx = tid + NTHR * i, n = idx >> 2, ch = idx & 3;
            const u32x4 v = *(const LAS u32x4*)(buf + n * 80 + ch * 16);
            size_t drow;
            if (c.gu) { const int jn = (c.n0 + n) & 1023; drow = (size_t)c.e * 2048 + (jn >> 7) * 256 + ((c.n0 + n) >= 1024 ? 128 : 0) + (jn & 127); }
            else drow = (size_t)c.e * D + c.n0 + n;
            *(u32x4*)((unsigned char*)(F.ws + (c.gu ? WS_WGU : WS_WD)) + drow * 1024 + c.k0 + 64 * half + ch * 16) = v; }
        CVT_LW(); CVT_BAR();
        if (t + 2 < nh) cvt_dma_issue(F, first, stride, t + 2);
    }
}
#undef CVT_LW
#undef CVT_BAR


__device__ __forceinline__ void p0_prologue(Frame& F, bool do_experts) {
    { bf16_t* WRT = (bf16_t*)(F.ws + WS_WRT); const float* wr = F.in[IN_WROUTER];
      for (int idx = F.vcu * NTHR + F.tid; idx < D * NE; idx += F.G * NTHR) { const int k = idx >> 5, e = idx & 31; const float v = wr[idx]; const unsigned hi = f2bf(v);
          WRT[e * D + k] = (bf16_t)hi; WRT[NE * D + e * D + k] = (bf16_t)f2bf(v - bf2f(hi)); } }
    LAS float* SL = (LAS float*)F.lds;
    for (int idx = F.tid; idx < 17 * 1024; idx += NTHR) { const int r = idx >> 10, k = idx & 1023; const float v = r < NB ? F.in[IN_C][r * D + k] : F.in[IN_CCTX][k]; SL[idx] = silu_f(v); }
    __syncthreads();
    LAS float* scr = (LAS float*)(F.lds + 69632 + F.wave * 8448);
    bf16_t* Win_t = (bf16_t*)(F.ws + WS_WIN); bf16_t* Wout_t = (bf16_t*)(F.ws + WS_WOUT); bf16_t* Wgu_t = (bf16_t*)(F.ws + WS_WGU); bf16_t* Wd_t = (bf16_t*)(F.ws + WS_WD);
    float* mod = (float*)(F.ws + WS_MOD);
    constexpr int I_MOD = NMOD / 8, I_WEFF = 4 * 64, I_WIN = 16 * (DIN / 32), I_ZERO = 224, I_WOUT = 8 * 32, I_GU = NE * 16 * 64, I_DN = NE * 16 * 32;
    const int nitems = I_MOD + I_WEFF + I_WIN + I_ZERO + I_WOUT + (do_experts ? I_GU + I_DN : 0);
    const int gw = F.wave * F.G + F.vcu, NGW = F.G * NWAVES;
    for (int it = gw; it < nitems; it += NGW) {
        int r = it;
        if (r < I_MOD) { p0_mod_item(F, r, SL, mod); continue; } r -= I_MOD;
        if (r < I_WEFF) { p0_weff_item(F, r, scr, Wout_t); continue; } r -= I_WEFF;
        if (r < I_WIN) { const int kb = r / (DIN / 32), nb = r % (DIN / 32); p0_transpose_item(F.in[IN_WIN], DIN, 64 * kb, 32 * nb, Win_t, D, win_drow(32 * nb), 0, scr, F.lane); continue; } r -= I_WIN;
        if (r < I_ZERO) { u32x4* o = (u32x4*)(Win_t + (size_t)(3 * 256 + 32 + r) * D) + F.lane * 2; o[0] = (u32x4){0u, 0u, 0u, 0u}; o[1] = (u32x4){0u, 0u, 0u, 0u}; continue; } r -= I_ZERO;
        if (r < I_WOUT) { const int kb = r / 32, nb = r % 32; p0_transpose_item(F.in[IN_WOUT], D, 64 * kb, 32 * nb, Wout_t, D, 32 * nb, 0, scr, F.lane); continue; } r -= I_WOUT;
        if (r < I_GU) { const int e = r / (16 * 64), q = r % (16 * 64), kb = q / 64, nb = q % 64, n0 = 32 * nb, jn = n0 & 1023;
            const int drow = e * 2048 + (jn >> 7) * 256 + (n0 >= 1024 ? 128 : 0) + (jn & 127);
            p0_transpose_item(F.in[IN_WGU] + (size_t)e * D * 2048, 2048, 64 * kb, n0, Wgu_t, D, drow, 0, scr, F.lane); continue; } r -= I_GU;
        { const int e = r / (16 * 32), q = r % (16 * 32), kb = q / 32, nb = q % 32;
            p0_transpose_item(F.in[IN_WDOWN] + (size_t)e * DFF * D, D, 64 * kb, 32 * nb, Wd_t, DFF, e * D + 32 * nb, 0, scr, F.lane); }
    }}

__device__ __forceinline__ void norm_row_bf16(const float* src, const float* wn, const float* sh, const float* sc, bf16_t* dst, int lane) {
    const f32x4* xr = (const f32x4*)src + lane;
    f32x4 v[4]; float s = 0.f;
#pragma unroll
    for (int j = 0; j < 4; ++j) { v[j] = xr[64 * j]; s += (v[j].x * v[j].x + v[j].y * v[j].y) + (v[j].z * v[j].z + v[j].w * v[j].w); }
    const float rstd = rsqrtf(wave_sum(s) * (1.f / D) + EPS);
    u32x2* o8 = (u32x2*)dst + lane;
#pragma unroll
    for (int j = 0; j < 4; ++j) { const f32x4 w = ((const f32x4*)wn)[lane + 64 * j], a = ((const f32x4*)sc)[lane + 64 * j], b = ((const f32x4*)sh)[lane + 64 * j];
        const f32x4 y = v[j] * rstd * w * (a + 1.f) + b; u32x2 p; p.x = pk2(y.x, y.y); p.y = pk2(y.z, y.w); o8[64 * j] = p; }
}
__device__ __forceinline__ void p1_norm1(Frame& F) {
    const float* mod = (const float*)(F.ws + WS_MOD); bf16_t* HN = (bf16_t*)(F.ws + WS_HN1);
    constexpr int RPB = NROW / 256;
    for (int blk = F.vcu; blk < 256; blk += F.G)
        for (int r = F.wave; r < RPB; r += NWAVES) { const int row = blk * RPB + r;
            const float* src = row < NTOK ? F.in[IN_X] + (size_t)row * D : F.in[IN_CTX] + (size_t)(row - NTOK) * D;
            const float* mr = mod + (size_t)(row < NTOK ? row / SEQ : NB) * NMOD;
            norm_row_bf16(src, F.in[IN_NMIX], mr, mr + 1024, HN + (size_t)row * D, F.lane); }
}

typedef __bf16 bf16x2n __attribute__((ext_vector_type(2)));
__device__ __forceinline__ unsigned pkbf(float lo, float hi) { f32x2 v = {lo, hi}; return __builtin_bit_cast(unsigned, __builtin_convertvector(v, bf16x2n)); }
#define MFMA32(a, b, c) __builtin_amdgcn_mfma_f32_32x32x16_bf16((a), (b), (c), 0, 0, 0)
constexpr int GP = 72;
constexpr int GL_QP = 0, GL_KP = 9216, GL_QQ = 18432, GL_KKT = 27648, GL_VT = 36864, GL_DEC = 55296, GL_GSUM = 55552, GL_R = 57600, GL_END = 61696;

__device__ __forceinline__ bf16x8 pack8(const f32x16& x, int s) {
    u32x4 p; p.x = pkbf(x[8 * s + 0], x[8 * s + 1]); p.y = pkbf(x[8 * s + 2], x[8 * s + 3]); p.z = pkbf(x[8 * s + 4], x[8 * s + 5]); p.w = pkbf(x[8 * s + 6], x[8 * s + 7]);
    return __builtin_bit_cast(bf16x8, p);
}
__device__ __forceinline__ bf16x8 ld_perm8(const LAS bf16_t* p) {
    const u32x2 a = *(const LAS u32x2*)p, b = *(const LAS u32x2*)(p + 8); u32x4 r; r.x = a.x; r.y = a.y; r.z = b.x; r.w = b.y; return __builtin_bit_cast(bf16x8, r);
}
__device__ __forceinline__ bf16x8 ld_nat8(const LAS bf16_t* p) { return *(const LAS bf16x8*)p; }

template <int GM>
__device__ __forceinline__ void gla_unit(Frame& F, const int unit) {
    const int b = unit >> 3, h = (unit >> 1) & 3, dir = unit & 1;
    const int w = F.wave, lane = F.lane, tid = F.tid;
    LAS unsigned char* L = F.lds;
    LAS bf16_t* QP = (LAS bf16_t*)(L + GL_QP); LAS bf16_t* KP = (LAS bf16_t*)(L + GL_KP); LAS bf16_t* QQ = (LAS bf16_t*)(L + GL_QQ);
    LAS bf16_t* KKT = (LAS bf16_t*)(L + GL_KKT); LAS bf16_t* VT = (LAS bf16_t*)(L + GL_VT);
    LAS float* DEC = (LAS float*)(L + GL_DEC); LAS float* GSUM = (LAS float*)(L + GL_GSUM); LAS float* RL = (LAS float*)(L + GL_R);
    const bf16_t* QB = (const bf16_t*)(F.ws + WS_QB); const bf16_t* KB = (const bf16_t*)(F.ws + WS_KB); const bf16_t* VB = (const bf16_t*)(F.ws + WS_VB);
    const float* RB = (const float*)(F.ws + WS_RB);
    bf16_t* OD = (bf16_t*)(F.ws + (GM >= 3 ? (dir ? 870 * MiB : 830 * MiB) : (dir ? WS_OB : WS_OF)));
    const float* wgk = F.in[dir ? IN_WGKB : IN_WGKF]; const float* bgk = F.in[dir ? IN_BGKB : IN_BGKF];
    float wg[16];
#pragma unroll
    for (int j = 0; j < 16; ++j) wg[j] = wgk[j * 256 + h * 64 + lane];
    const float bg = bgk[h * 64 + lane];
    f32x16 S0, S1;
#pragma unroll
    for (int i = 0; i < 16; ++i) { S0[i] = 0.f; S1[i] = 0.f; }
    const int tb = w >> 2, vb = w & 3, c = lane & 31, hh = lane >> 5;
    const int vs = tid >> 3, vc = tid & 7;
    unsigned pq[8], pk[8]; u32x4 pv0, pv1; f32x2 pr;
#define GLA_LOAD(step) do { const int _s = (step); const bool _ctx = _s < 4; const int _ci = _ctx ? _s : _s - 4; const int _ch = dir ? ((_ctx ? 3 : 31) - _ci) : _ci; \
        const int _row0 = _ctx ? NTOK + b * CTX + _ch * 64 : b * SEQ + _ch * 64; \
        _Pragma("unroll") for (int _i = 0; _i < 8; ++_i) { const int _t = 8 * w + _i; const size_t _row = (size_t)(_row0 + (dir ? 63 - _t : _t)); \
            pk[_i] = KB[_row * 256 + h * 64 + lane]; pq[_i] = _ctx ? 0u : (unsigned)QB[_row * 256 + h * 64 + lane]; } \
        { const size_t _row = (size_t)(_row0 + (dir ? 63 - vs : vs)); const u32x4* _vp = (const u32x4*)(VB + _row * 512 + h * 128 + vc * 16); pv0 = _vp[0]; pv1 = _vp[1]; \
          pr = *(const f32x2*)(RB + _row * 32 + dir * 16 + vc * 2); } } while (0)
    GLA_LOAD(0);
    for (int step = 0; step < 36; ++step) {
        const bool isctx = step < 4; const int ci = isctx ? step : step - 4; const int chunk = dir ? ((isctx ? 3 : 31) - ci) : ci;
        const int row0 = isctx ? NTOK + b * CTX + chunk * 64 : b * SEQ + chunk * 64;
        unsigned cq[8], ck[8]; u32x4 cv0 = pv0, cv1 = pv1;
#pragma unroll
        for (int i = 0; i < 8; ++i) { cq[i] = pq[i]; ck[i] = pk[i]; }
        *(LAS f32x2*)(RL + vs * 16 + vc * 2) = pr;
        __syncthreads();
        float cs[8];
        { float run = 0.f;
#pragma unroll
          for (int i = 0; i < 8; ++i) { const LAS f32x4* rp = (const LAS f32x4*)(RL + (8 * w + i) * 16); float x = bg;
#pragma unroll
              for (int q4 = 0; q4 < ((GM == 3) ? 1 : 4); ++q4) { const f32x4 rv = rp[q4]; x += rv[0] * wg[4 * q4 + 0] + rv[1] * wg[4 * q4 + 1] + rv[2] * wg[4 * q4 + 2] + rv[3] * wg[4 * q4 + 3]; }
              const float gk = (GM == 3) ? x * 1e-3f : (fminf(x, 0.f) - __logf(1.f + __expf(-fabsf(x)))) * (1.f / 16.f); run += gk; cs[i] = run; }
          GSUM[w * 64 + lane] = run; }
        __syncthreads();
        { float pre = 0.f, mid = 0.f, tot = 0.f;
#pragma unroll
          for (int g = 0; g < 8; ++g) { const float gsum = GSUM[g * 64 + lane]; if (g < w) pre += gsum; if (g < 4) mid += gsum; tot += gsum; }
          if (w == 0) DEC[lane] = __expf(tot);
          const float em = __expf(mid), etm = __expf(tot - mid);
          u32x4 kk4;
          float kkf[8];
#pragma unroll
          for (int i = 0; i < ((GM == 4) ? 1 : 8); ++i) { const int t = 8 * w + i; const float bc = pre + cs[i]; const float kv = bf2f(ck[i]);
              const float e2 = __expf(mid - bc); kkf[i] = kv * (e2 * etm);
              if (!isctx) { const float qv = bf2f(cq[i]) * 0.125f; const float e1 = __expf(bc - mid), e3 = e1 * em;
                  const unsigned w1 = pkbf(qv * e1, kv * e2), w2 = pkbf(qv * e3, 0.f);
                  QP[t * GP + lane] = (bf16_t)(w1 & 0xffffu); KP[t * GP + lane] = (bf16_t)(w1 >> 16); QQ[t * GP + lane] = (bf16_t)(w2 & 0xffffu); } }
          kk4.x = pkbf(kkf[0], kkf[1]); kk4.y = pkbf(kkf[2], kkf[3]); kk4.z = pkbf(kkf[4], kkf[5]); kk4.w = pkbf(kkf[6], kkf[7]);
          *(LAS u32x4*)(KKT + lane * GP + 8 * w) = kk4;
          const unsigned vw[8] = {cv0.x, cv0.y, cv0.z, cv0.w, cv1.x, cv1.y, cv1.z, cv1.w};
#pragma unroll
          for (int e = 0; e < ((GM == 4) ? 1 : 8); ++e) { VT[(vc * 16 + 2 * e) * GP + vs] = (bf16_t)(vw[e] & 0xffffu); VT[(vc * 16 + 2 * e + 1) * GP + vs] = (bf16_t)(vw[e] >> 16); } }
        if (step + 1 < 36) GLA_LOAD(step + 1);
        __syncthreads();
        if (!isctx && GM != 1) {
            f32x16 O;
#pragma unroll
            for (int i = 0; i < 16; ++i) O[i] = 0.f;
#pragma unroll
            for (int s = 0; s < 2; ++s) { O = MFMA32(ld_perm8(QQ + (32 * tb + c) * GP + 16 * s + 4 * hh), pack8(S0, s), O);
                                          O = MFMA32(ld_perm8(QQ + (32 * tb + c) * GP + 32 + 16 * s + 4 * hh), pack8(S1, s), O); }
#pragma unroll
            for (int sb = 0; sb < 2; ++sb) { if (sb > tb) continue;
                f32x16 X;
#pragma unroll
                for (int i = 0; i < 16; ++i) X[i] = 0.f;
#pragma unroll
                for (int s = 0; s < 4; ++s) X = MFMA32(ld_nat8(KP + (32 * sb + c) * GP + 16 * s + 8 * hh), ld_nat8(QP + (32 * tb + c) * GP + 16 * s + 8 * hh), X);
                if (sb == tb) {
#pragma unroll
                    for (int r = 0; r < 16; ++r) { const int sl = (r & 3) + 8 * (r >> 2) + 4 * hh; X[r] = (sl <= c) ? X[r] : 0.f; } }
#pragma unroll
                for (int s = 0; s < 2; ++s) O = MFMA32(pack8(X, s), ld_perm8(VT + (32 * vb + c) * GP + 32 * sb + 16 * s + 4 * hh), O);
            }
#pragma unroll
            for (int r = 0; r < ((GM == 2) ? 1 : 16); ++r) { const int t = 32 * tb + (r & 3) + 8 * (r >> 2) + 4 * hh; const size_t row = (size_t)(row0 + (dir ? 63 - t : t));
                OD[row * 512 + h * 128 + 32 * vb + c] = (bf16_t)(pkbf(O[r], 0.f) & 0xffffu); }
        }
        if (GM != 1) {
#pragma unroll
            for (int g4 = 0; g4 < 4; ++g4) { const f32x4 d0 = *(const LAS f32x4*)(DEC + 8 * g4 + 4 * hh), d1 = *(const LAS f32x4*)(DEC + 32 + 8 * g4 + 4 * hh);
#pragma unroll
                for (int z = 0; z < 4; ++z) { S0[4 * g4 + z] *= d0[z]; S1[4 * g4 + z] *= d1[z]; } }
#pragma unroll
            for (int s = 0; s < 4; ++s) { const bf16x8 vf = ld_nat8(VT + (32 * vb + c) * GP + 16 * s + 8 * hh);
                S0 = MFMA32(ld_nat8(KKT + c * GP + 16 * s + 8 * hh), vf, S0);
                S1 = MFMA32(ld_nat8(KKT + (32 + c) * GP + 16 * s + 8 * hh), vf, S1); }
        }
    }
#undef GLA_LOAD
    __syncthreads();
}

constexpr int PRS = 72 * 2;
__device__ __forceinline__ int pslot(int x) { return 2 * (x + (x >> 3)); }
template <int G_>
__device__ __forceinline__ void pool_unit_g(Frame& F, const int cblk, const int b) {
    constexpr int g = G_, wdw = 2 << g, lo = wdw >> 1, hi = wdw - 1 - lo;
    LAS f32x4* X = (LAS f32x4*)F.lds;
    LAS f32x4* H = (LAS f32x4*)(F.lds + 73728);
    const bf16_t* PB = (const bf16_t*)(F.ws + WS_PB) + ((size_t)((b * 4 + g) * 16 + cblk) * 2048) * 8;
    bf16_t* MIX = (bf16_t*)(F.ws + WS_MIX);
    int tid = F.tid; asm volatile("" : "+v"(tid));
#pragma unroll
    for (int i = 0; i < 4; ++i) { const int tok = tid + 512 * i, r = tok >> 6, x = tok & 63; const u32x4 v = *(const u32x4*)(PB + (size_t)tok * 8);
        LAS f32x4* p = X + r * PRS + pslot(x);
        p[0] = (f32x4){bflo(v.x), bfhi(v.x), bflo(v.y), bfhi(v.y)}; p[1] = (f32x4){bflo(v.z), bfhi(v.z), bflo(v.w), bfhi(v.w)}; }
    __syncthreads();
    { const int q = tid & 1, cs = (tid >> 1) & 7, r = tid >> 4; const LAS f32x4* xr = X + r * PRS + q; LAS f32x4* hr = H + r * PRS + q;
      const int c0 = 8 * cs; f32x4 s = {0.f, 0.f, 0.f, 0.f};
#pragma unroll
      for (int d = -lo; d <= hi; ++d) { const int x = c0 + d; const bool ok = (x >= 0) && (x < GW); const int xc = x < 0 ? 0 : (x > GW - 1 ? GW - 1 : x); const f32x4 v = xr[pslot(xc)]; s += ok ? v : (f32x4){0.f, 0.f, 0.f, 0.f}; if (((d + lo) & 3) == 3) asm volatile("" ::: "memory"); }
      hr[pslot(c0)] = s;
#pragma unroll
      for (int j = 1; j < 8; ++j) { const int xin = c0 + j + hi, xout = c0 + j - 1 - lo; const bool oki = xin < GW, oko = xout >= 0;
          const f32x4 vi = xr[pslot(oki ? xin : GW - 1)], vo = xr[pslot(oko ? xout : 0)];
          s += oki ? vi : (f32x4){0.f, 0.f, 0.f, 0.f}; s -= oko ? vo : (f32x4){0.f, 0.f, 0.f, 0.f}; hr[pslot(c0 + j)] = s; } }
    __syncthreads();
    { const int q = tid & 1, cc = (tid >> 1) & 63, rs = tid >> 7; const int col = pslot(cc) + q; const int r0s = 8 * rs;
      const int c0 = max(cc - lo, 0), c1 = min(cc + hi + 1, GW); const float ncol = (float)(c1 - c0);
      f32x4 s = {0.f, 0.f, 0.f, 0.f};
#pragma unroll
      for (int d = -lo; d <= hi; ++d) { const int y = r0s + d; const bool ok = (y >= 0) && (y < GROWS); const int yc = y < 0 ? 0 : (y > GROWS - 1 ? GROWS - 1 : y); const f32x4 v = H[yc * PRS + col]; s += ok ? v : (f32x4){0.f, 0.f, 0.f, 0.f}; if (((d + lo) & 3) == 3) asm volatile("" ::: "memory"); }
#pragma unroll
      for (int j = 0; j < 8; ++j) { const int r = r0s + j;
          if (j > 0) { const int yin = r + hi, yout = r - 1 - lo; const bool oki = yin < GROWS, oko = yout >= 0;
              const f32x4 vi = H[(oki ? yin : GROWS - 1) * PRS + col], vo = H[(oko ? yout : 0) * PRS + col];
              s += oki ? vi : (f32x4){0.f, 0.f, 0.f, 0.f}; s -= oko ? vo : (f32x4){0.f, 0.f, 0.f, 0.f}; }
          const int ra = max(r - lo, 0), rb = min(r + hi + 1, GROWS);
          const float inv = 1.f / ((float)(rb - ra) * ncol);
          const f32x4 o = s * inv - X[r * PRS + col];
          u32x2 pw; pw.x = pkbf(o[0], o[1]); pw.y = pkbf(o[2], o[3]);
          *(u32x2*)(MIX + (size_t)(b * SEQ + r * GW + cc) * D + 512 + g * 128 + cblk * 8 + q * 4) = pw; } }
    __syncthreads();
}
__device__ __forceinline__ void pool_unit(Frame& F, const int unit) {
    const int g = unit & 3, cblk = (unit >> 2) & 15, b = unit >> 6;
    if (g == 0) pool_unit_g<0>(F, cblk, b); else if (g == 1) pool_unit_g<1>(F, cblk, b); else if (g == 2) pool_unit_g<2>(F, cblk, b); else pool_unit_g<3>(F, cblk, b);
}

__device__ __forceinline__ void p4_gla_out(Frame& F) {
    const bf16_t* OFp = (const bf16_t*)(F.ws + WS_OF); const bf16_t* OBp = (const bf16_t*)(F.ws + WS_OB); const bf16_t* GB = (const bf16_t*)(F.ws + WS_GB);
    bf16_t* MIX = (bf16_t*)(F.ws + WS_MIX); const float* wn = F.in[IN_GLANW];
    const int lane = F.lane, gw = F.vcu * NWAVES + F.wave, NGW = F.G * NWAVES;
    const f32x4 w0 = *(const f32x4*)(wn + (lane & 15) * 8), w1 = *(const f32x4*)(wn + (lane & 15) * 8 + 4);
    for (int tok = gw; tok < NTOK; tok += NGW) {
        const u32x4 fa = *((const u32x4*)(OFp + (size_t)tok * 512) + lane), fb = *((const u32x4*)(OBp + (size_t)tok * 512) + lane);
        const f32x4 o0 = (f32x4){bflo(fa.x) + bflo(fb.x), bfhi(fa.x) + bfhi(fb.x), bflo(fa.y) + bflo(fb.y), bfhi(fa.y) + bfhi(fb.y)};
        const f32x4 o1 = (f32x4){bflo(fa.z) + bflo(fb.z), bfhi(fa.z) + bfhi(fb.z), bflo(fa.w) + bflo(fb.w), bfhi(fa.w) + bfhi(fb.w)};
        const u32x4 gv = *((const u32x4*)(GB + (size_t)tok * 512) + lane);
        float ss = (o0[0] * o0[0] + o0[1] * o0[1]) + (o0[2] * o0[2] + o0[3] * o0[3]) + (o1[0] * o1[0] + o1[1] * o1[1]) + (o1[2] * o1[2] + o1[3] * o1[3]);
        ss += __shfl_xor(ss, 1); ss += __shfl_xor(ss, 2); ss += __shfl_xor(ss, 4); ss += __shfl_xor(ss, 8);
        const float rstd = rsqrtf(ss * (1.f / 128.f) + EPS);
        const float gg[8] = {bflo(gv.x), bfhi(gv.x), bflo(gv.y), bfhi(gv.y), bflo(gv.z), bfhi(gv.z), bflo(gv.w), bfhi(gv.w)};
        float y[8];
#pragma unroll
        for (int j = 0; j < 4; ++j) { y[j] = o0[j] * rstd * w0[j] * silu_f(gg[j]); y[4 + j] = o1[j] * rstd * w1[j] * silu_f(gg[4 + j]); }
        u32x4 pw; pw.x = pkbf(y[0], y[1]); pw.y = pkbf(y[2], y[3]); pw.z = pkbf(y[4], y[5]); pw.w = pkbf(y[6], y[7]);
        *((u32x4*)(MIX + (size_t)tok * D) + lane) = pw;
    }
}

constexpr int P6_AP = 1032;
constexpr int L6_AH = 0, L6_AL = 32 * P6_AP * 2, L6_LG = 2 * L6_AL;
constexpr int L6_REC = L6_LG + 128 * 33 * 4;
constexpr int L6_RED = 0;
static_assert(L6_REC + 4096 <= LDSCTL_OFF && 8 * 32 * 33 * 4 <= L6_LG, "P6 LDS map");
__device__ __forceinline__ void p6_router(Frame& F) {
    LAS bf16_t* AH = (LAS bf16_t*)(F.lds + L6_AH); LAS bf16_t* AL = (LAS bf16_t*)(F.lds + L6_AL); LAS float* LG = (LAS float*)(F.lds + L6_LG); LAS float* RED = (LAS float*)(F.lds + L6_RED);
    LAS unsigned* REC = (LAS unsigned*)(F.lds + L6_REC); LAS float* RECW = (LAS float*)(F.lds + L6_REC + 2048);
    LAS int* LCNT = (LAS int*)(F.lds + LDSCTL_OFF) + LC_CNT; LAS int* GBASE = LCNT + 32;
    const float* b_router = F.in[IN_BROUTER]; const float* wn = F.in[IN_NMLP];
    const float* mod = (const float*)(F.ws + WS_MOD); const float* h1 = F.out;
    unsigned char* HN2 = (unsigned char*)(F.ws + WS_HN2);
    int* gcnt = (int*)(F.ws + WS_CTL) + CW_CNT; int* list = (int*)(F.ws + WS_LIST); unsigned* ASG = (unsigned*)(F.ws + WS_ASG); float* TOPW = (float*)(F.ws + WS_TOPW);
    const int lane = F.lane, w = F.wave, tid = F.tid, c = lane & 31, hh = lane >> 5;
    bf16x8 bh[8], bl[8];
    { const bf16_t* WRT = (const bf16_t*)(F.ws + WS_WRT);
#pragma unroll
      for (int s = 0; s < 8; ++s) { bh[s] = *(const bf16x8*)(WRT + c * D + 128 * w + 16 * s + 8 * hh); bl[s] = *(const bf16x8*)(WRT + NE * D + c * D + 128 * w + 16 * s + 8 * hh); } }
    const f32x4 wn4[4] = {((const f32x4*)wn)[lane], ((const f32x4*)wn)[lane + 64], ((const f32x4*)wn)[lane + 128], ((const f32x4*)wn)[lane + 192]};
    for (int tblk = F.vcu; tblk < NTOK / 128; tblk += F.G) {
        if (tid < 32) LCNT[tid] = 0;
        const float* mrow = mod + (size_t)((tblk * 128) >> 11) * NMOD;
        f32x4 sc4[4], sh4[4];
#pragma unroll
        for (int j = 0; j < 4; ++j) { sc4[j] = ((const f32x4*)(mrow + 4096))[lane + 64 * j] + 1.f; sh4[j] = ((const f32x4*)(mrow + 3072))[lane + 64 * j]; }
        f32x4 hn[4];
        { const f32x4* xr = (const f32x4*)(h1 + (size_t)(tblk * 128 + 4 * w) * D) + lane;
#pragma unroll
          for (int j = 0; j < 4; ++j) hn[j] = xr[64 * j]; }
        for (int tile = 0; tile < 4; ++tile) {
#pragma unroll 1
            for (int q = 0; q < 4; ++q) { const int tl = 4 * w + q, tok = tblk * 128 + tile * 32 + tl;
                f32x4 hv[4]; float s = 0.f;
#pragma unroll
                for (int j = 0; j < 4; ++j) { hv[j] = hn[j]; s += (hv[j].x * hv[j].x + hv[j].y * hv[j].y) + (hv[j].z * hv[j].z + hv[j].w * hv[j].w); }
                { const int nq = tile * 4 + q + 1; if (nq < 16) { const int ntok = tblk * 128 + (nq >> 2) * 32 + 4 * w + (nq & 3); const f32x4* xr = (const f32x4*)(h1 + (size_t)ntok * D) + lane;
#pragma unroll
                    for (int j = 0; j < 4; ++j) hn[j] = xr[64 * j]; } }
                const float rstd = rsqrtf(wave_sum(s) * (1.f / D) + EPS);
                unsigned* o4 = (unsigned*)(HN2 + (size_t)tok * D) + lane;
#pragma unroll
                for (int j = 0; j < 4; ++j) { const f32x4 y = hv[j] * rstd * wn4[j] * sc4[j] + sh4[j];
                    o4[64 * j] = pg8::pk4_fp8(y.x, y.y, y.z, y.w);
                    u32x2 hi2; hi2.x = pkbf(y.x, y.y); hi2.y = pkbf(y.z, y.w);
                    u32x2 lo2; lo2.x = pkbf(y.x - bflo(hi2.x), y.y - bfhi(hi2.x)); lo2.y = pkbf(y.z - bflo(hi2.y), y.w - bfhi(hi2.y));
                    *(LAS u32x2*)(AH + tl * P6_AP + 4 * lane + 256 * j) = hi2; *(LAS u32x2*)(AL + tl * P6_AP + 4 * lane + 256 * j) = lo2; } }
            __syncthreads();
            f32x16 Dp;
#pragma unroll
            for (int i = 0; i < 16; ++i) Dp[i] = 0.f;
#pragma unroll
            for (int s = 0; s < 8; ++s) { const bf16x8 ah = *(const LAS bf16x8*)(AH + c * P6_AP + 128 * w + 16 * s + 8 * hh), al = *(const LAS bf16x8*)(AL + c * P6_AP + 128 * w + 16 * s + 8 * hh);
                Dp = MFMA32(ah, bh[s], Dp); Dp = MFMA32(ah, bl[s], Dp); Dp = MFMA32(al, bh[s], Dp); }
            __syncthreads();
#pragma unroll
            for (int r = 0; r < 16; ++r) RED[w * (32 * 33) + ((r & 3) + 8 * (r >> 2) + 4 * hh) * 33 + c] = Dp[r];
            __syncthreads();
            { const int tl = tid >> 4, e0 = tid & 15; float a0 = 0.f, a1 = 0.f;
#pragma unroll
              for (int ww = 0; ww < 8; ++ww) { a0 += RED[ww * (32 * 33) + tl * 33 + e0]; a1 += RED[ww * (32 * 33) + tl * 33 + e0 + 16]; }
              LG[(tile * 32 + tl) * 33 + e0] = a0 + b_router[e0]; LG[(tile * 32 + tl) * 33 + e0 + 16] = a1 + b_router[e0 + 16]; }
            __syncthreads();
        }
        if (tid < 128) { float lgv[32];
#pragma unroll
            for (int e = 0; e < 32; ++e) lgv[e] = LG[tid * 33 + e];
            int se[4]; float sv[4];
#pragma unroll
            for (int r = 0; r < 4; ++r) { float bv = -3.0e38f; int bi = 0;
#pragma unroll
                for (int e = 0; e < 32; ++e) { bool ok = lgv[e] > bv;
#pragma unroll
                    for (int q = 0; q < r; ++q) ok = ok && (se[q] != e);
                    bv = ok ? lgv[e] : bv; bi = ok ? e : bi; }
                se[r] = bi; sv[r] = bv; }
            float ex[4], den = 0.f;
#pragma unroll
            for (int r = 0; r < 4; ++r) { ex[r] = __expf(sv[r] - sv[0]); den += ex[r]; }
            const float inv = 1.f / den;
#pragma unroll
            for (int r = 0; r < 4; ++r) { const int lp = __hip_atomic_fetch_add(&LCNT[se[r]], 1, __ATOMIC_RELAXED, __HIP_MEMORY_SCOPE_WORKGROUP);
                REC[tid * 4 + r] = ((unsigned)se[r] << 16) | (unsigned)lp; RECW[tid * 4 + r] = ex[r] * inv; } }
        __syncthreads();
        { int t2 = tid; asm volatile("" : "+v"(t2)); if (t2 < 32) GBASE[t2] = atomicAdd(&gcnt[64 * t2], LCNT[t2]); }
        __syncthreads();
        { const unsigned rec = REC[tid]; const int e = rec >> 16, pos = GBASE[e] + (int)(rec & 0xffffu), aid = tblk * 512 + tid;
          list[e * NTOK + pos] = aid; ASG[aid] = ((unsigned)e << 16) | (unsigned)pos; TOPW[aid] = RECW[tid]; }
        __syncthreads();
    }
}
__device__ __forceinline__ void moe_tables(Frame& F) {
    LAS int* TST = (LAS int*)(F.lds + LDSCTL_OFF) + LC_TST; LAS int* LCNT = (LAS int*)(F.lds + LDSCTL_OFF) + LC_CNT;
    const int* gcnt = (const int*)(F.ws + WS_CTL) + CW_CNT;
    if (F.tid < 64) {
        const int lane = F.lane; const int c = lane < NE ? gcnt[64 * lane] : 0; const int mt = (c + 255) >> 8; int inc = mt;
#pragma unroll
        for (int o = 1; o < 32; o <<= 1) { const int up = __shfl_up(inc, o); if (lane >= o) inc += up; }
        if (lane < NE) { LCNT[lane] = c; TST[lane] = inc - mt; }
        if (lane == NE - 1) TST[NE] = inc;
    }
    __syncthreads();
}
__device__ __forceinline__ f32x4 fp8x4_to_f32(unsigned w) { const f32x2 lo = __builtin_amdgcn_cvt_pk_f32_fp8((int)w, false), hi = __builtin_amdgcn_cvt_pk_f32_fp8((int)w, true); return (f32x4){lo.x, lo.y, hi.x, hi.y}; }
__device__ __forceinline__ void p9_final(Frame& F) {
    const LAS int* TST = (const LAS int*)(F.lds + LDSCTL_OFF) + LC_TST;
    const unsigned* ASG = (const unsigned*)(F.ws + WS_ASG); const float* TOPW = (const float*)(F.ws + WS_TOPW); const unsigned char* Y = (const unsigned char*)(F.ws + WS_Y);
    const float* mod = (const float*)(F.ws + WS_MOD); const float* fw = F.in[IN_FNW]; float* out = F.out;
    const int lane = F.lane, gw = F.vcu * NWAVES + F.wave, NGW = F.G * NWAVES;
    f32x4 fwv[4];
#pragma unroll
    for (int j = 0; j < 4; ++j) fwv[j] = ((const f32x4*)fw)[lane + 64 * j];
    for (int tok0 = gw; tok0 < NTOK; tok0 += 2 * NGW) {
        int tk[2]; tk[0] = tok0; tk[1] = (tok0 + NGW < NTOK) ? tok0 + NGW : tok0;
        unsigned yv[2][4][4]; float wg[2][4]; f32x4 xv[2][4], gv[2][4];
#pragma unroll
        for (int u = 0; u < 2; ++u) { const u32x4 a4 = *(const u32x4*)(ASG + (size_t)tk[u] * 4); const f32x4 w4 = *(const f32x4*)(TOPW + (size_t)tk[u] * 4);
            const unsigned aa[4] = {a4.x, a4.y, a4.z, a4.w};
#pragma unroll
            for (int r = 0; r < 4; ++r) { const unsigned a = (unsigned)__builtin_amdgcn_readfirstlane((int)aa[r]); wg[u][r] = w4[r];
                const size_t row = (size_t)TST[a >> 16] * 256 + (a & 0xffffu); const unsigned* yp = (const unsigned*)(Y + row * D) + lane;
#pragma unroll
                for (int j = 0; j < 4; ++j) yv[u][r][j] = yp[64 * j]; }
            const f32x4* xr = (const f32x4*)(out + (size_t)tk[u] * D) + lane; const f32x4* g2 = (const f32x4*)(mod + (size_t)(tk[u] >> 11) * NMOD + 5120) + lane;
#pragma unroll
            for (int j = 0; j < 4; ++j) { xv[u][j] = xr[64 * j]; gv[u][j] = g2[64 * j]; } }
#pragma unroll
        for (int u = 0; u < 2; ++u) { f32x4 v[4]; float s = 0.f;
#pragma unroll
            for (int j = 0; j < 4; ++j) { f32x4 acc = fp8x4_to_f32(yv[u][0][j]) * wg[u][0];
#pragma unroll
                for (int r = 1; r < 4; ++r) acc += fp8x4_to_f32(yv[u][r][j]) * wg[u][r];
                v[j] = xv[u][j] + gv[u][j] * acc; s += (v[j].x * v[j].x + v[j].y * v[j].y) + (v[j].z * v[j].z + v[j].w * v[j].w); }
            const float rstd = rsqrtf(wave_sum(s) * (1.f / D) + EPS);
            if (u == 0 || tk[1] != tk[0]) { f32x4* xo = (f32x4*)(out + (size_t)tk[u] * D) + lane;
#pragma unroll
                for (int j = 0; j < 4; ++j) xo[64 * j] = v[j] * rstd * fwv[j]; } }
    }
}

#ifndef MK_N_LAUNCHES
#define MK_N_LAUNCHES 1
#endif
constexpr int N_PHASES = 10;
#ifndef PROBE_TWICE
#define PROBE_TWICE -1
#endif
__global__ void __launch_bounds__(NTHR, 2) mk_fwd(Args args) {
    extern __shared__ __attribute__((aligned(16))) unsigned char lds_raw[];
    Frame F;
    F.lds = (LAS unsigned char*)lds_raw;
    F.tid = threadIdx.x; F.lane = F.tid & 63; F.wave = __builtin_amdgcn_readfirstlane(F.tid >> 6);
    F.G = gridDim.x; { const int bx = blockIdx.x; F.vcu = (F.G % 8 == 0) ? (bx % 8) * (F.G / 8) + bx / 8 : bx; }
    F.in = args.in; F.out = args.out; F.ws = args.ws;
    for (int u = F.tid; u < (LDS_BYTES - LDSCTL_OFF) / 4; u += NTHR) ((LAS unsigned*)(F.lds + LDSCTL_OFF))[u] = 0u;
    __syncthreads();
    const int lo = args.ph_lo, hi = args.ph_hi;
    XcdBarrier bar; bar.bar = (unsigned*)(F.ws + WS_CTL) + CW_BAR; bar.x = 0; bar.st = nullptr;
    if (hi - lo > 1) bar = xcd_barrier_post((unsigned*)(F.ws + WS_CTL) + CW_BAR, (volatile LAS unsigned*)(F.lds + LDSCTL_OFF) + LC_BAR);
#define IN(k) (lo <= (k) && (k) < hi)
#define SEAM(k) do { if (IN(k) && IN((k) + 1)) xcd_barrier(bar); } while (0)
    if (IN(0)) { p0_prologue(F, false); } SEAM(0);
    if (IN(1)) { p1_norm1(F); } SEAM(1);
    if (IN(2)) for (int rep_ = 0; rep_ < (PROBE_TWICE == 2 ? 2 : 1); ++rep_) { if (rep_) xcd_barrier(bar);
        pg8::SchedInProj S{F.G, (int)blockIdx.x};
        pg8::EpiInProj E{(bf16_t*)(F.ws + WS_KB), (bf16_t*)(F.ws + WS_VB), (bf16_t*)(F.ws + WS_QB), (bf16_t*)(F.ws + WS_GB), (bf16_t*)(F.ws + WS_PB), (float*)(F.ws + WS_RB)};
        pg8::gemm_phase<pg8::EpiInProj, pg8::SchedInProj, true, false>(F.lds, (const char*)(F.ws + WS_HN1), (const char*)(F.ws + WS_WIN), D * 2, S, E);
    } SEAM(2);
    if (IN(3)) {
        const int bx = blockIdx.x, nG = (F.G + 1) >> 1, nP = F.G - nG;
        constexpr int CVT_N = 2048 + 1024, CVT_ODD = 2560, CVT_ODD2 = CVT_ODD + 256;
        if ((bx & 1) == 0) { for (int u = bx >> 1; u < NB * 8; u += nG) gla_unit<0>(F, u);
#if PROBE_TWICE == 38
                             for (int u = bx >> 1; u < NB * 8; u += nG) gla_unit<0>(F, u);
#endif
                             cvt_expert_items_dma(F, CVT_ODD2 + (bx >> 1), nG, CVT_N); }
        else { for (int u = bx >> 1; u < NB * 64; u += nP) pool_unit(F, u);
#if PROBE_TWICE == 37
               for (int u = bx >> 1; u < NB * 64; u += nP) pool_unit(F, u);
#endif
               cvt_expert_items_dma(F, bx >> 1, nP, CVT_ODD);
               if ((bx >> 1) >= 64) cvt_expert_items_dma(F, CVT_ODD + (bx >> 1) - 64, 64, CVT_ODD2);
#if PROBE_TWICE == 36
               __syncthreads(); cvt_expert_items_dma(F, bx >> 1, nP, CVT_ODD);
#endif
               __syncthreads();
               for (int rep_ = 0; rep_ < (PROBE_TWICE == 35 ? 2 : 1); ++rep_)
               { pg8::SchedInProjG S{nP, bx >> 1};
                 pg8::EpiInProj E{(bf16_t*)(F.ws + WS_KB), (bf16_t*)(F.ws + WS_VB), (bf16_t*)(F.ws + WS_QB), (bf16_t*)(F.ws + WS_GB), (bf16_t*)(F.ws + WS_PB), (float*)(F.ws + WS_RB)};
                 pg8::gemm_phase<pg8::EpiInProj, pg8::SchedInProjG, true, false>(F.lds, (const char*)(F.ws + WS_HN1), (const char*)(F.ws + WS_WIN), D * 2, S, E); } }
    } SEAM(3);
    if (IN(4)) { p4_gla_out(F); } SEAM(4);
    if (IN(5)) {
        pg8::SchedPlain S{F.G, (int)blockIdx.x, NTOK / 256, D / 256};
        pg8::EpiResid E{F.in[IN_X], (const float*)(F.ws + WS_MOD), F.out};
        pg8::gemm_phase<pg8::EpiResid, pg8::SchedPlain, true, false>(F.lds, (const char*)(F.ws + WS_MIX), (const char*)(F.ws + WS_WOUT), D * 2, S, E);
    } SEAM(5);
    if (IN(6)) { p6_router(F); } SEAM(6);
    const LAS int* TST = (const LAS int*)(F.lds + LDSCTL_OFF) + LC_TST; const LAS int* LCN = (const LAS int*)(F.lds + LDSCTL_OFF) + LC_CNT;
    if (IN(7)) {
        moe_tables(F);
        pg8::SchedMoE<8, true> S{F.G, (int)blockIdx.x, TST, LCN, (const int*)(F.ws + WS_LIST)};
        pg8::EpiSwiglu<true> E{(void*)(F.ws + WS_ACT), F.in[IN_BGU], 1.f / WSCALE};
        pg8::gemm_phase<pg8::EpiSwiglu<true>, pg8::SchedMoE<8, true>, true, true>(F.lds, (const char*)(F.ws + WS_HN2), (const char*)(F.ws + WS_WGU), D, S, E);
    } SEAM(7);
    if (IN(8)) {
        moe_tables(F);
        pg8::SchedMoE<4, false> S{F.G, (int)blockIdx.x, TST, LCN, nullptr};
        pg8::EpiDown E{(unsigned char*)(F.ws + WS_Y), F.in[IN_BDOWN], 1.f / WSCALE};
        pg8::gemm_phase<pg8::EpiDown, pg8::SchedMoE<4, false>, true, true>(F.lds, (const char*)(F.ws + WS_ACT), (const char*)(F.ws + WS_WD), DFF, S, E);
    } SEAM(8);
    if (IN(9)) { moe_tables(F); p9_final(F); }
#undef IN
#undef SEAM
}

extern "C" void kernel_launch(void* const* d_in, const int* in_sizes, int n_in, void* d_out, int out_size, void* d_ws, size_t ws_size, hipStream_t stream) {
    static int grid = 0;
    if (grid == 0) {
        if (n_in != 24 || ws_size < WS_END || out_size != NTOK * D) { fprintf(stderr, "kernel_launch: unexpected n_in %d / ws_size %zu / out %d\n", n_in, ws_size, out_size); grid = -1; return; }
        int dev = 0, cus = 0, per_cu = 0;
        if (hipGetDevice(&dev) != hipSuccess || hipDeviceGetAttribute(&cus, hipDeviceAttributeMultiprocessorCount, dev) != hipSuccess) { grid = -1; return; }
        if (hipFuncSetAttribute((const void*)mk_fwd, hipFuncAttributeMaxDynamicSharedMemorySize, LDS_BYTES) != hipSuccess) { fprintf(stderr, "kernel_launch: hipFuncSetAttribute failed\n"); grid = -1; return; }
        if (hipOccupancyMaxActiveBlocksPerMultiprocessor(&per_cu, (const void*)mk_fwd, NTHR, LDS_BYTES) != hipSuccess || per_cu < 1) { fprintf(stderr, "kernel_launch: occupancy query says %d workgroups per CU\n", per_cu); (void)hipGetLastError(); grid = -1; return; }
        (void)hipGetLastError();
        grid = cus;
    }
    if (grid < 0) return;
    (void)hipMemsetAsync((char*)d_ws + WS_CTL, 0, 1 * MiB, stream);
    Args a{};
    for (int i = 0; i < 24; ++i) a.in[i] = (const float*)d_in[i];
    a.out = (float*)d_out; a.ws = (unsigned char*)d_ws;
    if (MK_N_LAUNCHES == 1) {
        a.ph_lo = 0; a.ph_hi = N_PHASES;
        void* kargs[] = {&a};
        const hipError_t e = hipLaunchCooperativeKernel((const void*)mk_fwd, dim3(grid), dim3(NTHR), kargs, LDS_BYTES, stream);
        if (e != hipSuccess) fprintf(stderr, "kernel_launch: cooperative launch failed: %s (grid %d)\n", hipGetErrorString(e), grid);
    } else {
        for (int ph = 0; ph < N_PHASES; ++ph) { a.ph_lo = ph; a.ph_hi = ph + 1; hipLaunchKernelGGL(mk_fwd, dim3(grid), dim3(NTHR), LDS_BYTES, stream, a); }
    }
}
```

```cpp
#include <hip/hip_runtime.h>
#include <stdint.h>
#include <stdio.h>

#define LAS __attribute__((address_space(3)))
#define GAS __attribute__((address_space(1)))
typedef unsigned short bf16_t;
typedef short bf16x8 __attribute__((ext_vector_type(8)));
typedef float f32x4 __attribute__((ext_vector_type(4)));
typedef float f32x2 __attribute__((ext_vector_type(2)));
typedef float f32x16 __attribute__((ext_vector_type(16)));
typedef unsigned u32x4 __attribute__((ext_vector_type(4)));
typedef unsigned u32x2 __attribute__((ext_vector_type(2)));

constexpr int D = 1024, NB = 16, SEQ = 2048, CTX = 256;
constexpr int NTOK = NB * SEQ, NCTX = NB * CTX, NROW = NTOK + NCTX;
constexpr int DIN = 2080, NE = 32, DFF = 1024;
constexpr int GW = 64, GROWS = 32;
constexpr int NMOD = 6144;
constexpr float EPS = 1e-6f;
constexpr int NWAVES = 8, NTHR = 512;
constexpr int WIN_N = 2304;
constexpr int NPADROWS = NTOK * 4 + NE * 256;

__device__ __forceinline__ unsigned f2bf(float f) { unsigned u = __builtin_bit_cast(unsigned, f); return (u + 0x7fffu + ((u >> 16) & 1u)) >> 16; }
__device__ __forceinline__ unsigned pk2(float lo, float hi) { return f2bf(lo) | (f2bf(hi) << 16); }
__device__ __forceinline__ float bf2f(unsigned v) { return __builtin_bit_cast(float, v << 16); }
__device__ __forceinline__ float bflo(unsigned w) { return __builtin_bit_cast(float, w << 16); }
__device__ __forceinline__ float bfhi(unsigned w) { return __builtin_bit_cast(float, w & 0xffff0000u); }
__device__ __forceinline__ unsigned cvt_pk_bf16(float lo, float hi) { unsigned r; asm volatile("v_cvt_pk_bf16_f32 %0, %1, %2" : "=v"(r) : "v"(lo), "v"(hi)); return r; }
__device__ __forceinline__ float wave_sum(float v) {
#pragma unroll
    for (int o = 1; o < 64; o <<= 1) v += __shfl_xor(v, o);
    return v;
}
__device__ __forceinline__ float silu_f(float x) { return x / (1.f + __expf(-x)); }
__device__ __forceinline__ float logsigmoid_f(float x) { return fminf(x, 0.f) - log1pf(expf(-fabsf(x))); }
#define LDS_WAIT() asm volatile("s_waitcnt lgkmcnt(0)" ::: "memory")
#define VM_WAIT() asm volatile("s_waitcnt vmcnt(0)" ::: "memory")

namespace pg8 {
constexpr int BM = 256, BK = 64, HALF = 128, HTB = HALF * BK * 2  , STAGE_BYTES = 8 * HTB, NXCD = 8, WGM = 8;
__host__ __device__ __forceinline__ int lds_byte(int r, int c) { const int st = (r >> 4) * 2 + (c >> 5), rr = r & 15, cc = c & 31, ob = rr * 64 + cc * 2; return st * 1024 + (ob ^ (((ob >> 9) & 1) << 5)); }
__host__ __device__ __forceinline__ void stage_rc(int b, int& R, int& C) { const int st = b / 1024, sb = b % 1024, swz = sb ^ (((sb >> 9) & 1) << 5); R = (st >> 1) * 16 + swz / 64; C = (st & 1) * 32 + (swz % 64) / 2; }
__host__ __device__ __forceinline__ int perm32(int rho) { const int n = rho >> 4, i = rho & 15; return 8 * (i >> 2) + 4 * n + (i & 3); }

struct Unit { int pm, pn, arow, bt, nvalid, e; };

typedef int i32x8 __attribute__((ext_vector_type(8)));
typedef int i32x4v __attribute__((ext_vector_type(4)));
__device__ __forceinline__ i32x8 cat8(const bf16x8 a, const bf16x8 b) { const i32x4v x = __builtin_bit_cast(i32x4v, a), y = __builtin_bit_cast(i32x4v, b); return __builtin_shufflevector(x, y, 0, 1, 2, 3, 4, 5, 6, 7); }
__device__ __forceinline__ bf16x8 lo8(const i32x8 v) { return __builtin_bit_cast(bf16x8, (i32x4v)__builtin_shufflevector(v, v, 0, 1, 2, 3)); }
__device__ __forceinline__ bf16x8 hi8(const i32x8 v) { return __builtin_bit_cast(bf16x8, (i32x4v)__builtin_shufflevector(v, v, 4, 5, 6, 7)); }
template <class Epi, class Sched, bool ALIGN_EPI, bool FP8>
__device__ __forceinline__ void gemm_phase(LAS unsigned char* lds, const char* Abase, const char* Bbase, const int pitch, const Sched& S, const Epi& E) {
    const int tid = threadIdx.x, wid = __builtin_amdgcn_readfirstlane(tid >> 6), lane = tid & 63, wr = wid >> 2, wc = wid & 3, fr = lane & 15, fq = lane >> 4;
    const int nt = pitch / 128;
    unsigned voffB[2];
#pragma unroll
    for (int i = 0; i < 2; ++i) { int R, C; stage_rc(tid * 16 + i * 8192, R, C); const int Rb = (R & ~31) + perm32(R & 31);
        voffB[i] = (unsigned)(Rb * pitch) + (unsigned)C * 2u; }
    const size_t kstep = (size_t)(BK * 2);
    const size_t hstep = (size_t)HALF * pitch;
    const unsigned ldsw = (unsigned)wid * 1024u;
    const int aoff = lds_byte(wr * 64 + fr, fq * 8), boff = lds_byte(wc * 32 + fr, fq * 8);
#define PG8_SA(b, h) (((b) * 2 + (h)) * HTB)
#define PG8_SB(b, h) ((4 + (b) * 2 + (h)) * HTB)
#define PG8_STAGE_B(bufoff, gbase) do { _Pragma("unroll") for (int _i = 0; _i < 2; ++_i) \
        __builtin_amdgcn_global_load_lds((const unsigned*)((const char*)(gbase) + voffB[_i]), (LAS unsigned*)(lds + (bufoff) + ldsw + _i * 8192), 16, 0, 0); } while (0)
#define PG8_STAGE_A(bufoff, ao, kb) do { _Pragma("unroll") for (int _i = 0; _i < 2; ++_i) \
        __builtin_amdgcn_global_load_lds((const unsigned*)(Abase + (size_t)(ao)[_i] + (size_t)(kb)), (LAS unsigned*)(lds + (bufoff) + ldsw + _i * 8192), 16, 0, 0); } while (0)
#define PG8_LDA(dst, b, h) do { _Pragma("unroll") for (int m = 0; m < 4; ++m) dst[m] = cat8(*(const LAS bf16x8*)(lds + PG8_SA(b, h) + aoff + m * 2048), *(const LAS bf16x8*)(lds + PG8_SA(b, h) + aoff + m * 2048 + 1024)); } while (0)
#define PG8_LDB(dst, b, h) do { _Pragma("unroll") for (int n = 0; n < 2; ++n) dst[n] = cat8(*(const LAS bf16x8*)(lds + PG8_SB(b, h) + boff + n * 2048), *(const LAS bf16x8*)(lds + PG8_SB(b, h) + boff + n * 2048 + 1024)); } while (0)
#define PG8_MMA(ai, bj, At, Bt) do { __builtin_amdgcn_s_setprio(1); _Pragma("unroll") for (int m = 0; m < 4; ++m) _Pragma("unroll") for (int n = 0; n < 2; ++n) { \
        if constexpr (FP8) { acc[ai][bj][m][n] = __builtin_amdgcn_mfma_scale_f32_16x16x128_f8f6f4(Bt[n], At[m], acc[ai][bj][m][n], 0, 0, 0, 0x7f7f7f7f, 0, 0x7f7f7f7f); } \
        else { acc[ai][bj][m][n] = __builtin_amdgcn_mfma_f32_16x16x32_bf16(lo8(Bt[n]), lo8(At[m]), acc[ai][bj][m][n], 0, 0, 0); \
               acc[ai][bj][m][n] = __builtin_amdgcn_mfma_f32_16x16x32_bf16(hi8(Bt[n]), hi8(At[m]), acc[ai][bj][m][n], 0, 0, 0); } } \
        __builtin_amdgcn_s_setprio(0); } while (0)
#define PG8_WAIT_V(n) asm volatile("s_waitcnt vmcnt(" #n ")" ::: "memory")
#define PG8_WAIT_L(n) asm volatile("s_waitcnt lgkmcnt(" #n ")" ::: "memory")
#define PG8_BAR __builtin_amdgcn_s_barrier()
#define PG8_SCHED __builtin_amdgcn_sched_barrier(0)
    Unit cur, nxt; int ui = 0;
    if (!S.next(0, cur)) return;
    f32x4 acc[2][2][4][2];
#pragma unroll
    for (int a = 0; a < 2; ++a)
#pragma unroll
        for (int b = 0; b < 2; ++b)
#pragma unroll
            for (int m = 0; m < 4; ++m)
#pragma unroll
                for (int n = 0; n < 2; ++n) acc[a][b][m][n] = (f32x4){0.f, 0.f, 0.f, 0.f};
    i32x8 At[4], B0[2], B1[2];
    unsigned aoc[2][2];
    LAS u32x4* nxslot = (LAS u32x4*)(lds + STAGE_BYTES) + tid;
#pragma unroll
    for (int h = 0; h < 2; ++h)
#pragma unroll
        for (int i = 0; i < 2; ++i) { int R2, C2; stage_rc(tid * 16 + i * 8192, R2, C2); aoc[h][i] = S.arow(cur, h * HALF + R2) * (unsigned)pitch + (unsigned)C2 * 2u; }
    const char* cB = Bbase + (size_t)cur.bt * pitch;
    PG8_STAGE_B(PG8_SB(0, 0), cB); PG8_STAGE_B(PG8_SB(0, 1), cB + hstep); PG8_STAGE_A(PG8_SA(0, 0), aoc[0], 0); PG8_STAGE_A(PG8_SA(0, 1), aoc[1], 0);
    if (wr == 1) PG8_BAR;
    PG8_WAIT_V(2); PG8_BAR;
    PG8_STAGE_B(PG8_SB(1, 0), cB + kstep); PG8_STAGE_A(PG8_SA(1, 0), aoc[0], kstep); PG8_STAGE_B(PG8_SB(1, 1), cB + hstep + kstep);
    PG8_WAIT_V(6); PG8_BAR;
    for (;;) {
        const bool has_next = S.next(ui + 1, nxt);
        int tq = tid; asm volatile("" : "+v"(tq));
        { unsigned nx4[4];
#pragma unroll
          for (int h = 0; h < 2; ++h)
#pragma unroll
              for (int i = 0; i < 2; ++i) { int R2, C2; stage_rc(tq * 16 + i * 8192, R2, C2); nx4[h * 2 + i] = has_next ? S.arow(nxt, h * HALF + R2) * (unsigned)pitch + (unsigned)C2 * 2u : aoc[h][i]; }
          *nxslot = (u32x4){nx4[0], nx4[1], nx4[2], nx4[3]}; }
        const char* nB = has_next ? Bbase + (size_t)nxt.bt * pitch : cB;
#pragma nounroll
        for (int t = 0; t < nt; t += 2) {
            const bool last = (t == nt - 2);
            const size_t k1 = (size_t)(t + 1) * kstep;
            const size_t k2 = last ? (size_t)0 : (size_t)(t + 2) * kstep, k3 = k2 + kstep;
            const char* b2 = last ? nB : cB + (size_t)(t + 2) * kstep; const char* b3 = b2 + kstep;
            PG8_LDB(B0, 0, 0); PG8_LDB(B1, 0, 1); PG8_SCHED; PG8_LDA(At, 0, 0); PG8_STAGE_A(PG8_SA(1, 1), aoc[1], k1);
            if (last) { const u32x4 nx = *nxslot; aoc[0][0] = nx.x; aoc[0][1] = nx.y; aoc[1][0] = nx.z; aoc[1][1] = nx.w; }
            PG8_WAIT_V(8); PG8_WAIT_L(0); PG8_BAR; PG8_MMA(0, 0, At, B0); PG8_MMA(0, 1, At, B1); PG8_BAR; PG8_SCHED;
            PG8_LDA(At, 0, 1); PG8_STAGE_B(PG8_SB(0, 0), b2); PG8_STAGE_B(PG8_SB(0, 1), b2 + hstep); PG8_STAGE_A(PG8_SA(0, 0), aoc[0], k2);
            PG8_WAIT_V(8); PG8_WAIT_L(0); PG8_BAR; PG8_MMA(1, 0, At, B0); PG8_MMA(1, 1, At, B1); PG8_BAR; PG8_SCHED;
            PG8_LDB(B0, 1, 0); PG8_LDB(B1, 1, 1); PG8_SCHED; PG8_LDA(At, 1, 0); PG8_STAGE_A(PG8_SA(0, 1), aoc[1], k2);
            PG8_WAIT_V(8); PG8_WAIT_L(0); PG8_BAR; PG8_MMA(0, 0, At, B0); PG8_MMA(0, 1, At, B1); PG8_BAR; PG8_SCHED;
            PG8_LDA(At, 1, 1); PG8_STAGE_B(PG8_SB(1, 0), b3); PG8_STAGE_B(PG8_SB(1, 1), b3 + hstep); PG8_STAGE_A(PG8_SA(1, 0), aoc[0], k3);
            PG8_WAIT_V(8); PG8_WAIT_L(0); PG8_BAR; PG8_MMA(1, 0, At, B0); PG8_MMA(1, 1, At, B1); PG8_BAR; PG8_SCHED;
        }
        if constexpr (ALIGN_EPI) { if (wr == 0) PG8_BAR; }
        E(acc, cur, wr, wc, fr, fq);
        if (!has_next) break;
#pragma unroll
        for (int a = 0; a < 2; ++a)
#pragma unroll
            for (int b = 0; b < 2; ++b)
#pragma unroll
                for (int m = 0; m < 4; ++m)
#pragma unroll
                    for (int n = 0; n < 2; ++n) acc[a][b][m][n] = (f32x4){0.f, 0.f, 0.f, 0.f};
        cur = nxt; cB = nB; ++ui;
        if constexpr (ALIGN_EPI) { if (wr == 1) PG8_BAR; }
    }
    PG8_WAIT_V(0);
    if constexpr (!ALIGN_EPI) { if (wr == 0) PG8_BAR; }
    PG8_BAR;
#undef PG8_SA
#undef PG8_SB
#undef PG8_STAGE_A
#undef PG8_STAGE_B
#undef PG8_LDA
#undef PG8_LDB
#undef PG8_MMA
#undef PG8_WAIT_V
#undef PG8_WAIT_L
#undef PG8_BAR
#undef PG8_SCHED
}

__device__ __forceinline__ int xcd_remap(int L, int nwg) { const int q = nwg / NXCD, r = nwg % NXCD, xcd = L % NXCD, off = L / NXCD; return (xcd < r ? xcd * (q + 1) : r * (q + 1) + (xcd - r) * q) + off; }

constexpr int NG2 = 64;
struct SchedInProj {
    int G, c;
    __device__ __forceinline__ bool next(int i, Unit& u) const {
        constexpr int NLAT = 128 * 7, NCTX = 16 * 4, NWG = NLAT + NCTX + NG2;
        const int L = i * G + c; if (L >= NWG) return false;
        const int wgid = xcd_remap(L, NWG); int pm, pn;
        if (wgid < NLAT) { const int nig = WGM * 7, gid = wgid / nig, j = (wgid % nig) / WGM; pm = gid * WGM + (wgid % nig) % WGM; pn = j < 5 ? j : j + 2; }
        else if (wgid < NLAT + NCTX) { const int w = wgid - NLAT, nig = WGM * 4, gid = w / nig; pm = 128 + gid * WGM + (w % nig) % WGM; pn = (w % nig) / WGM; }
        else { const int w = wgid - NLAT - NCTX; pm = w >> 1; pn = 5 + (w & 1); }
        u.pm = pm; u.pn = pn; u.arow = pm * BM; u.bt = pn * BM; u.nvalid = BM; u.e = 0; return true;
    }
    __device__ __forceinline__ unsigned arow(const Unit& u, int rloc) const { return (unsigned)(u.arow + rloc); }
};
struct SchedInProjG {
    int nwg, c;
    __device__ __forceinline__ bool next(int i, Unit& u) const {
        const int L = NG2 + i * nwg + c; if (L >= 256) return false;
        u.pm = L >> 1; u.pn = 5 + (L & 1); u.arow = u.pm * BM; u.bt = u.pn * BM; u.nvalid = BM; u.e = 0; return true;
    }
    __device__ __forceinline__ unsigned arow(const Unit& u, int rloc) const { return (unsigned)(u.arow + rloc); }
};
struct SchedPlain {
    int G, c, nM, nN;
    __device__ __forceinline__ bool next(int i, Unit& u) const {
        const int nwg = nM * nN, L = i * G + c; if (L >= nwg) return false;
        const int wgid = xcd_remap(L, nwg), nig = WGM * nN, gid = wgid / nig, fm = gid * WGM, gsz = (nM - fm) < WGM ? (nM - fm) : WGM;
        u.pm = fm + ((wgid % nig) % gsz); u.pn = (wgid % nig) / gsz; u.arow = u.pm * BM; u.bt = u.pn * BM; u.nvalid = BM; u.e = 0; return true;
    }
    __device__ __forceinline__ unsigned arow(const Unit& u, int rloc) const { return (unsigned)(u.arow + rloc); }
};
template <int NT, bool GATHER>
struct SchedMoE {
    int G, c; const LAS int* tst; const LAS int* cnt; const int* list;
    __device__ __forceinline__ bool next(int i, Unit& u) const {
        const int nwg = tst[NE] * NT, L = i * G + c; if (L >= nwg) return false;
        const int wgid = xcd_remap(L, nwg);
        int e = 0;
#pragma unroll
        for (int s = 16; s >= 1; s >>= 1) { if (tst[e + s] * NT <= wgid) e += s; }
        const int t0 = tst[e], mt = tst[e + 1] - t0, w = wgid - t0 * NT, nig = WGM * NT, gid = w / nig, fm = gid * WGM, gsz = (mt - fm) < WGM ? (mt - fm) : WGM;
        const int m = fm + ((w % nig) % gsz), n = (w % nig) / gsz;
        u.pm = t0 + m; u.pn = n; u.e = e; u.bt = (e * NT + n) * BM;
        if (GATHER) { u.arow = e * NTOK + m * BM; const int left = cnt[e] - m * BM; u.nvalid = left < BM ? left : BM; }
        else { u.arow = u.pm * BM; u.nvalid = BM; }
        return true;
    }
    __device__ __forceinline__ unsigned arow(const Unit& u, int rloc) const {
        if (GATHER) { const int tok = (rloc < u.nvalid) ? (list[u.arow + rloc] >> 2) : 0; return (unsigned)tok; }
        return (unsigned)(u.arow + rloc);
    }
};

struct EpiInProj {
    bf16_t *KB, *VB, *QB, *GB, *PB; float* RB;
    __device__ __forceinline__ void operator()(const f32x4 (&acc)[2][2][4][2], const Unit& u, int wr, int wc, int fr, int fq) const {
        const int pn = u.pn, row0 = u.pm * BM + wr * 64 + fr;
        if (pn == 3) {
            if (wc != 0) return;
#pragma unroll
            for (int ai = 0; ai < 2; ++ai)
#pragma unroll
                for (int m = 0; m < 4; ++m) { float* rp = RB + (size_t)(row0 + ai * HALF + m * 16) * 32 + 8 * fq;
                    *(f32x4*)rp = acc[ai][0][m][0]; *(f32x4*)(rp + 4) = acc[ai][0][m][1]; }
            return;
        }
        if (pn >= 7) {
#pragma unroll
            for (int ai = 0; ai < 2; ++ai)
#pragma unroll
                for (int m = 0; m < 4; ++m) { const int row = row0 + ai * HALF + m * 16, b = row >> 11, t = row & 2047;
#pragma unroll
                    for (int bj = 0; bj < 2; ++bj) { const int g = (pn - 7) * 2 + bj, cblk = wc * 4 + fq;
                        const f32x4 v0 = acc[ai][bj][m][0], v1 = acc[ai][bj][m][1]; u32x4 w; w.x = cvt_pk_bf16(v0[0], v0[1]); w.y = cvt_pk_bf16(v0[2], v0[3]); w.z = cvt_pk_bf16(v1[0], v1[1]); w.w = cvt_pk_bf16(v1[2], v1[3]);
                        *(u32x4*)(PB + ((((size_t)(b * 4 + g) * 16 + cblk) * 2048 + t) * 8)) = w; } }
            return;
        }
        bf16_t* base; int ldc, coff;
        if (pn == 0) { base = KB; ldc = 256; coff = 0; } else if (pn <= 2) { base = VB; ldc = 512; coff = (pn - 1) * 256; }
        else if (pn == 4) { base = QB; ldc = 256; coff = 0; } else { base = GB; ldc = 512; coff = (pn - 5) * 256; }
        const int col0 = coff + wc * 32 + 8 * fq;
#pragma unroll
        for (int ai = 0; ai < 2; ++ai)
#pragma unroll
            for (int m = 0; m < 4; ++m) { bf16_t* rowp = base + (size_t)(row0 + ai * HALF + m * 16) * ldc + col0;
#pragma unroll
                for (int bj = 0; bj < 2; ++bj) { const f32x4 v0 = acc[ai][bj][m][0], v1 = acc[ai][bj][m][1];
                    u32x4 w; w.x = cvt_pk_bf16(v0[0], v0[1]); w.y = cvt_pk_bf16(v0[2], v0[3]); w.z = cvt_pk_bf16(v1[0], v1[1]); w.w = cvt_pk_bf16(v1[2], v1[3]);
                    *(u32x4*)(rowp + bj * HALF) = w; } }
    }
};
struct EpiResid {
    const float* x; const float* mod; float* out;
    __device__ __forceinline__ void operator()(const f32x4 (&acc)[2][2][4][2], const Unit& u, int wr, int wc, int fr, int fq) const {
        const int row0 = u.pm * BM + wr * 64 + fr, col0 = u.pn * BM + wc * 32 + 8 * fq;
        const float* g1 = mod + (size_t)(row0 >> 11) * NMOD + 2048 + col0;
        f32x4 gv[2][2];
#pragma unroll
        for (int bj = 0; bj < 2; ++bj)
#pragma unroll
            for (int n = 0; n < 2; ++n) gv[bj][n] = *(const f32x4*)(g1 + bj * HALF + 4 * n);
        f32x4 xa[2][2], xb[2][2];
#define RES_LOAD(dst, g_) do { const size_t _o = (size_t)(row0 + ((g_) >> 2) * HALF + ((g_) & 3) * 16) * D + col0; \
            _Pragma("unroll") for (int bj = 0; bj < 2; ++bj) _Pragma("unroll") for (int n = 0; n < 2; ++n) dst[bj][n] = *(const f32x4*)(x + _o + bj * HALF + 4 * n); } while (0)
#define RES_STORE(src, g_) do { const size_t _o = (size_t)(row0 + ((g_) >> 2) * HALF + ((g_) & 3) * 16) * D + col0; \
            _Pragma("unroll") for (int bj = 0; bj < 2; ++bj) _Pragma("unroll") for (int n = 0; n < 2; ++n) *(f32x4*)(out + _o + bj * HALF + 4 * n) = src[bj][n] + gv[bj][n] * acc[(g_) >> 2][bj][(g_) & 3][n]; } while (0)
        RES_LOAD(xa, 0);
#pragma unroll
        for (int g2 = 0; g2 < 8; g2 += 2) { RES_LOAD(xb, g2 + 1); RES_STORE(xa, g2); if (g2 + 2 < 8) RES_LOAD(xa, g2 + 2); RES_STORE(xb, g2 + 1); }
#undef RES_LOAD
#undef RES_STORE
    }
};
__device__ __forceinline__ unsigned pk4_fp8(float a, float b, float c, float d) { int w = 0; w = __builtin_amdgcn_cvt_pk_fp8_f32(a, b, w, false); w = __builtin_amdgcn_cvt_pk_fp8_f32(c, d, w, true); return (unsigned)w; }
template <bool FP8>
struct EpiSwiglu {
    void* act; const float* bgu; float ascale;
    __device__ __forceinline__ void operator()(const f32x4 (&acc)[2][2][4][2], const Unit& u, int wr, int wc, int fr, int fq) const {
        const int row0 = u.pm * BM + wr * 64 + fr, cc = u.pn * HALF + wc * 32 + 8 * fq;
        const float* bg = bgu + (size_t)u.e * 2048 + cc;
        f32x4 bgv[2], buv[2];
#pragma unroll
        for (int n = 0; n < 2; ++n) { bgv[n] = *(const f32x4*)(bg + 4 * n); buv[n] = *(const f32x4*)(bg + 1024 + 4 * n); }
#pragma unroll
        for (int ai = 0; ai < 2; ++ai)
#pragma unroll
            for (int m = 0; m < 4; ++m) { float r[8];
#pragma unroll
                for (int n = 0; n < 2; ++n) { const f32x4 gq = acc[ai][0][m][n] * ascale + bgv[n], uq = acc[ai][1][m][n] * ascale + buv[n];
#pragma unroll
                    for (int j = 0; j < 4; j += 2) { f32x2 gt = {fminf(gq[j], 7.f), fminf(gq[j + 1], 7.f)};
                        f32x2 up1 = {fminf(fmaxf(uq[j], -7.f), 7.f), fminf(fmaxf(uq[j + 1], -7.f), 7.f)}; up1 = up1 + 1.f;
                        const f32x2 z = gt * (-1.702f * 1.44269504089f);
                        f32x2 d = {__builtin_amdgcn_exp2f(z.x), __builtin_amdgcn_exp2f(z.y)}; d = d + 1.f;
                        const f32x2 rc = {__builtin_amdgcn_rcpf(d.x), __builtin_amdgcn_rcpf(d.y)};
                        const f32x2 o = (up1 * gt) * rc; r[4 * n + j] = o.x; r[4 * n + j + 1] = o.y; } }
                if constexpr (FP8) { u32x2 w; w.x = pk4_fp8(r[0], r[1], r[2], r[3]); w.y = pk4_fp8(r[4], r[5], r[6], r[7]);
                    *(u32x2*)((unsigned char*)act + (size_t)(row0 + ai * HALF + m * 16) * DFF + cc) = w; }
                else { u32x4 w; w.x = cvt_pk_bf16(r[0], r[1]); w.y = cvt_pk_bf16(r[2], r[3]); w.z = cvt_pk_bf16(r[4], r[5]); w.w = cvt_pk_bf16(r[6], r[7]);
                    *(u32x4*)((bf16_t*)act + (size_t)(row0 + ai * HALF + m * 16) * DFF + cc) = w; } }
    }
};
struct EpiDown {
    unsigned char* y; const float* bd; float ascale;
    __device__ __forceinline__ void operator()(const f32x4 (&acc)[2][2][4][2], const Unit& u, int wr, int wc, int fr, int fq) const {
        const int row0 = u.pm * BM + wr * 64 + fr, col0 = u.pn * BM + wc * 32 + 8 * fq;
        const float* bp = bd + (size_t)u.e * D + col0;
        f32x4 bv[2][2];
#pragma unroll
        for (int bj = 0; bj < 2; ++bj)
#pragma unroll
            for (int n = 0; n < 2; ++n) bv[bj][n] = *(const f32x4*)(bp + bj * HALF + 4 * n);
#pragma unroll
        for (int ai = 0; ai < 2; ++ai)
#pragma unroll
            for (int m = 0; m < 4; ++m) { unsigned char* rowp = y + (size_t)(row0 + ai * HALF + m * 16) * D + col0;
#pragma unroll
                for (int bj = 0; bj < 2; ++bj) { const f32x4 v0 = acc[ai][bj][m][0] * ascale + bv[bj][0], v1 = acc[ai][bj][m][1] * ascale + bv[bj][1];
                    u32x2 w; w.x = pk4_fp8(v0[0], v0[1], v0[2], v0[3]); w.y = pk4_fp8(v1[0], v1[1], v1[2], v1[3]);
                    *(u32x2*)(rowp + bj * HALF) = w; } }
    }
};
}

constexpr size_t MiB = 1u << 20;
constexpr size_t WS_CTL = 0, WS_MOD = 1 * MiB, WS_TOPW = 2 * MiB, WS_ASG = 3 * MiB, WS_WRT = 3 * MiB + 512 * 1024, WS_LIST = 4 * MiB, WS_WIN = 8 * MiB, WS_WOUT = 13 * MiB,
                 WS_WGU = 16 * MiB, WS_WD = 80 * MiB, WS_HN1 = 112 * MiB, WS_HN2 = 112 * MiB,
                 WS_KB = 184 * MiB, WS_VB = 202 * MiB, WS_RB = 238 * MiB, WS_QB = 243 * MiB, WS_GB = 259 * MiB, WS_PB = 291 * MiB,
                 WS_OF = 323 * MiB, WS_OB = 387 * MiB, WS_MIX = 451 * MiB, WS_ACT = 184 * MiB, WS_Y = 515 * MiB, WS_END = 787 * MiB;
static_assert(WS_ACT + (size_t)NPADROWS * DFF <= WS_Y && WS_Y + (size_t)NPADROWS * D * 2 <= WS_END, "ws map");


constexpr int CW_CNT = 0;
constexpr int CW_BAR = 4096;

constexpr int RING_BYTES = 131072;
constexpr int LDSCTL_OFF = 155648;
constexpr int LDS_BYTES = 163840;
constexpr int LC_BAR = 0, LC_TST = 16, LC_CNT = 64;

#define XB_TMO      128
#define XB_XCNT(j)  (256  + 64 * (j))
#define XB_XSUB(j)  (1280 + 64 * (j))
#define XB_XGEN(j)  (2304 + 64 * (j))
#define XB_TOP      3328
#define XB_TOPGEN   3392
#define XCD_BAR_WORDS 3456
#define XB_SPIN_CAP (1u << 18)
__device__ __forceinline__ unsigned xb_ld(unsigned* p)              { return __hip_atomic_load(p, __ATOMIC_RELAXED, __HIP_MEMORY_SCOPE_AGENT); }
__device__ __forceinline__ unsigned xb_add(unsigned* p, unsigned v) { return __hip_atomic_fetch_add(p, v, __ATOMIC_RELAXED, __HIP_MEMORY_SCOPE_AGENT); }
__device__ __forceinline__ unsigned xb_xcc_id() { return (unsigned)__builtin_amdgcn_s_getreg((3 << 11) | 20) & 0xFu; }
#define XB_SPIN(cond, bar) do { unsigned _sp = 0; while (cond) { __builtin_amdgcn_s_sleep(1); \
    if ((++_sp & 255u) == 0u) { if (xb_ld(&(bar)[XB_TMO])) break; if (_sp > XB_SPIN_CAP) { atomicAdd(&(bar)[XB_TMO], 1u); break; } } } } while (0)
struct XcdBarrier { unsigned* bar; unsigned x; volatile LAS unsigned* st; };
__device__ __forceinline__ XcdBarrier xcd_barrier_post(unsigned* bar, volatile LAS unsigned* st) {
    XcdBarrier b; b.bar = bar; b.x = xb_xcc_id(); b.st = st;
    if (threadIdx.x == 0) (void)xb_add(&bar[XB_XCNT(b.x)], 1u);
    return b;
}
__device__ __forceinline__ void xcd_barrier_complete(unsigned* bar, unsigned x, unsigned& nloc, unsigned& nx) {
    const unsigned G = gridDim.x * gridDim.y * gridDim.z;
    unsigned sum, cnt, mine, sp = 0u;
    for (;;) {
        sum = 0u; cnt = 0u; mine = 0u;
#pragma unroll
        for (unsigned j = 0; j < 16; ++j) { const unsigned c = xb_ld(&bar[XB_XCNT(j)]); sum += c; cnt += (c > 0u) ? 1u : 0u; mine = (j == x) ? c : mine; }
        if (sum == G) break;
        __builtin_amdgcn_s_sleep(1);
        if ((++sp & 255u) == 0u) { if (xb_ld(&bar[XB_TMO])) break; if (sp > XB_SPIN_CAP) { atomicAdd(&bar[XB_TMO], 1u); break; } }
    }
    nloc = mine > 0u ? mine : 1u; nx = cnt > 0u ? cnt : 1u;
}
__device__ __forceinline__ void xcd_barrier(const XcdBarrier& b) {
    asm volatile("s_waitcnt vmcnt(0)" ::: "memory");
    __syncthreads();
    if (threadIdx.x == 0) {
        unsigned* bar = b.bar;
        __builtin_amdgcn_s_waitcnt(0);
        unsigned nloc = b.st[0], nx = b.st[1];
        if (nloc == 0u) { xcd_barrier_complete(bar, b.x, nloc, nx); b.st[0] = nloc; b.st[1] = nx; }
        const unsigned old = xb_add(&bar[XB_XSUB(b.x)], 1u);
        const unsigned gen = old / nloc;
        if (old + 1u == (gen + 1u) * nloc) {
            __builtin_amdgcn_fence(__ATOMIC_RELEASE, "agent");
            asm volatile("s_waitcnt vmcnt(0)" ::: "memory");
            const unsigned og = xb_add(&bar[XB_TOP], 1u);
            const unsigned tg = og / nx;
            if (og + 1u == (tg + 1u) * nx) xb_add(&bar[XB_TOPGEN], 1u);
            else XB_SPIN(xb_ld(&bar[XB_TOPGEN]) == tg, bar);
            __builtin_amdgcn_fence(__ATOMIC_ACQUIRE, "agent");
            xb_add(&bar[XB_XGEN(b.x)], 1u);
            asm volatile("s_waitcnt vmcnt(0)" ::: "memory");
        } else {
            XB_SPIN(xb_ld(&bar[XB_XGEN(b.x)]) == gen, bar);
            __builtin_amdgcn_fence(__ATOMIC_ACQUIRE, "agent");
            asm volatile("s_waitcnt vmcnt(0)" ::: "memory");
        }
    }
    __syncthreads();
}

struct Args { const float* in[24]; float* out; unsigned char* ws; int ph_lo, ph_hi; };
struct Frame {
    LAS unsigned char* lds;
    int tid, lane, wave, vcu, G;
    const float* const* in; float* out; unsigned char* ws;
};
#define IN_X 0
#define IN_C 1
#define IN_CTX 2
#define IN_CCTX 3
#define IN_WADA 4
#define IN_BADA 5
#define IN_NMIX 6
#define IN_NMLP 7
#define IN_WIN 8
#define IN_WGKF 9
#define IN_BGKF 10
#define IN_WGKB 11
#define IN_BGKB 12
#define IN_GLANW 13
#define IN_WPOOL 14
#define IN_PSCALE 15
#define IN_WOUT 16
#define IN_WROUTER 17
#define IN_BROUTER 18
#define IN_WGU 19
#define IN_BGU 20
#define IN_WDOWN 21
#define IN_BDOWN 22
#define IN_FNW 23

__device__ __forceinline__ void p0_transpose_item(const float* W, int ldw, int k0, int n0, bf16_t* WT, int ldd, int drow, int dk0, LAS float* scr, int lane) {
#pragma unroll 8
    for (int i = 0; i < 32; ++i) { const int kk = 2 * i + (lane >> 5); scr[kk * 33 + (lane & 31)] = W[(size_t)(k0 + kk) * ldw + n0 + (lane & 31)]; }
    LDS_WAIT(); asm volatile("" ::: "memory");
    const int c = lane & 7;
#pragma unroll
    for (int j = 0; j < 4; ++j) { const int n = (lane >> 3) + 8 * j; const LAS float* s = scr + (8 * c) * 33 + n;
        u32x4 o; o.x = pk2(s[0 * 33], s[1 * 33]); o.y = pk2(s[2 * 33], s[3 * 33]); o.z = pk2(s[4 * 33], s[5 * 33]); o.w = pk2(s[6 * 33], s[7 * 33]);
        *(u32x4*)(WT + (size_t)(drow + n) * ldd + dk0 + k0 + 8 * c) = o; }
    LDS_WAIT(); asm volatile("" ::: "memory");
}
__device__ __forceinline__ int win_drow(int n0) {
    if (n0 < 256) return 4 * 256 + n0;
    if (n0 < 512) return n0 - 256;
    if (n0 < 1024) return 256 + (n0 - 512);
    if (n0 < 1536) return 5 * 256 + (n0 - 1024);
    if (n0 < 1568) return 3 * 256 + (n0 - 1536);
    return 7 * 256 + (n0 - 1568);
}
__device__ __forceinline__ void p0_mod_item(Frame& F, int item, const LAS float* SL, float* mod) {
    const float* w_ada = F.in[IN_WADA]; const float* b_ada = F.in[IN_BADA];
    const int j = item * 8 + (F.lane & 7), kp = F.lane >> 3;
    float acc[17];
#pragma unroll
    for (int r = 0; r < 17; ++r) acc[r] = 0.f;
#pragma unroll 4
    for (int i = 0; i < 128; ++i) { const int k = kp + 8 * i; const float w = w_ada[(size_t)k * NMOD + j];
#pragma unroll
        for (int r = 0; r < 17; ++r) acc[r] += SL[r * 1024 + k] * w; }
#pragma unroll
    for (int r = 0; r < 17; ++r) { float a = acc[r]; a += __shfl_xor(a, 8); a += __shfl_xor(a, 16); a += __shfl_xor(a, 32); if (kp == 0) mod[r * NMOD + j] = a + b_ada[j]; }
}
__device__ __forceinline__ void p0_weff_item(Frame& F, int item, LAS float* scr, bf16_t* Wout_t) {
    const float* w_pool = F.in[IN_WPOOL]; const float* pscale = F.in[IN_PSCALE]; const float* w_out = F.in[IN_WOUT];
    const int g = item >> 6, n0 = (item & 63) * 16, lane = F.lane;
#pragma unroll 4
    for (int q = 0; q < 32; ++q) { const int idx = lane + 64 * q, j = idx >> 4, nn = idx & 15; scr[idx] = w_out[(size_t)(512 + g * 128 + j) * D + n0 + nn] * pscale[g * 128 + j]; }
    LDS_WAIT(); asm volatile("" ::: "memory");
    float a0[16], a1[16];
#pragma unroll
    for (int nn = 0; nn < 16; ++nn) { a0[nn] = 0.f; a1[nn] = 0.f; }
    const float* wp0 = w_pool + (size_t)(g * 128 + lane) * 128; const float* wp1 = wp0 + 64 * 128;
    for (int j = 0; j < 128; ++j) { const float p0 = wp0[j], p1 = wp1[j];
#pragma unroll
        for (int q = 0; q < 4; ++q) { const f32x4 t = *(const LAS f32x4*)(scr + j * 16 + 4 * q);
#pragma unroll
            for (int z = 0; z < 4; ++z) { a0[4 * q + z] += p0 * t[z]; a1[4 * q + z] += p1 * t[z]; } } }
#pragma unroll
    for (int nn = 0; nn < 16; ++nn) { bf16_t* o = Wout_t + (size_t)(n0 + nn) * D + 512 + g * 128 + lane; o[0] = (bf16_t)f2bf(a0[nn]); o[64] = (bf16_t)f2bf(a1[nn]); }
    LDS_WAIT(); asm volatile("" ::: "memory");
}
constexpr int P0_CVT_E = 0;
constexpr float WSCALE = 32.f;
constexpr int CVP = 260;
__device__ __forceinline__ unsigned pk4_fp8s(float a, float b, float c, float d) { int w = 0; w = __builtin_amdgcn_cvt_pk_fp8_f32(a * WSCALE, b * WSCALE, w, false); w = __builtin_amdgcn_cvt_pk_fp8_f32(c * WSCALE, d * WSCALE, w, true); return (unsigned)w; }
struct CvtItem { const float* src; int ldw, k0, n0, e; bool gu; };
__device__ __forceinline__ CvtItem cvt_decode(Frame& F, int item) {
    CvtItem c;
    if (item < 2048) { c.gu = true; c.e = item >> 6; c.k0 = ((item >> 3) & 7) * 128; c.n0 = (item & 7) * 256; c.src = F.in[IN_WGU] + (size_t)c.e * D * 2048; c.ldw = 2048; }
    else { const int r = item - 2048 + P0_CVT_E * 32; c.gu = false; c.e = r >> 5; c.k0 = ((r >> 2) & 7) * 128; c.n0 = (r & 3) * 256; c.src = F.in[IN_WDOWN] + (size_t)c.e * DFF * D; c.ldw = D; }
    return c;
}
template <int MODE>
__device__ __forceinline__ void cvt_expert_items(Frame& F, int first, int stride, int nitems) {
    if (first >= nitems) return;
    LAS float* T = (LAS float*)F.lds;
    int tid = F.tid; asm volatile("" : "+v"(tid));
    f32x4 R[16];
    { const CvtItem c = cvt_decode(F, first);
#pragma unroll
      for (int i = 0; i < 16; ++i) { const int idx = tid + NTHR * i, kk = idx >> 6, n4 = idx & 63; R[i] = __builtin_nontemporal_load((const f32x4*)(c.src + (size_t)(c.k0 + kk) * c.ldw + c.n0 + 4 * n4)); } }
    for (int item = first; item < nitems; item += stride) {
        const CvtItem c = cvt_decode(F, item);
#pragma unroll
        for (int i = 0; i < 16; ++i) { const int idx = tid + NTHR * i, kk = idx >> 6, n4 = idx & 63; *(LAS f32x4*)(T + kk * CVP + 4 * n4) = R[i]; }
        __syncthreads();
        if (MODE != 1 && item + stride < nitems) { const CvtItem cn = cvt_decode(F, item + stride);
#pragma unroll
            for (int i = 0; i < 16; ++i) { const int idx = tid + NTHR * i, kk = idx >> 6, n4 = idx & 63; R[i] = __builtin_nontemporal_load((const f32x4*)(cn.src + (size_t)(cn.k0 + kk) * cn.ldw + cn.n0 + 4 * n4)); } }
        u32x4 o[4];
        { const int n = F.wave * 32 + (F.lane & 31), half = F.lane >> 5;
          const LAS float* col = T + (64 * half) * CVP + n;
#pragma unroll
          for (int q = 0; q < 4; ++q) { unsigned w4[4];
#pragma unroll
              for (int z = 0; z < 4; ++z) { const LAS float* p = col + (16 * q + 4 * z) * CVP; w4[z] = pk4_fp8s(p[0], p[CVP], p[2 * CVP], p[3 * CVP]); }
              o[q] = (u32x4){w4[0], w4[1], w4[2], w4[3]}; }
          __syncthreads();
          LAS unsigned char* OUTL = (LAS unsigned char*)F.lds;
#pragma unroll
          for (int q = 0; q < 4; ++q) *(LAS u32x4*)(OUTL + n * 144 + half * 64 + q * 16) = o[q]; }
        __syncthreads();
#pragma unroll
        for (int i = 0; i < 4; ++i) { const int idx = tid + NTHR * i, n = idx >> 3, ch = idx & 7;
            const u32x4 v = *(const LAS u32x4*)((const LAS unsigned char*)F.lds + n * 144 + ch * 16);
            size_t drow;
            if (c.gu) { const int jn = (c.n0 + n) & 1023; drow = (size_t)c.e * 2048 + (jn >> 7) * 256 + ((c.n0 + n) >= 1024 ? 128 : 0) + (jn & 127); }
            else drow = (size_t)c.e * D + c.n0 + n;
            if (MODE != 2 || v.x == 0x12345678u) *(u32x4*)((unsigned char*)(F.ws + (c.gu ? WS_WGU : WS_WD)) + drow * 1024 + c.k0 + ch * 16) = v; }
        __syncthreads();
    }
}

constexpr int CVH = 64 * CVP * 4;
__device__ __forceinline__ void cvt_dma_issue(Frame& F, int first, int stride, int t) {
    const CvtItem c = cvt_decode(F, first + (t >> 1) * stride); const int half = t & 1;
    LAS unsigned char* buf = F.lds + (t & 1) * CVH;
#pragma unroll
    for (int i = 0; i < 8; ++i) { const int row = 8 * F.wave + i;
        __builtin_amdgcn_global_load_lds((const unsigned*)(c.src + (size_t)(c.k0 + 64 * half + row) * c.ldw + c.n0 + 4 * F.lane), (LAS unsigned*)(buf + row * (CVP * 4)), 16, 0, 2); }
}
#define CVT_LW() asm volatile("s_waitcnt lgkmcnt(0)" ::: "memory")
#define CVT_BAR() do { __builtin_amdgcn_s_barrier(); asm volatile("" ::: "memory"); } while (0)
__device__ __forceinline__ void cvt_expert_items_dma(Frame& F, int first, int stride, int nitems) {
    if (first >= nitems) return;
    const int nh = 2 * ((nitems - first + stride - 1) / stride);
    int tid = F.tid; asm volatile("" : "+v"(tid));
    cvt_dma_issue(F, first, stride, 0); cvt_dma_issue(F, first, stride, 1);
    for (int t = 0; t < nh; ++t) {
        const CvtItem c = cvt_decode(F, first + (t >> 1) * stride); const int half = t & 1;
        LAS unsigned char* buf = F.lds + (t & 1) * CVH; const LAS float* T = (const LAS float*)buf;
        if (t + 1 < nh) asm volatile("s_waitcnt vmcnt(8)" ::: "memory"); else asm volatile("s_waitcnt vmcnt(0)" ::: "memory");
        CVT_BAR();
        u32x4 o0, o1;
        { const int n = F.wave * 32 + (F.lane & 31), kq = F.lane >> 5;
          const LAS float* col = T + (32 * kq) * CVP + n; unsigned w8[8];
#pragma unroll
          for (int z = 0; z < 8; ++z) { const LAS float* p = col + (4 * z) * CVP; w8[z] = pk4_fp8s(p[0], p[CVP], p[2 * CVP], p[3 * CVP]); }
          o0 = (u32x4){w8[0], w8[1], w8[2], w8[3]}; o1 = (u32x4){w8[4], w8[5], w8[6], w8[7]};
          CVT_LW(); CVT_BAR();
          *(LAS u32x4*)(buf + n * 80 + kq * 32) = o0; *(LAS u32x4*)(buf + n * 80 + kq * 32 + 16) = o1; }
        CVT_LW(); CVT_BAR();
#pragma unroll
        for (int i = 0; i < 2; ++i) { const int idx = tid + NTHR * i, n = idx >> 2, ch = idx & 3;
            const u32x4 v = *(const LAS u32x4*)(buf + n * 80 + ch * 16);
            size_t drow;
            if (c.gu) { const int jn = (c.n0 + n) & 1023; drow = (size_t)c.e * 2048 + (jn >> 7) * 256 + ((c.n0 + n) >= 1024 ? 128 : 0) + (jn & 127); }
            else drow = (size_t)c.e * D + c.n0 + n;
            *(u32x4*)((unsigned char*)(F.ws + (c.gu ? WS_WGU : WS_WD)) + drow * 1024 + c.k0 + 64 * half + ch * 16) = v; }
        CVT_LW(); CVT_BAR();
        if (t + 2 < nh) cvt_dma_issue(F, first, stride, t + 2);
    }
}
#undef CVT_LW
#undef CVT_BAR


__device__ __forceinline__ void p0_prologue(Frame& F, bool do_experts) {
    { bf16_t* WRT = (bf16_t*)(F.ws + WS_WRT); const float* wr = F.in[IN_WROUTER];
      for (int idx = F.vcu * NTHR + F.tid; idx < D * NE; idx += F.G * NTHR) { const int k = idx >> 5, e = idx & 31; const float v = wr[idx]; const unsigned hi = f2bf(v);
          WRT[e * D + k] = (bf16_t)hi; WRT[NE * D + e * D + k] = (bf16_t)f2bf(v - bf2f(hi)); } }
    LAS float* SL = (LAS float*)F.lds;
    for (int idx = F.tid; idx < 17 * 1024; idx += NTHR) { const int r = idx >> 10, k = idx & 1023; const float v = r < NB ? F.in[IN_C][r * D + k] : F.in[IN_CCTX][k]; SL[idx] = silu_f(v); }
    __syncthreads();
    LAS float* scr = (LAS float*)(F.lds + 69632 + F.wave * 8448);
    bf16_t* Win_t = (bf16_t*)(F.ws + WS_WIN); bf16_t* Wout_t = (bf16_t*)(F.ws + WS_WOUT); bf16_t* Wgu_t = (bf16_t*)(F.ws + WS_WGU); bf16_t* Wd_t = (bf16_t*)(F.ws + WS_WD);
    float* mod = (float*)(F.ws + WS_MOD);
    constexpr int I_MOD = NMOD / 8, I_WEFF = 4 * 64, I_WIN = 16 * (DIN / 32), I_ZERO = 224, I_WOUT = 8 * 32, I_GU = NE * 16 * 64, I_DN = NE * 16 * 32;
    const int nitems = I_MOD + I_WEFF + I_WIN + I_ZERO + I_WOUT + (do_experts ? I_GU + I_DN : 0);
    const int gw = F.wave * F.G + F.vcu, NGW = F.G * NWAVES;
    for (int it = gw; it < nitems; it += NGW) {
        int r = it;
        if (r < I_MOD) { p0_mod_item(F, r, SL, mod); continue; } r -= I_MOD;
        if (r < I_WEFF) { p0_weff_item(F, r, scr, Wout_t); continue; } r -= I_WEFF;
        if (r < I_WIN) { const int kb = r / (DIN / 32), nb = r % (DIN / 32); p0_transpose_item(F.in[IN_WIN], DIN, 64 * kb, 32 * nb, Win_t, D, win_drow(32 * nb), 0, scr, F.lane); continue; } r -= I_WIN;
        if (r < I_ZERO) { u32x4* o = (u32x4*)(Win_t + (size_t)(3 * 256 + 32 + r) * D) + F.lane * 2; o[0] = (u32x4){0u, 0u, 0u, 0u}; o[1] = (u32x4){0u, 0u, 0u, 0u}; continue; } r -= I_ZERO;
        if (r < I_WOUT) { const int kb = r / 32, nb = r % 32; p0_transpose_item(F.in[IN_WOUT], D, 64 * kb, 32 * nb, Wout_t, D, 32 * nb, 0, scr, F.lane); continue; } r -= I_WOUT;
        if (r < I_GU) { const int e = r / (16 * 64), q = r % (16 * 64), kb = q / 64, nb = q % 64, n0 = 32 * nb, jn = n0 & 1023;
            const int drow = e * 2048 + (jn >> 7) * 256 + (n0 >= 1024 ? 128 : 0) + (jn & 127);
            p0_transpose_item(F.in[IN_WGU] + (size_t)e * D * 2048, 2048, 64 * kb, n0, Wgu_t, D, drow, 0, scr, F.lane); continue; } r -= I_GU;
        { const int e = r / (16 * 32), q = r % (16 * 32), kb = q / 32, nb = q % 32;
            p0_transpose_item(F.in[IN_WDOWN] + (size_t)e * DFF * D, D, 64 * kb, 32 * nb, Wd_t, DFF, e * D + 32 * nb, 0, scr, F.lane); }
    }}

__device__ __forceinline__ void norm_row_bf16(const float* src, const float* wn, const float* sh, const float* sc, bf16_t* dst, int lane) {
    const f32x4* xr = (const f32x4*)src + lane;
    f32x4 v[4]; float s = 0.f;
#pragma unroll
    for (int j = 0; j < 4; ++j) { v[j] = xr[64 * j]; s += (v[j].x * v[j].x + v[j].y * v[j].y) + (v[j].z * v[j].z + v[j].w * v[j].w); }
    const float rstd = rsqrtf(wave_sum(s) * (1.f / D) + EPS);
    u32x2* o8 = (u32x2*)dst + lane;
#pragma unroll
    for (int j = 0; j < 4; ++j) { const f32x4 w = ((const f32x4*)wn)[lane + 64 * j], a = ((const f32x4*)sc)[lane + 64 * j], b = ((const f32x4*)sh)[lane + 64 * j];
        const f32x4 y = v[j] * rstd * w * (a + 1.f) + b; u32x2 p; p.x = pk2(y.x, y.y); p.y = pk2(y.z, y.w); o8[64 * j] = p; }
}
__device__ __forceinline__ void p1_norm1(Frame& F) {
    const float* mod = (const float*)(F.ws + WS_MOD); bf16_t* HN = (bf16_t*)(F.ws + WS_HN1);
    constexpr int RPB = NROW / 256;
    for (int blk = F.vcu; blk < 256; blk += F.G)
        for (int r = F.wave; r < RPB; r += NWAVES) { const int row = blk * RPB + r;
            const float* src = row < NTOK ? F.in[IN_X] + (size_t)row * D : F.in[IN_CTX] + (size_t)(row - NTOK) * D;
            const float* mr = mod + (size_t)(row < NTOK ? row / SEQ : NB) * NMOD;
            norm_row_bf16(src, F.in[IN_NMIX], mr, mr + 1024, HN + (size_t)row * D, F.lane); }
}

typedef __bf16 bf16x2n __attribute__((ext_vector_type(2)));
__device__ __forceinline__ unsigned pkbf(float lo, float hi) { f32x2 v = {lo, hi}; return __builtin_bit_cast(unsigned, __builtin_convertvector(v, bf16x2n)); }
#define MFMA32(a, b, c) __builtin_amdgcn_mfma_f32_32x32x16_bf16((a), (b), (c), 0, 0, 0)
constexpr int GP = 72;
constexpr int GL_QP = 0, GL_KP = 9216, GL_QQ = 18432, GL_KKT = 27648, GL_VT = 36864, GL_DEC = 55296, GL_GSUM = 55552, GL_R = 57600, GL_END = 61696;

__device__ __forceinline__ bf16x8 pack8(const f32x16& x, int s) {
    u32x4 p; p.x = pkbf(x[8 * s + 0], x[8 * s + 1]); p.y = pkbf(x[8 * s + 2], x[8 * s + 3]); p.z = pkbf(x[8 * s + 4], x[8 * s + 5]); p.w = pkbf(x[8 * s + 6], x[8 * s + 7]);
    return __builtin_bit_cast(bf16x8, p);
}
__device__ __forceinline__ bf16x8 ld_perm8(const LAS bf16_t* p) {
    const u32x2 a = *(const LAS u32x2*)p, b = *(const LAS u32x2*)(p + 8); u32x4 r; r.x = a.x; r.y = a.y; r.z = b.x; r.w = b.y; return __builtin_bit_cast(bf16x8, r);
}
__device__ __forceinline__ bf16x8 ld_nat8(const LAS bf16_t* p) { return *(const LAS bf16x8*)p; }

template <int GM>
__device__ __forceinline__ void gla_unit(Frame& F, const int unit) {
    const int b = unit >> 3, h = (unit >> 1) & 3, dir = unit & 1;
    const int w = F.wave, lane = F.lane, tid = F.tid;
    LAS unsigned char* L = F.lds;
    LAS bf16_t* QP = (LAS bf16_t*)(L + GL_QP); LAS bf16_t* KP = (LAS bf16_t*)(L + GL_KP); LAS bf16_t* QQ = (LAS bf16_t*)(L + GL_QQ);
    LAS bf16_t* KKT = (LAS bf16_t*)(L + GL_KKT); LAS bf16_t* VT = (LAS bf16_t*)(L + GL_VT);
    LAS float* DEC = (LAS float*)(L + GL_DEC); LAS float* GSUM = (LAS float*)(L + GL_GSUM); LAS float* RL = (LAS float*)(L + GL_R);
    const bf16_t* QB = (const bf16_t*)(F.ws + WS_QB); const bf16_t* KB = (const bf16_t*)(F.ws + WS_KB); const bf16_t* VB = (const bf16_t*)(F.ws + WS_VB);
    const float* RB = (const float*)(F.ws + WS_RB);
    bf16_t* OD = (bf16_t*)(F.ws + (GM >= 3 ? (dir ? 870 * MiB : 830 * MiB) : (dir ? WS_OB : WS_OF)));
    const float* wgk = F.in[dir ? IN_WGKB : IN_WGKF]; const float* bgk = F.in[dir ? IN_BGKB : IN_BGKF];
    f32x2 wg[8];
#pragma unroll
    for (int j = 0; j < 8; ++j) wg[j] = (f32x2){wgk[(2 * j) * 256 + h * 64 + lane], wgk[(2 * j + 1) * 256 + h * 64 + lane]};
    const float bg = bgk[h * 64 + lane];
    f32x16 S0, S1;
#pragma unroll
    for (int i = 0; i < 16; ++i) { S0[i] = 0.f; S1[i] = 0.f; }
    const int tb = w >> 2, vb = w & 3, c = lane & 31, hh = lane >> 5;
    const int vs = lane, vc = w;
    const int rs = tid >> 3, rc = tid & 7;
    unsigned pq[8], pk[8]; u32x4 pv0, pv1; f32x2 pr;
#define GLA_LOAD(step) do { const int _s = (step); const bool _ctx = _s < 4; const int _ci = _ctx ? _s : _s - 4; const int _ch = dir ? ((_ctx ? 3 : 31) - _ci) : _ci; \
        const int _row0 = _ctx ? NTOK + b * CTX + _ch * 64 : b * SEQ + _ch * 64; \
        _Pragma("unroll") for (int _i = 0; _i < 8; ++_i) { const int _t = 8 * w + _i; const size_t _row = (size_t)(_row0 + (dir ? 63 - _t : _t)); \
            pk[_i] = KB[_row * 256 + h * 64 + lane]; pq[_i] = _ctx ? 0u : (unsigned)QB[_row * 256 + h * 64 + lane]; } \
        { const size_t _row = (size_t)(_row0 + (dir ? 63 - vs : vs)); const u32x4* _vp = (const u32x4*)(VB + _row * 512 + h * 128 + vc * 16); pv0 = _vp[0]; pv1 = _vp[1]; \
          const size_t _rr = (size_t)(_row0 + (dir ? 63 - rs : rs)); pr = *(const f32x2*)(RB + _rr * 32 + dir * 16 + rc * 2); } } while (0)
    GLA_LOAD(0);
    for (int step = 0; step < 36; ++step) {
        const bool isctx = step < 4; const int ci = isctx ? step : step - 4; const int chunk = dir ? ((isctx ? 3 : 31) - ci) : ci;
        const int row0 = isctx ? NTOK + b * CTX + chunk * 64 : b * SEQ + chunk * 64;
        unsigned cq[8], ck[8]; u32x4 cv0 = pv0, cv1 = pv1;
#pragma unroll
        for (int i = 0; i < 8; ++i) { cq[i] = pq[i]; ck[i] = pk[i]; }
        *(LAS f32x2*)(RL + rs * 16 + rc * 2) = pr;
        __syncthreads();
        float cs[8];
        { float run = 0.f;
#pragma unroll
          for (int i = 0; i < 8; ++i) { const LAS f32x4* rp = (const LAS f32x4*)(RL + (8 * w + i) * 16); f32x2 a2 = {bg, 0.f};
#pragma unroll
              for (int q4 = 0; q4 < ((GM == 3) ? 1 : 4); ++q4) { const f32x4 rv = rp[q4]; a2 = __builtin_elementwise_fma((f32x2){rv[0], rv[1]}, wg[2 * q4], a2); a2 = __builtin_elementwise_fma((f32x2){rv[2], rv[3]}, wg[2 * q4 + 1], a2); }
              const float x = a2.x + a2.y;
              const float gk = (GM == 3) ? x * 1e-3f : __builtin_fmaf(__builtin_amdgcn_logf(1.f + __builtin_amdgcn_exp2f(fabsf(x) * -1.44269504089f)), -0.69314718056f / 16.f, fminf(x, 0.f) * (1.f / 16.f));
              run += gk; cs[i] = run; }
          GSUM[w * 64 + lane] = run; }
        __syncthreads();
        { float pre = 0.f, mid = 0.f, tot = 0.f;
#pragma unroll
          for (int g = 0; g < 8; ++g) { const float gsum = GSUM[g * 64 + lane]; if (g < w) pre += gsum; if (g < 4) mid += gsum; tot += gsum; }
          if (w == 0) DEC[lane] = __expf(tot);
          const f32x2 emt = {__expf(mid), __expf(tot - mid)}; const float pm = pre - mid;
          u32x4 kk4;
          float kkf[8];
#pragma unroll
          for (int i = 0; i < ((GM == 4) ? 1 : 8); ++i) { const int t = 8 * w + i; const float dd = pm + cs[i];
              const f32x2 ea = __builtin_elementwise_fma((f32x2){dd, dd}, (f32x2){1.44269504089f, -1.44269504089f}, (f32x2){-3.f, 0.f});
              const f32x2 e = {__builtin_amdgcn_exp2f(ea.x), __builtin_amdgcn_exp2f(ea.y)};
              const f32x2 qk = {bf2f(cq[i]), bf2f(ck[i])};
              const f32x2 o2 = qk * (e * emt); kkf[i] = o2.y;
              if (!isctx) { const f32x2 o1 = qk * e; const unsigned w1 = pkbf(o1.x, o1.y), w2 = pkbf(o2.x, 0.f);
                  QP[t * GP + lane] = (bf16_t)(w1 & 0xffffu); KP[t * GP + lane] = (bf16_t)(w1 >> 16); QQ[t * GP + lane] = (bf16_t)(w2 & 0xffffu); } }
          kk4.x = pkbf(kkf[0], kkf[1]); kk4.y = pkbf(kkf[2], kkf[3]); kk4.z = pkbf(kkf[4], kkf[5]); kk4.w = pkbf(kkf[6], kkf[7]);
          *(LAS u32x4*)(KKT + lane * GP + 8 * w) = kk4;
          const unsigned vw[8] = {cv0.x, cv0.y, cv0.z, cv0.w, cv1.x, cv1.y, cv1.z, cv1.w};
#pragma unroll
          for (int e = 0; e < ((GM == 4) ? 1 : 8); ++e) { VT[(vc * 16 + 2 * e) * GP + vs] = (bf16_t)(vw[e] & 0xffffu); VT[(vc * 16 + 2 * e + 1) * GP + vs] = (bf16_t)(vw[e] >> 16); } }
        if (step + 1 < 36) GLA_LOAD(step + 1);
        __syncthreads();
        if (!isctx && GM != 1) {
            f32x16 O;
#pragma unroll
            for (int i = 0; i < 16; ++i) O[i] = 0.f;
#pragma unroll
            for (int s = 0; s < 2; ++s) { O = MFMA32(ld_perm8(QQ + (32 * tb + c) * GP + 16 * s + 4 * hh), pack8(S0, s), O);
                                          O = MFMA32(ld_perm8(QQ + (32 * tb + c) * GP + 32 + 16 * s + 4 * hh), pack8(S1, s), O); }
#pragma unroll
            for (int sb = 0; sb < 2; ++sb) { if (sb > tb) continue;
                f32x16 X;
#pragma unroll
                for (int i = 0; i < 16; ++i) X[i] = 0.f;
#pragma unroll
                for (int s = 0; s < 4; ++s) X = MFMA32(ld_nat8(KP + (32 * sb + c) * GP + 16 * s + 8 * hh), ld_nat8(QP + (32 * tb + c) * GP + 16 * s + 8 * hh), X);
                if (sb == tb) {
#pragma unroll
                    for (int r = 0; r < 16; ++r) { const int sl = (r & 3) + 8 * (r >> 2) + 4 * hh; X[r] = (sl <= c) ? X[r] : 0.f; } }
#pragma unroll
                for (int s = 0; s < 2; ++s) O = MFMA32(pack8(X, s), ld_perm8(VT + (32 * vb + c) * GP + 32 * sb + 16 * s + 4 * hh), O);
            }
#pragma unroll
            for (int r = 0; r < ((GM == 2) ? 1 : 16); ++r) { const int t = 32 * tb + (r & 3) + 8 * (r >> 2) + 4 * hh; const size_t row = (size_t)(row0 + (dir ? 63 - t : t));
                OD[row * 512 + h * 128 + 32 * vb + c] = (bf16_t)(pkbf(O[r], 0.f) & 0xffffu); }
        }
        if (GM != 1) {
#pragma unroll
            for (int g4 = 0; g4 < 4; ++g4) { const f32x4 d0 = *(const LAS f32x4*)(DEC + 8 * g4 + 4 * hh), d1 = *(const LAS f32x4*)(DEC + 32 + 8 * g4 + 4 * hh);
#pragma unroll
                for (int z = 0; z < 4; ++z) { S0[4 * g4 + z] *= d0[z]; S1[4 * g4 + z] *= d1[z]; } }
#pragma unroll
            for (int s = 0; s < 4; ++s) { const bf16x8 vf = ld_nat8(VT + (32 * vb + c) * GP + 16 * s + 8 * hh);
                S0 = MFMA32(ld_nat8(KKT + c * GP + 16 * s + 8 * hh), vf, S0);
                S1 = MFMA32(ld_nat8(KKT + (32 + c) * GP + 16 * s + 8 * hh), vf, S1); }
        }
    }
#undef GLA_LOAD
    __syncthreads();
}

constexpr int PRS = 72 * 2;
__device__ __forceinline__ int pslot(int x) { return 2 * (x + (x >> 3)); }
template <int G_>
__device__ __forceinline__ void pool_unit_g(Frame& F, const int cblk, const int b) {
    constexpr int g = G_, wdw = 2 << g, lo = wdw >> 1, hi = wdw - 1 - lo;
    LAS f32x4* X = (LAS f32x4*)F.lds;
    LAS f32x4* H = (LAS f32x4*)(F.lds + 73728);
    const bf16_t* PB = (const bf16_t*)(F.ws + WS_PB) + ((size_t)((b * 4 + g) * 16 + cblk) * 2048) * 8;
    bf16_t* MIX = (bf16_t*)(F.ws + WS_MIX);
    int tid = F.tid; asm volatile("" : "+v"(tid));
#pragma unroll
    for (int i = 0; i < 4; ++i) { const int tok = tid + 512 * i, r = tok >> 6, x = tok & 63; const u32x4 v = *(const u32x4*)(PB + (size_t)tok * 8);
        LAS f32x4* p = X + r * PRS + pslot(x);
        p[0] = (f32x4){bflo(v.x), bfhi(v.x), bflo(v.y), bfhi(v.y)}; p[1] = (f32x4){bflo(v.z), bfhi(v.z), bflo(v.w), bfhi(v.w)}; }
    __syncthreads();
    { const int q = tid & 1, cs = (tid >> 1) & 7, r = tid >> 4; const LAS f32x4* xr = X + r * PRS + q; LAS f32x4* hr = H + r * PRS + q;
      const int c0 = 8 * cs; f32x4 s = {0.f, 0.f, 0.f, 0.f};
#pragma unroll
      for (int d = -lo; d <= hi; ++d) { const int x = c0 + d; const bool ok = (x >= 0) && (x < GW); const int xc = x < 0 ? 0 : (x > GW - 1 ? GW - 1 : x); const f32x4 v = xr[pslot(xc)]; s += ok ? v : (f32x4){0.f, 0.f, 0.f, 0.f}; if (((d + lo) & 3) == 3) asm volatile("" ::: "memory"); }
      hr[pslot(c0)] = s;
#pragma unroll
      for (int j = 1; j < 8; ++j) { const int xin = c0 + j + hi, xout = c0 + j - 1 - lo; const bool oki = xin < GW, oko = xout >= 0;
          const f32x4 vi = xr[pslot(oki ? xin : GW - 1)], vo = xr[pslot(oko ? xout : 0)];
          s += oki ? vi : (f32x4){0.f, 0.f, 0.f, 0.f}; s -= oko ? vo : (f32x4){0.f, 0.f, 0.f, 0.f}; hr[pslot(c0 + j)] = s; } }
    __syncthreads();
    { const int q = tid & 1, cc = (tid >> 1) & 63, rs = tid >> 7; const int col = pslot(cc) + q; const int r0s = 8 * rs;
      const int c0 = max(cc - lo, 0), c1 = min(cc + hi + 1, GW); const float ncol = (float)(c1 - c0);
      f32x4 s = {0.f, 0.f, 0.f, 0.f};
#pragma unroll
      for (int d = -lo; d <= hi; ++d) { const int y = r0s + d; const bool ok = (y >= 0) && (y < GROWS); const int yc = y < 0 ? 0 : (y > GROWS - 1 ? GROWS - 1 : y); const f32x4 v = H[yc * PRS + col]; s += ok ? v : (f32x4){0.f, 0.f, 0.f, 0.f}; if (((d + lo) & 3) == 3) asm volatile("" ::: "memory"); }
#pragma unroll
      for (int j = 0; j < 8; ++j) { const int r = r0s + j;
          if (j > 0) { const int yin = r + hi, yout = r - 1 - lo; const bool oki = yin < GROWS, oko = yout >= 0;
              const f32x4 vi = H[(oki ? yin : GROWS - 1) * PRS + col], vo = H[(oko ? yout : 0) * PRS + col];
              s += oki ? vi : (f32x4){0.f, 0.f, 0.f, 0.f}; s -= oko ? vo : (f32x4){0.f, 0.f, 0.f, 0.f}; }
          const int ra = max(r - lo, 0), rb = min(r + hi + 1, GROWS);
          const float inv = 1.f / ((float)(rb - ra) * ncol);
          const f32x4 o = s * inv - X[r * PRS + col];
          u32x2 pw; pw.x = pkbf(o[0], o[1]); pw.y = pkbf(o[2], o[3]);
          *(u32x2*)(MIX + (size_t)(b * SEQ + r * GW + cc) * D + 512 + g * 128 + cblk * 8 + q * 4) = pw; } }
    __syncthreads();
}
__device__ __forceinline__ void pool_unit(Frame& F, const int unit) {
    const int g = unit & 3, cblk = (unit >> 2) & 15, b = unit >> 6;
    if (g == 0) pool_unit_g<0>(F, cblk, b); else if (g == 1) pool_unit_g<1>(F, cblk, b); else if (g == 2) pool_unit_g<2>(F, cblk, b); else pool_unit_g<3>(F, cblk, b);
}

__device__ __forceinline__ void p4_gla_out(Frame& F) {
    const bf16_t* OFp = (const bf16_t*)(F.ws + WS_OF); const bf16_t* OBp = (const bf16_t*)(F.ws + WS_OB); const bf16_t* GB = (const bf16_t*)(F.ws + WS_GB);
    bf16_t* MIX = (bf16_t*)(F.ws + WS_MIX); const float* wn = F.in[IN_GLANW];
    const int lane = F.lane, gw = F.vcu * NWAVES + F.wave, NGW = F.G * NWAVES;
    const f32x4 w0 = *(const f32x4*)(wn + (lane & 15) * 8), w1 = *(const f32x4*)(wn + (lane & 15) * 8 + 4);
    for (int tok = gw; tok < NTOK; tok += NGW) {
        const u32x4 fa = *((const u32x4*)(OFp + (size_t)tok * 512) + lane), fb = *((const u32x4*)(OBp + (size_t)tok * 512) + lane);
        const f32x4 o0 = (f32x4){bflo(fa.x) + bflo(fb.x), bfhi(fa.x) + bfhi(fb.x), bflo(fa.y) + bflo(fb.y), bfhi(fa.y) + bfhi(fb.y)};
        const f32x4 o1 = (f32x4){bflo(fa.z) + bflo(fb.z), bfhi(fa.z) + bfhi(fb.z), bflo(fa.w) + bflo(fb.w), bfhi(fa.w) + bfhi(fb.w)};
        const u32x4 gv = *((const u32x4*)(GB + (size_t)tok * 512) + lane);
        float ss = (o0[0] * o0[0] + o0[1] * o0[1]) + (o0[2] * o0[2] + o0[3] * o0[3]) + (o1[0] * o1[0] + o1[1] * o1[1]) + (o1[2] * o1[2] + o1[3] * o1[3]);
        ss += __shfl_xor(ss, 1); ss += __shfl_xor(ss, 2); ss += __shfl_xor(ss, 4); ss += __shfl_xor(ss, 8);
        const float rstd = rsqrtf(ss * (1.f / 128.f) + EPS);
        const float gg[8] = {bflo(gv.x), bfhi(gv.x), bflo(gv.y), bfhi(gv.y), bflo(gv.z), bfhi(gv.z), bflo(gv.w), bfhi(gv.w)};
        float y[8];
#pragma unroll
        for (int j = 0; j < 4; ++j) { y[j] = o0[j] * rstd * w0[j] * silu_f(gg[j]); y[4 + j] = o1[j] * rstd * w1[j] * silu_f(gg[4 + j]); }
        u32x4 pw; pw.x = pkbf(y[0], y[1]); pw.y = pkbf(y[2], y[3]); pw.z = pkbf(y[4], y[5]); pw.w = pkbf(y[6], y[7]);
        *((u32x4*)(MIX + (size_t)tok * D) + lane) = pw;
    }
}

constexpr int P6_AP = 1032;
constexpr int L6_AH = 0, L6_AL = 32 * P6_AP * 2, L6_LG = 2 * L6_AL;
constexpr int L6_REC = L6_LG + 128 * 33 * 4;
constexpr int L6_RED = 0;
static_assert(L6_REC + 4096 <= LDSCTL_OFF && 8 * 32 * 33 * 4 <= L6_LG, "P6 LDS map");
__device__ __forceinline__ void p6_router(Frame& F) {
    LAS bf16_t* AH = (LAS bf16_t*)(F.lds + L6_AH); LAS bf16_t* AL = (LAS bf16_t*)(F.lds + L6_AL); LAS float* LG = (LAS float*)(F.lds + L6_LG); LAS float* RED = (LAS float*)(F.lds + L6_RED);
    LAS unsigned* REC = (LAS unsigned*)(F.lds + L6_REC); LAS float* RECW = (LAS float*)(F.lds + L6_REC + 2048);
    LAS int* LCNT = (LAS int*)(F.lds + LDSCTL_OFF) + LC_CNT; LAS int* GBASE = LCNT + 32;
    const float* b_router = F.in[IN_BROUTER]; const float* wn = F.in[IN_NMLP];
    const float* mod = (const float*)(F.ws + WS_MOD); const float* h1 = F.out;
    unsigned char* HN2 = (unsigned char*)(F.ws + WS_HN2);
    int* gcnt = (int*)(F.ws + WS_CTL) + CW_CNT; int* list = (int*)(F.ws + WS_LIST); unsigned* ASG = (unsigned*)(F.ws + WS_ASG); float* TOPW = (float*)(F.ws + WS_TOPW);
    const int lane = F.lane, w = F.wave, tid = F.tid, c = lane & 31, hh = lane >> 5;
    bf16x8 bh[8], bl[8];
    { const bf16_t* WRT = (const bf16_t*)(F.ws + WS_WRT);
#pragma unroll
      for (int s = 0; s < 8; ++s) { bh[s] = *(const bf16x8*)(WRT + c * D + 128 * w + 16 * s + 8 * hh); bl[s] = *(const bf16x8*)(WRT + NE * D + c * D + 128 * w + 16 * s + 8 * hh); } }
    const f32x4 wn4[4] = {((const f32x4*)wn)[lane], ((const f32x4*)wn)[lane + 64], ((const f32x4*)wn)[lane + 128], ((const f32x4*)wn)[lane + 192]};
    for (int tblk = F.vcu; tblk < NTOK / 128; tblk += F.G) {
        if (tid < 32) LCNT[tid] = 0;
        const float* mrow = mod + (size_t)((tblk * 128) >> 11) * NMOD;
        f32x4 sc4[4], sh4[4];
#pragma unroll
        for (int j = 0; j < 4; ++j) { sc4[j] = ((const f32x4*)(mrow + 4096))[lane + 64 * j] + 1.f; sh4[j] = ((const f32x4*)(mrow + 3072))[lane + 64 * j]; }
        f32x4 hn[4];
        { const f32x4* xr = (const f32x4*)(h1 + (size_t)(tblk * 128 + 4 * w) * D) + lane;
#pragma unroll
          for (int j = 0; j < 4; ++j) hn[j] = xr[64 * j]; }
        for (int tile = 0; tile < 4; ++tile) {
#pragma unroll 1
            for (int q = 0; q < 4; ++q) { const int tl = 4 * w + q, tok = tblk * 128 + tile * 32 + tl;
                f32x4 hv[4]; float s = 0.f;
#pragma unroll
                for (int j = 0; j < 4; ++j) { hv[j] = hn[j]; s += (hv[j].x * hv[j].x + hv[j].y * hv[j].y) + (hv[j].z * hv[j].z + hv[j].w * hv[j].w); }
                { const int nq = tile * 4 + q + 1; if (nq < 16) { const int ntok = tblk * 128 + (nq >> 2) * 32 + 4 * w + (nq & 3); const f32x4* xr = (const f32x4*)(h1 + (size_t)ntok * D) + lane;
#pragma unroll
                    for (int j = 0; j < 4; ++j) hn[j] = xr[64 * j]; } }
                const float rstd = rsqrtf(wave_sum(s) * (1.f / D) + EPS);
                unsigned* o4 = (unsigned*)(HN2 + (size_t)tok * D) + lane;
#pragma unroll
                for (int j = 0; j < 4; ++j) { const f32x4 y = hv[j] * rstd * wn4[j] * sc4[j] + sh4[j];
                    o4[64 * j] = pg8::pk4_fp8(y.x, y.y, y.z, y.w);
                    u32x2 hi2; hi2.x = pkbf(y.x, y.y); hi2.y = pkbf(y.z, y.w);
                    u32x2 lo2; lo2.x = pkbf(y.x - bflo(hi2.x), y.y - bfhi(hi2.x)); lo2.y = pkbf(y.z - bflo(hi2.y), y.w - bfhi(hi2.y));
                    *(LAS u32x2*)(AH + tl * P6_AP + 4 * lane + 256 * j) = hi2; *(LAS u32x2*)(AL + tl * P6_AP + 4 * lane + 256 * j) = lo2; } }
            __syncthreads();
            f32x16 Dp;
#pragma unroll
            for (int i = 0; i < 16; ++i) Dp[i] = 0.f;
#pragma unroll
            for (int s = 0; s < 8; ++s) { const bf16x8 ah = *(const LAS bf16x8*)(AH + c * P6_AP + 128 * w + 16 * s + 8 * hh), al = *(const LAS bf16x8*)(AL + c * P6_AP + 128 * w + 16 * s + 8 * hh);
                Dp = MFMA32(ah, bh[s], Dp); Dp = MFMA32(ah, bl[s], Dp); Dp = MFMA32(al, bh[s], Dp); }
            __syncthreads();
#pragma unroll
            for (int r = 0; r < 16; ++r) RED[w * (32 * 33) + ((r & 3) + 8 * (r >> 2) + 4 * hh) * 33 + c] = Dp[r];
            __syncthreads();
            { const int tl = tid >> 4, e0 = tid & 15; float a0 = 0.f, a1 = 0.f;
#pragma unroll
              for (int ww = 0; ww < 8; ++ww) { a0 += RED[ww * (32 * 33) + tl * 33 + e0]; a1 += RED[ww * (32 * 33) + tl * 33 + e0 + 16]; }
              LG[(tile * 32 + tl) * 33 + e0] = a0 + b_router[e0]; LG[(tile * 32 + tl) * 33 + e0 + 16] = a1 + b_router[e0 + 16]; }
            __syncthreads();
        }
        if (tid < 128) { float lgv[32];
#pragma unroll
            for (int e = 0; e < 32; ++e) lgv[e] = LG[tid * 33 + e];
            int se[4]; float sv[4];
#pragma unroll
            for (int r = 0; r < 4; ++r) { float bv = -3.0e38f; int bi = 0;
#pragma unroll
                for (int e = 0; e < 32; ++e) { bool ok = lgv[e] > bv;
#pragma unroll
                    for (int q = 0; q < r; ++q) ok = ok && (se[q] != e);
                    bv = ok ? lgv[e] : bv; bi = ok ? e : bi; }
                se[r] = bi; sv[r] = bv; }
            float ex[4], den = 0.f;
#pragma unroll
            for (int r = 0; r < 4; ++r) { ex[r] = __expf(sv[r] - sv[0]); den += ex[r]; }
            const float inv = 1.f / den;
#pragma unroll
            for (int r = 0; r < 4; ++r) { const int lp = __hip_atomic_fetch_add(&LCNT[se[r]], 1, __ATOMIC_RELAXED, __HIP_MEMORY_SCOPE_WORKGROUP);
                REC[tid * 4 + r] = ((unsigned)se[r] << 16) | (unsigned)lp; RECW[tid * 4 + r] = ex[r] * inv; } }
        __syncthreads();
        { int t2 = tid; asm volatile("" : "+v"(t2)); if (t2 < 32) GBASE[t2] = atomicAdd(&gcnt[64 * t2], LCNT[t2]); }
        __syncthreads();
        { const unsigned rec = REC[tid]; const int e = rec >> 16, pos = GBASE[e] + (int)(rec & 0xffffu), aid = tblk * 512 + tid;
          list[e * NTOK + pos] = aid; ASG[aid] = ((unsigned)e << 16) | (unsigned)pos; TOPW[aid] = RECW[tid]; }
        __syncthreads();
    }
}
__device__ __forceinline__ void moe_tables(Frame& F) {
    LAS int* TST = (LAS int*)(F.lds + LDSCTL_OFF) + LC_TST; LAS int* LCNT = (LAS int*)(F.lds + LDSCTL_OFF) + LC_CNT;
    const int* gcnt = (const int*)(F.ws + WS_CTL) + CW_CNT;
    if (F.tid < 64) {
        const int lane = F.lane; const int c = lane < NE ? gcnt[64 * lane] : 0; const int mt = (c + 255) >> 8; int inc = mt;
#pragma unroll
        for (int o = 1; o < 32; o <<= 1) { const int up = __shfl_up(inc, o); if (lane >= o) inc += up; }
        if (lane < NE) { LCNT[lane] = c; TST[lane] = inc - mt; }
        if (lane == NE - 1) TST[NE] = inc;
    }
    __syncthreads();
}
__device__ __forceinline__ f32x4 fp8x4_to_f32(unsigned w) { const f32x2 lo = __builtin_amdgcn_cvt_pk_f32_fp8((int)w, false), hi = __builtin_amdgcn_cvt_pk_f32_fp8((int)w, true); return (f32x4){lo.x, lo.y, hi.x, hi.y}; }
__device__ __forceinline__ void p9_final(Frame& F) {
    const LAS int* TST = (const LAS int*)(F.lds + LDSCTL_OFF) + LC_TST;
    const unsigned* ASG = (const unsigned*)(F.ws + WS_ASG); const float* TOPW = (const float*)(F.ws + WS_TOPW); const unsigned char* Y = (const unsigned char*)(F.ws + WS_Y);
    const float* mod = (const float*)(F.ws + WS_MOD); const float* fw = F.in[IN_FNW]; float* out = F.out;
    const int lane = F.lane, gw = F.vcu * NWAVES + F.wave, NGW = F.G * NWAVES;
    f32x4 fwv[4];
#pragma unroll
    for (int j = 0; j < 4; ++j) fwv[j] = ((const f32x4*)fw)[lane + 64 * j];
    for (int tok0 = gw; tok0 < NTOK; tok0 += 2 * NGW) {
        int tk[2]; tk[0] = tok0; tk[1] = (tok0 + NGW < NTOK) ? tok0 + NGW : tok0;
        unsigned yv[2][4][4]; float wg[2][4]; f32x4 xv[2][4], gv[2][4];
#pragma unroll
        for (int u = 0; u < 2; ++u) { const u32x4 a4 = *(const u32x4*)(ASG + (size_t)tk[u] * 4); const f32x4 w4 = *(const f32x4*)(TOPW + (size_t)tk[u] * 4);
            const unsigned aa[4] = {a4.x, a4.y, a4.z, a4.w};
#pragma unroll
            for (int r = 0; r < 4; ++r) { const unsigned a = (unsigned)__builtin_amdgcn_readfirstlane((int)aa[r]); wg[u][r] = w4[r];
                const size_t row = (size_t)TST[a >> 16] * 256 + (a & 0xffffu); const unsigned* yp = (const unsigned*)(Y + row * D) + lane;
#pragma unroll
                for (int j = 0; j < 4; ++j) yv[u][r][j] = yp[64 * j]; }
            const f32x4* xr = (const f32x4*)(out + (size_t)tk[u] * D) + lane; const f32x4* g2 = (const f32x4*)(mod + (size_t)(tk[u] >> 11) * NMOD + 5120) + lane;
#pragma unroll
            for (int j = 0; j < 4; ++j) { xv[u][j] = xr[64 * j]; gv[u][j] = g2[64 * j]; } }
#pragma unroll
        for (int u = 0; u < 2; ++u) { f32x4 v[4]; float s = 0.f;
#pragma unroll
            for (int j = 0; j < 4; ++j) { f32x4 acc = fp8x4_to_f32(yv[u][0][j]) * wg[u][0];
#pragma unroll
                for (int r = 1; r < 4; ++r) acc += fp8x4_to_f32(yv[u][r][j]) * wg[u][r];
                v[j] = xv[u][j] + gv[u][j] * acc; s += (v[j].x * v[j].x + v[j].y * v[j].y) + (v[j].z * v[j].z + v[j].w * v[j].w); }
            const float rstd = rsqrtf(wave_sum(s) * (1.f / D) + EPS);
            if (u == 0 || tk[1] != tk[0]) { f32x4* xo = (f32x4*)(out + (size_t)tk[u] * D) + lane;
#pragma unroll
                for (int j = 0; j < 4; ++j) xo[64 * j] = v[j] * rstd * fwv[j]; } }
    }
}

#ifndef MK_N_LAUNCHES
#define MK_N_LAUNCHES 1
#endif
constexpr int N_PHASES = 10;
#ifndef PROBE_TWICE
#define PROBE_TWICE -1
#endif
__global__ void __launch_bounds__(NTHR, 2) mk_fwd(Args args) {
    extern __shared__ __attribute__((aligned(16))) unsigned char lds_raw[];
    Frame F;
    F.lds = (LAS unsigned char*)lds_raw;
    F.tid = threadIdx.x; F.lane = F.tid & 63; F.wave = __builtin_amdgcn_readfirstlane(F.tid >> 6);
    F.G = gridDim.x; { const int bx = blockIdx.x; F.vcu = (F.G % 8 == 0) ? (bx % 8) * (F.G / 8) + bx / 8 : bx; }
    F.in = args.in; F.out = args.out; F.ws = args.ws;
    for (int u = F.tid; u < (LDS_BYTES - LDSCTL_OFF) / 4; u += NTHR) ((LAS unsigned*)(F.lds + LDSCTL_OFF))[u] = 0u;
    __syncthreads();
    const int lo = args.ph_lo, hi = args.ph_hi;
    XcdBarrier bar; bar.bar = (unsigned*)(F.ws + WS_CTL) + CW_BAR; bar.x = 0; bar.st = nullptr;
    if (hi - lo > 1) bar = xcd_barrier_post((unsigned*)(F.ws + WS_CTL) + CW_BAR, (volatile LAS unsigned*)(F.lds + LDSCTL_OFF) + LC_BAR);
#define IN(k) (lo <= (k) && (k) < hi)
#define SEAM(k) do { if (IN(k) && IN((k) + 1)) xcd_barrier(bar); } while (0)
    if (IN(0)) { p0_prologue(F, false); } SEAM(0);
    if (IN(1)) { p1_norm1(F); } SEAM(1);
    if (IN(2)) for (int rep_ = 0; rep_ < (PROBE_TWICE == 2 ? 2 : 1); ++rep_) { if (rep_) xcd_barrier(bar);
        pg8::SchedInProj S{F.G, (int)blockIdx.x};
        pg8::EpiInProj E{(bf16_t*)(F.ws + WS_KB), (bf16_t*)(F.ws + WS_VB), (bf16_t*)(F.ws + WS_QB), (bf16_t*)(F.ws + WS_GB), (bf16_t*)(F.ws + WS_PB), (float*)(F.ws + WS_RB)};
        pg8::gemm_phase<pg8::EpiInProj, pg8::SchedInProj, true, false>(F.lds, (const char*)(F.ws + WS_HN1), (const char*)(F.ws + WS_WIN), D * 2, S, E);
    } SEAM(2);
    if (IN(3)) {
        const int bx = blockIdx.x, nG = (F.G + 1) >> 1, nP = F.G - nG;
        constexpr int CVT_N = 2048 + 1024, CVT_ODD = 2432, CVT_ODD2 = CVT_ODD + 256;
        if ((bx & 1) == 0) { for (int u = bx >> 1; u < NB * 8; u += nG) gla_unit<0>(F, u);
#if PROBE_TWICE >= 380 && PROBE_TWICE < 390
                             for (int u = bx >> 1; u < NB * 8; u += nG) gla_unit<PROBE_TWICE - 380>(F, u);
#endif
                             cvt_expert_items_dma(F, CVT_ODD2 + (bx >> 1), nG, CVT_N); }
        else { for (int u = bx >> 1; u < NB * 64; u += nP) pool_unit(F, u);
#if PROBE_TWICE == 37
               for (int u = bx >> 1; u < NB * 64; u += nP) pool_unit(F, u);
#endif
               cvt_expert_items_dma(F, bx >> 1, nP, CVT_ODD);
               if ((bx >> 1) >= 64) cvt_expert_items_dma(F, CVT_ODD + (bx >> 1) - 64, 64, CVT_ODD2);
#if PROBE_TWICE == 36
               __syncthreads(); cvt_expert_items_dma(F, bx >> 1, nP, CVT_ODD);
#endif
               __syncthreads();
               for (int rep_ = 0; rep_ < (PROBE_TWICE == 35 ? 2 : 1); ++rep_)
               { pg8::SchedInProjG S{nP, bx >> 1};
                 pg8::EpiInProj E{(bf16_t*)(F.ws + WS_KB), (bf16_t*)(F.ws + WS_VB), (bf16_t*)(F.ws + WS_QB), (bf16_t*)(F.ws + WS_GB), (bf16_t*)(F.ws + WS_PB), (float*)(F.ws + WS_RB)};
                 pg8::gemm_phase<pg8::EpiInProj, pg8::SchedInProjG, true, false>(F.lds, (const char*)(F.ws + WS_HN1), (const char*)(F.ws + WS_WIN), D * 2, S, E); } }
    } SEAM(3);
    if (IN(4)) { p4_gla_out(F); } SEAM(4);
    if (IN(5)) {
        pg8::SchedPlain S{F.G, (int)blockIdx.x, NTOK / 256, D / 256};
        pg8::EpiResid E{F.in[IN_X], (const float*)(F.ws + WS_MOD), F.out};
        pg8::gemm_phase<pg8::EpiResid, pg8::SchedPlain, true, false>(F.lds, (const char*)(F.ws + WS_MIX), (const char*)(F.ws + WS_WOUT), D * 2, S, E);
    } SEAM(5);
    if (IN(6)) { p6_router(F); } SEAM(6);
    const LAS int* TST = (const LAS int*)(F.lds + LDSCTL_OFF) + LC_TST; const LAS int* LCN = (const LAS int*)(F.lds + LDSCTL_OFF) + LC_CNT;
    if (IN(7)) {
        moe_tables(F);
        pg8::SchedMoE<8, true> S{F.G, (int)blockIdx.x, TST, LCN, (const int*)(F.ws + WS_LIST)};
        pg8::EpiSwiglu<true> E{(void*)(F.ws + WS_ACT), F.in[IN_BGU], 1.f / WSCALE};
        pg8::gemm_phase<pg8::EpiSwiglu<true>, pg8::SchedMoE<8, true>, true, true>(F.lds, (const char*)(F.ws + WS_HN2), (const char*)(F.ws + WS_WGU), D, S, E);
    } SEAM(7);
    if (IN(8)) {
        moe_tables(F);
        pg8::SchedMoE<4, false> S{F.G, (int)blockIdx.x, TST, LCN, nullptr};
        pg8::EpiDown E{(unsigned char*)(F.ws + WS_Y), F.in[IN_BDOWN], 1.f / WSCALE};
        pg8::gemm_phase<pg8::EpiDown, pg8::SchedMoE<4, false>, true, true>(F.lds, (const char*)(F.ws + WS_ACT), (const char*)(F.ws + WS_WD), DFF, S, E);
    } SEAM(8);
    if (IN(9)) { moe_tables(F); p9_final(F); }
#undef IN
#undef SEAM
}

extern "C" void kernel_launch(void* const* d_in, const int* in_sizes, int n_in, void* d_out, int out_size, void* d_ws, size_t ws_size, hipStream_t stream) {
    static int grid = 0;
    if (grid == 0) {
        if (n_in != 24 || ws_size < WS_END || out_size != NTOK * D) { fprintf(stderr, "kernel_launch: unexpected n_in %d / ws_size %zu / out %d\n", n_in, ws_size, out_size); grid = -1; return; }
        int dev = 0, cus = 0, per_cu = 0;
        if (hipGetDevice(&dev) != hipSuccess || hipDeviceGetAttribute(&cus, hipDeviceAttributeMultiprocessorCount, dev) != hipSuccess) { grid = -1; return; }
        if (hipFuncSetAttribute((const void*)mk_fwd, hipFuncAttributeMaxDynamicSharedMemorySize, LDS_BYTES) != hipSuccess) { fprintf(stderr, "kernel_launch: hipFuncSetAttribute failed\n"); grid = -1; return; }
        if (hipOccupancyMaxActiveBlocksPerMultiprocessor(&per_cu, (const void*)mk_fwd, NTHR, LDS_BYTES) != hipSuccess || per_cu < 1) { fprintf(stderr, "kernel_launch: occupancy query says %d workgroups per CU\n", per_cu); (void)hipGetLastError(); grid = -1; return; }
        (void)hipGetLastError();
        grid = cus;
    }
    if (grid < 0) return;
    (void)hipMemsetAsync((char*)d_ws + WS_CTL, 0, 1 * MiB, stream);
    Args a{};
    for (int i = 0; i < 24; ++i) a.in[i] = (const float*)d_in[i];
    a.out = (float*)d_out; a.ws = (unsigned char*)d_ws;
    if (MK_N_LAUNCHES == 1) {
        a.ph_lo = 0; a.ph_hi = N_PHASES;
        void* kargs[] = {&a};
        const hipError_t e = hipLaunchCooperativeKernel((const void*)mk_fwd, dim3(grid), dim3(NTHR), kargs, LDS_BYTES, stream);
        if (e != hipSuccess) fprintf(stderr, "kernel_launch: cooperative launch failed: %s (grid %d)\n", hipGetErrorString(e), grid);
    } else {
        for (int ph = 0; ph < N_PHASES; ++ph) { a.ph_lo = ph; a.ph_hi = ph + 1; hipLaunchKernelGGL(mk_fwd, dim3(grid), dim3(NTHR), LDS_BYTES, stream, a); }
    }
}
```

```cpp
#include <hip/hip_runtime.h>
#include <stdint.h>
#include <stdio.h>

#define LAS __attribute__((address_space(3)))
#define GAS __attribute__((address_space(1)))
typedef unsigned short bf16_t;
typedef short bf16x8 __attribute__((ext_vector_type(8)));
typedef float f32x4 __attribute__((ext_vector_type(4)));
typedef float f32x2 __attribute__((ext_vector_type(2)));
typedef float f32x16 __attribute__((ext_vector_type(16)));
typedef unsigned u32x4 __attribute__((ext_vector_type(4)));
typedef unsigned u32x2 __attribute__((ext_vector_type(2)));

constexpr int D = 1024, NB = 16, SEQ = 2048, CTX = 256;
constexpr int NTOK = NB * SEQ, NCTX = NB * CTX, NROW = NTOK + NCTX;
constexpr int DIN = 2080, NE = 32, DFF = 1024;
constexpr int GW = 64, GROWS = 32;
constexpr int NMOD = 6144;
constexpr float EPS = 1e-6f;
constexpr int NWAVES = 8, NTHR = 512;
constexpr int WIN_N = 2304;
constexpr int NPADROWS = NTOK * 4 + NE * 256;

__device__ __forceinline__ unsigned f2bf(float f) { unsigned u = __builtin_bit_cast(unsigned, f); return (u + 0x7fffu + ((u >> 16) & 1u)) >> 16; }
__device__ __forceinline__ unsigned pk2(float lo, float hi) { return f2bf(lo) | (f2bf(hi) << 16); }
__device__ __forceinline__ float bf2f(unsigned v) { return __builtin_bit_cast(float, v << 16); }
__device__ __forceinline__ float bflo(unsigned w) { return __builtin_bit_cast(float, w << 16); }
__device__ __forceinline__ float bfhi(unsigned w) { return __builtin_bit_cast(float, w & 0xffff0000u); }
__device__ __forceinline__ unsigned cvt_pk_bf16(float lo, float hi) { unsigned r; asm volatile("v_cvt_pk_bf16_f32 %0, %1, %2" : "=v"(r) : "v"(lo), "v"(hi)); return r; }
__device__ __forceinline__ float wave_sum(float v) {
#pragma unroll
    for (int o = 1; o < 64; o <<= 1) v += __shfl_xor(v, o);
    return v;
}
__device__ __forceinline__ float silu_f(float x) { return x / (1.f + __expf(-x)); }
__device__ __forceinline__ float logsigmoid_f(float x) { return fminf(x, 0.f) - log1pf(expf(-fabsf(x))); }
#define LDS_WAIT() asm volatile("s_waitcnt lgkmcnt(0)" ::: "memory")
#define VM_WAIT() asm volatile("s_waitcnt vmcnt(0)" ::: "memory")

namespace pg8 {
constexpr int BM = 256, BK = 64, HALF = 128, HTB = HALF * BK * 2  , STAGE_BYTES = 8 * HTB, NXCD = 8, WGM = 8;
__host__ __device__ __forceinline__ int lds_byte(int r, int c) { const int st = (r >> 4) * 2 + (c >> 5), rr = r & 15, cc = c & 31, ob = rr * 64 + cc * 2; return st * 1024 + (ob ^ (((ob >> 9) & 1) << 5)); }
__host__ __device__ __forceinline__ void stage_rc(int b, int& R, int& C) { const int st = b / 1024, sb = b % 1024, swz = sb ^ (((sb >> 9) & 1) << 5); R = (st >> 1) * 16 + swz / 64; C = (st & 1) * 32 + (swz % 64) / 2; }
__host__ __device__ __forceinline__ int perm32(int rho) { const int n = rho >> 4, i = rho & 15; return 8 * (i >> 2) + 4 * n + (i & 3); }

struct Unit { int pm, pn, arow, bt, nvalid, e; };

typedef int i32x8 __attribute__((ext_vector_type(8)));
typedef int i32x4v __attribute__((ext_vector_type(4)));
__device__ __forceinline__ i32x8 cat8(const bf16x8 a, const bf16x8 b) { const i32x4v x = __builtin_bit_cast(i32x4v, a), y = __builtin_bit_cast(i32x4v, b); return __builtin_shufflevector(x, y, 0, 1, 2, 3, 4, 5, 6, 7); }
__device__ __forceinline__ bf16x8 lo8(const i32x8 v) { return __builtin_bit_cast(bf16x8, (i32x4v)__builtin_shufflevector(v, v, 0, 1, 2, 3)); }
__device__ __forceinline__ bf16x8 hi8(const i32x8 v) { return __builtin_bit_cast(bf16x8, (i32x4v)__builtin_shufflevector(v, v, 4, 5, 6, 7)); }
template <class Epi, class Sched, bool ALIGN_EPI, bool FP8>
__device__ __forceinline__ void gemm_phase(LAS unsigned char* lds, const char* Abase, const char* Bbase, const int pitch, const Sched& S, const Epi& E) {
    const int tid = threadIdx.x, wid = __builtin_amdgcn_readfirstlane(tid >> 6), lane = tid & 63, wr = wid >> 2, wc = wid & 3, fr = lane & 15, fq = lane >> 4;
    const int nt = pitch / 128;
    unsigned voffB[2];
#pragma unroll
    for (int i = 0; i < 2; ++i) { int R, C; stage_rc(tid * 16 + i * 8192, R, C); const int Rb = (R & ~31) + perm32(R & 31);
        voffB[i] = (unsigned)(Rb * pitch) + (unsigned)C * 2u; }
    const size_t kstep = (size_t)(BK * 2);
    const size_t hstep = (size_t)HALF * pitch;
    const unsigned ldsw = (unsigned)wid * 1024u;
    const int aoff = lds_byte(wr * 64 + fr, fq * 8), boff = lds_byte(wc * 32 + fr, fq * 8);
#define PG8_SA(b, h) (((b) * 2 + (h)) * HTB)
#define PG8_SB(b, h) ((4 + (b) * 2 + (h)) * HTB)
#define PG8_STAGE_B(bufoff, gbase) do { _Pragma("unroll") for (int _i = 0; _i < 2; ++_i) \
        __builtin_amdgcn_global_load_lds((const unsigned*)((const char*)(gbase) + voffB[_i]), (LAS unsigned*)(lds + (bufoff) + ldsw + _i * 8192), 16, 0, 0); } while (0)
#define PG8_STAGE_A(bufoff, ao, kb) do { _Pragma("unroll") for (int _i = 0; _i < 2; ++_i) \
        __builtin_amdgcn_global_load_lds((const unsigned*)(Abase + (size_t)(ao)[_i] + (size_t)(kb)), (LAS unsigned*)(lds + (bufoff) + ldsw + _i * 8192), 16, 0, 0); } while (0)
#define PG8_LDA(dst, b, h) do { _Pragma("unroll") for (int m = 0; m < 4; ++m) dst[m] = cat8(*(const LAS bf16x8*)(lds + PG8_SA(b, h) + aoff + m * 2048), *(const LAS bf16x8*)(lds + PG8_SA(b, h) + aoff + m * 2048 + 1024)); } while (0)
#define PG8_LDB(dst, b, h) do { _Pragma("unroll") for (int n = 0; n < 2; ++n) dst[n] = cat8(*(const LAS bf16x8*)(lds + PG8_SB(b, h) + boff + n * 2048), *(const LAS bf16x8*)(lds + PG8_SB(b, h) + boff + n * 2048 + 1024)); } while (0)
#define PG8_MMA(ai, bj, At, Bt) do { __builtin_amdgcn_s_setprio(1); _Pragma("unroll") for (int m = 0; m < 4; ++m) _Pragma("unroll") for (int n = 0; n < 2; ++n) { \
        if constexpr (FP8) { acc[ai][bj][m][n] = __builtin_amdgcn_mfma_scale_f32_16x16x128_f8f6f4(Bt[n], At[m], acc[ai][bj][m][n], 0, 0, 0, 0x7f7f7f7f, 0, 0x7f7f7f7f); } \
        else { acc[ai][bj][m][n] = __builtin_amdgcn_mfma_f32_16x16x32_bf16(lo8(Bt[n]), lo8(At[m]), acc[ai][bj][m][n], 0, 0, 0); \
               acc[ai][bj][m][n] = __builtin_amdgcn_mfma_f32_16x16x32_bf16(hi8(Bt[n]), hi8(At[m]), acc[ai][bj][m][n], 0, 0, 0); } } \
        __builtin_amdgcn_s_setprio(0); } while (0)
#define PG8_WAIT_V(n) asm volatile("s_waitcnt vmcnt(" #n ")" ::: "memory")
#define PG8_WAIT_L(n) asm volatile("s_waitcnt lgkmcnt(" #n ")" ::: "memory")
#define PG8_BAR __builtin_amdgcn_s_barrier()
#define PG8_SCHED __builtin_amdgcn_sched_barrier(0)
    Unit cur, nxt; int ui = 0;
    if (!S.next(0, cur)) return;
    f32x4 acc[2][2][4][2];
#pragma unroll
    for (int a = 0; a < 2; ++a)
#pragma unroll
        for (int b = 0; b < 2; ++b)
#pragma unroll
            for (int m = 0; m < 4; ++m)
#pragma unroll
                for (int n = 0; n < 2; ++n) acc[a][b][m][n] = (f32x4){0.f, 0.f, 0.f, 0.f};
    i32x8 At[4], B0[2], B1[2];
    unsigned aoc[2][2];
    LAS u32x4* nxslot = (LAS u32x4*)(lds + STAGE_BYTES) + tid;
#pragma unroll
    for (int h = 0; h < 2; ++h)
#pragma unroll
        for (int i = 0; i < 2; ++i) { int R2, C2; stage_rc(tid * 16 + i * 8192, R2, C2); aoc[h][i] = S.arow(cur, h * HALF + R2) * (unsigned)pitch + (unsigned)C2 * 2u; }
    const char* cB = Bbase + (size_t)cur.bt * pitch;
    PG8_STAGE_B(PG8_SB(0, 0), cB); PG8_STAGE_B(PG8_SB(0, 1), cB + hstep); PG8_STAGE_A(PG8_SA(0, 0), aoc[0], 0); PG8_STAGE_A(PG8_SA(0, 1), aoc[1], 0);
    if (wr == 1) PG8_BAR;
    PG8_WAIT_V(2); PG8_BAR;
    PG8_STAGE_B(PG8_SB(1, 0), cB + kstep); PG8_STAGE_A(PG8_SA(1, 0), aoc[0], kstep); PG8_STAGE_B(PG8_SB(1, 1), cB + hstep + kstep);
    PG8_WAIT_V(6); PG8_BAR;
    for (;;) {
        const bool has_next = S.next(ui + 1, nxt);
        int tq = tid; asm volatile("" : "+v"(tq));
        { unsigned nx4[4];
#pragma unroll
          for (int h = 0; h < 2; ++h)
#pragma unroll
              for (int i = 0; i < 2; ++i) { int R2, C2; stage_rc(tq * 16 + i * 8192, R2, C2); nx4[h * 2 + i] = has_next ? S.arow(nxt, h * HALF + R2) * (unsigned)pitch + (unsigned)C2 * 2u : aoc[h][i]; }
          *nxslot = (u32x4){nx4[0], nx4[1], nx4[2], nx4[3]}; }
        const char* nB = has_next ? Bbase + (size_t)nxt.bt * pitch : cB;
#pragma nounroll
        for (int t = 0; t < nt; t += 2) {
            const bool last = (t == nt - 2);
            const size_t k1 = (size_t)(t + 1) * kstep;
            const size_t k2 = last ? (size_t)0 : (size_t)(t + 2) * kstep, k3 = k2 + kstep;
            const char* b2 = last ? nB : cB + (size_t)(t + 2) * kstep; const char* b3 = b2 + kstep;
            PG8_LDB(B0, 0, 0); PG8_LDB(B1, 0, 1); PG8_SCHED; PG8_LDA(At, 0, 0); PG8_STAGE_A(PG8_SA(1, 1), aoc[1], k1);
            if (last) { const u32x4 nx = *nxslot; aoc[0][0] = nx.x; aoc[0][1] = nx.y; aoc[1][0] = nx.z; aoc[1][1] = nx.w; }
            PG8_WAIT_V(8); PG8_WAIT_L(0); PG8_BAR; PG8_MMA(0, 0, At, B0); PG8_MMA(0, 1, At, B1); PG8_BAR; PG8_SCHED;
            PG8_LDA(At, 0, 1); PG8_STAGE_B(PG8_SB(0, 0), b2); PG8_STAGE_B(PG8_SB(0, 1), b2 + hstep); PG8_STAGE_A(PG8_SA(0, 0), aoc[0], k2);
            PG8_WAIT_V(8); PG8_WAIT_L(0); PG8_BAR; PG8_MMA(1, 0, At, B0); PG8_MMA(1, 1, At, B1); PG8_BAR; PG8_SCHED;
            PG8_LDB(B0, 1, 0); PG8_LDB(B1, 1, 1); PG8_SCHED; PG8_LDA(At, 1, 0); PG8_STAGE_A(PG8_SA(0, 1), aoc[1], k2);
            PG8_WAIT_V(8); PG8_WAIT_L(0); PG8_BAR; PG8_MMA(0, 0, At, B0); PG8_MMA(0, 1, At, B1); PG8_BAR; PG8_SCHED;
            PG8_LDA(At, 1, 1); PG8_STAGE_B(PG8_SB(1, 0), b3); PG8_STAGE_B(PG8_SB(1, 1), b3 + hstep); PG8_STAGE_A(PG8_SA(1, 0), aoc[0], k3);
            PG8_WAIT_V(8); PG8_WAIT_L(0); PG8_BAR; PG8_MMA(1, 0, At, B0); PG8_MMA(1, 1, At, B1); PG8_BAR; PG8_SCHED;
        }
        if constexpr (ALIGN_EPI) { if (wr == 0) PG8_BAR; }
        E(acc, cur, wr, wc, fr, fq);
        if (!has_next) break;
#pragma unroll
        for (int a = 0; a < 2; ++a)
#pragma unroll
            for (int b = 0; b < 2; ++b)
#pragma unroll
                for (int m = 0; m < 4; ++m)
#pragma unroll
                    for (int n = 0; n < 2; ++n) acc[a][b][m][n] = (f32x4){0.f, 0.f, 0.f, 0.f};
        cur = nxt; cB = nB; ++ui;
        if constexpr (ALIGN_EPI) { if (wr == 1) PG8_BAR; }
    }
    PG8_WAIT_V(0);
    if constexpr (!ALIGN_EPI) { if (wr == 0) PG8_BAR; }
    PG8_BAR;
#undef PG8_SA
#undef PG8_SB
#undef PG8_STAGE_A
#undef PG8_STAGE_B
#undef PG8_LDA
#undef PG8_LDB
#undef PG8_MMA
#undef PG8_WAIT_V
#undef PG8_WAIT_L
#undef PG8_BAR
#undef PG8_SCHED
}

__device__ __forceinline__ int xcd_remap(int L, int nwg) { const int q = nwg / NXCD, r = nwg % NXCD, xcd = L % NXCD, off = L / NXCD; return (xcd < r ? xcd * (q + 1) : r * (q + 1) + (xcd - r) * q) + off; }

constexpr int NG2 = 64;
struct SchedInProj {
    int G, c;
    __device__ __forceinline__ bool next(int i, Unit& u) const {
        constexpr int NLAT = 128 * 7, NCTX = 16 * 4, NWG = NLAT + NCTX + NG2;
        const int L = i * G + c; if (L >= NWG) return false;
        const int wgid = xcd_remap(L, NWG); int pm, pn;
        if (wgid < NLAT) { const int nig = WGM * 7, gid = wgid / nig, j = (wgid % nig) / WGM; pm = gid * WGM + (wgid % nig) % WGM; pn = j < 5 ? j : j + 2; }
        else if (wgid < NLAT + NCTX) { const int w = wgid - NLAT, nig = WGM * 4, gid = w / nig; pm = 128 + gid * WGM + (w % nig) % WGM; pn = (w % nig) / WGM; }
        else { const int w = wgid - NLAT - NCTX; pm = w >> 1; pn = 5 + (w & 1); }
        u.pm = pm; u.pn = pn; u.arow = pm * BM; u.bt = pn * BM; u.nvalid = BM; u.e = 0; return true;
    }
    __device__ __forceinline__ unsigned arow(const Unit& u, int rloc) const { return (unsigned)(u.arow + rloc); }
};
struct SchedInProjG {
    int nwg, c;
    __device__ __forceinline__ bool next(int i, Unit& u) const {
        const int L = NG2 + i * nwg + c; if (L >= 256) return false;
        u.pm = L >> 1; u.pn = 5 + (L & 1); u.arow = u.pm * BM; u.bt = u.pn * BM; u.nvalid = BM; u.e = 0; return true;
    }
    __device__ __forceinline__ unsigned arow(const Unit& u, int rloc) const { return (unsigned)(u.arow + rloc); }
};
struct SchedPlain {
    int G, c, nM, nN;
    __device__ __forceinline__ bool next(int i, Unit& u) const {
        const int nwg = nM * nN, L = i * G + c; if (L >= nwg) return false;
        const int wgid = xcd_remap(L, nwg), nig = WGM * nN, gid = wgid / nig, fm = gid * WGM, gsz = (nM - fm) < WGM ? (nM - fm) : WGM;
        u.pm = fm + ((wgid % nig) % gsz); u.pn = (wgid % nig) / gsz; u.arow = u.pm * BM; u.bt = u.pn * BM; u.nvalid = BM; u.e = 0; return true;
    }
    __device__ __forceinline__ unsigned arow(const Unit& u, int rloc) const { return (unsigned)(u.arow + rloc); }
};
template <int NT, bool GATHER>
struct SchedMoE {
    int G, c; const LAS int* tst; const LAS int* cnt; const int* list;
    __device__ __forceinline__ bool next(int i, Unit& u) const {
        const int nwg = tst[NE] * NT, L = i * G + c; if (L >= nwg) return false;
        const int wgid = xcd_remap(L, nwg);
        int e = 0;
#pragma unroll
        for (int s = 16; s >= 1; s >>= 1) { if (tst[e + s] * NT <= wgid) e += s; }
        const int t0 = tst[e], mt = tst[e + 1] - t0, w = wgid - t0 * NT, nig = WGM * NT, gid = w / nig, fm = gid * WGM, gsz = (mt - fm) < WGM ? (mt - fm) : WGM;
        const int m = fm + ((w % nig) % gsz), n = (w % nig) / gsz;
        u.pm = t0 + m; u.pn = n; u.e = e; u.bt = (e * NT + n) * BM;
        if (GATHER) { u.arow = e * NTOK + m * BM; const int left = cnt[e] - m * BM; u.nvalid = left < BM ? left : BM; }
        else { u.arow = u.pm * BM; u.nvalid = BM; }
        return true;
    }
    __device__ __forceinline__ unsigned arow(const Unit& u, int rloc) const {
        if (GATHER) { const int tok = (rloc < u.nvalid) ? (list[u.arow + rloc] >> 2) : 0; return (unsigned)tok; }
        return (unsigned)(u.arow + rloc);
    }
};

struct EpiInProj {
    bf16_t *KB, *VB, *QB, *GB, *PB; float* RB;
    __device__ __forceinline__ void operator()(const f32x4 (&acc)[2][2][4][2], const Unit& u, int wr, int wc, int fr, int fq) const {
        const int pn = u.pn, row0 = u.pm * BM + wr * 64 + fr;
        if (pn == 3) {
            if (wc != 0) return;
#pragma unroll
            for (int ai = 0; ai < 2; ++ai)
#pragma unroll
                for (int m = 0; m < 4; ++m) { float* rp = RB + (size_t)(row0 + ai * HALF + m * 16) * 32 + 8 * fq;
                    *(f32x4*)rp = acc[ai][0][m][0]; *(f32x4*)(rp + 4) = acc[ai][0][m][1]; }
            return;
        }
        if (pn >= 7) {
#pragma unroll
            for (int ai = 0; ai < 2; ++ai)
#pragma unroll
                for (int m = 0; m < 4; ++m) { const int row = row0 + ai * HALF + m * 16, b = row >> 11, t = row & 2047;
#pragma unroll
                    for (int bj = 0; bj < 2; ++bj) { const int g = (pn - 7) * 2 + bj, cblk = wc * 4 + fq;
                        const f32x4 v0 = acc[ai][bj][m][0], v1 = acc[ai][bj][m][1]; u32x4 w; w.x = cvt_pk_bf16(v0[0], v0[1]); w.y = cvt_pk_bf16(v0[2], v0[3]); w.z = cvt_pk_bf16(v1[0], v1[1]); w.w = cvt_pk_bf16(v1[2], v1[3]);
                        *(u32x4*)(PB + ((((size_t)(b * 4 + g) * 16 + cblk) * 2048 + t) * 8)) = w; } }
            return;
        }
        bf16_t* base; int ldc, coff;
        if (pn == 0) { base = KB; ldc = 256; coff = 0; } else if (pn <= 2) { base = VB; ldc = 512; coff = (pn - 1) * 256; }
        else if (pn == 4) { base = QB; ldc = 256; coff = 0; } else { base = GB; ldc = 512; coff = (pn - 5) * 256; }
        const int col0 = coff + wc * 32 + 8 * fq;
#pragma unroll
        for (int ai = 0; ai < 2; ++ai)
#pragma unroll
            for (int m = 0; m < 4; ++m) { bf16_t* rowp = base + (size_t)(row0 + ai * HALF + m * 16) * ldc + col0;
#pragma unroll
                for (int bj = 0; bj < 2; ++bj) { const f32x4 v0 = acc[ai][bj][m][0], v1 = acc[ai][bj][m][1];
                    u32x4 w; w.x = cvt_pk_bf16(v0[0], v0[1]); w.y = cvt_pk_bf16(v0[2], v0[3]); w.z = cvt_pk_bf16(v1[0], v1[1]); w.w = cvt_pk_bf16(v1[2], v1[3]);
                    *(u32x4*)(rowp + bj * HALF) = w; } }
    }
};
typedef __bf16 bf16x2v __attribute__((ext_vector_type(2)));
__device__ __forceinline__ unsigned pk2n(float lo, float hi) { f32x2 v = {lo, hi}; return __builtin_bit_cast(unsigned, __builtin_convertvector(v, bf16x2v)); }
struct EpiResid {
    const float* x; const float* mod; bf16_t* out;
    __device__ __forceinline__ void operator()(const f32x4 (&acc)[2][2][4][2], const Unit& u, int wr, int wc, int fr, int fq) const {
        const int row0 = u.pm * BM + wr * 64 + fr, col0 = u.pn * BM + wc * 32 + 8 * fq;
        const float* g1 = mod + (size_t)(row0 >> 11) * NMOD + 2048 + col0;
        f32x4 gv[2][2];
#pragma unroll
        for (int bj = 0; bj < 2; ++bj)
#pragma unroll
            for (int n = 0; n < 2; ++n) gv[bj][n] = *(const f32x4*)(g1 + bj * HALF + 4 * n);
        f32x4 xa[2][2], xb[2][2];
#define RES_LOAD(dst, g_) do { const size_t _o = (size_t)(row0 + ((g_) >> 2) * HALF + ((g_) & 3) * 16) * D + col0; \
            _Pragma("unroll") for (int bj = 0; bj < 2; ++bj) _Pragma("unroll") for (int n = 0; n < 2; ++n) dst[bj][n] = *(const f32x4*)(x + _o + bj * HALF + 4 * n); } while (0)
#define RES_STORE(src, g_) do { const size_t _o = (size_t)(row0 + ((g_) >> 2) * HALF + ((g_) & 3) * 16) * D + col0; \
            _Pragma("unroll") for (int bj = 0; bj < 2; ++bj) { const f32x4 _a = src[bj][0] + gv[bj][0] * acc[(g_) >> 2][bj][(g_) & 3][0], _b = src[bj][1] + gv[bj][1] * acc[(g_) >> 2][bj][(g_) & 3][1]; \
                u32x4 _w; _w.x = pk2n(_a.x, _a.y); _w.y = pk2n(_a.z, _a.w); _w.z = pk2n(_b.x, _b.y); _w.w = pk2n(_b.z, _b.w); *(u32x4*)(out + _o + bj * HALF) = _w; } } while (0)
        RES_LOAD(xa, 0);
#pragma unroll
        for (int g2 = 0; g2 < 8; g2 += 2) { RES_LOAD(xb, g2 + 1); RES_STORE(xa, g2); if (g2 + 2 < 8) RES_LOAD(xa, g2 + 2); RES_STORE(xb, g2 + 1); }
#undef RES_LOAD
#undef RES_STORE
    }
};
__device__ __forceinline__ unsigned pk4_fp8(float a, float b, float c, float d) { int w = 0; w = __builtin_amdgcn_cvt_pk_fp8_f32(a, b, w, false); w = __builtin_amdgcn_cvt_pk_fp8_f32(c, d, w, true); return (unsigned)w; }
template <bool FP8>
struct EpiSwiglu {
    void* act; const float* bgu; float ascale;
    __device__ __forceinline__ void operator()(const f32x4 (&acc)[2][2][4][2], const Unit& u, int wr, int wc, int fr, int fq) const {
        const int row0 = u.pm * BM + wr * 64 + fr, cc = u.pn * HALF + wc * 32 + 8 * fq;
        const float* bg = bgu + (size_t)u.e * 2048 + cc;
        f32x4 bgv[2], buv[2];
#pragma unroll
        for (int n = 0; n < 2; ++n) { bgv[n] = *(const f32x4*)(bg + 4 * n); buv[n] = *(const f32x4*)(bg + 1024 + 4 * n); }
#pragma unroll
        for (int ai = 0; ai < 2; ++ai)
#pragma unroll
            for (int m = 0; m < 4; ++m) { float r[8];
#pragma unroll
                for (int n = 0; n < 2; ++n) { const f32x4 gq = acc[ai][0][m][n] * ascale + bgv[n], uq = acc[ai][1][m][n] * ascale + buv[n];
#pragma unroll
                    for (int j = 0; j < 4; j += 2) { f32x2 gt = {fminf(gq[j], 7.f), fminf(gq[j + 1], 7.f)};
                        f32x2 up1 = {fminf(fmaxf(uq[j], -7.f), 7.f), fminf(fmaxf(uq[j + 1], -7.f), 7.f)}; up1 = up1 + 1.f;
                        const f32x2 z = gt * (-1.702f * 1.44269504089f);
                        f32x2 d = {__builtin_amdgcn_exp2f(z.x), __builtin_amdgcn_exp2f(z.y)}; d = d + 1.f;
                        const f32x2 rc = {__builtin_amdgcn_rcpf(d.x), __builtin_amdgcn_rcpf(d.y)};
                        const f32x2 o = (up1 * gt) * rc; r[4 * n + j] = o.x; r[4 * n + j + 1] = o.y; } }
                if constexpr (FP8) { u32x2 w; w.x = pk4_fp8(r[0], r[1], r[2], r[3]); w.y = pk4_fp8(r[4], r[5], r[6], r[7]);
                    *(u32x2*)((unsigned char*)act + (size_t)(row0 + ai * HALF + m * 16) * DFF + cc) = w; }
                else { u32x4 w; w.x = cvt_pk_bf16(r[0], r[1]); w.y = cvt_pk_bf16(r[2], r[3]); w.z = cvt_pk_bf16(r[4], r[5]); w.w = cvt_pk_bf16(r[6], r[7]);
                    *(u32x4*)((bf16_t*)act + (size_t)(row0 + ai * HALF + m * 16) * DFF + cc) = w; } }
    }
};
struct EpiDown {
    unsigned char* y; const float* bd; float ascale;
    __device__ __forceinline__ void operator()(const f32x4 (&acc)[2][2][4][2], const Unit& u, int wr, int wc, int fr, int fq) const {
        const int row0 = u.pm * BM + wr * 64 + fr, col0 = u.pn * BM + wc * 32 + 8 * fq;
        const float* bp = bd + (size_t)u.e * D + col0;
        f32x4 bv[2][2];
#pragma unroll
        for (int bj = 0; bj < 2; ++bj)
#pragma unroll
            for (int n = 0; n < 2; ++n) bv[bj][n] = *(const f32x4*)(bp + bj * HALF + 4 * n);
#pragma unroll
        for (int ai = 0; ai < 2; ++ai)
#pragma unroll
            for (int m = 0; m < 4; ++m) { unsigned char* rowp = y + (size_t)(row0 + ai * HALF + m * 16) * D + col0;
#pragma unroll
                for (int bj = 0; bj < 2; ++bj) { const f32x4 v0 = acc[ai][bj][m][0] * ascale + bv[bj][0], v1 = acc[ai][bj][m][1] * ascale + bv[bj][1];
                    u32x2 w; w.x = pk4_fp8(v0[0], v0[1], v0[2], v0[3]); w.y = pk4_fp8(v1[0], v1[1], v1[2], v1[3]);
                    *(u32x2*)(rowp + bj * HALF) = w; } }
    }
};
}

constexpr size_t MiB = 1u << 20;
constexpr size_t WS_CTL = 0, WS_MOD = 1 * MiB, WS_TOPW = 2 * MiB, WS_ASG = 3 * MiB, WS_WRT = 3 * MiB + 512 * 1024, WS_LIST = 4 * MiB, WS_WIN = 8 * MiB, WS_WOUT = 13 * MiB,
                 WS_WGU = 16 * MiB, WS_WD = 80 * MiB, WS_HN1 = 112 * MiB, WS_HN2 = 112 * MiB,
                 WS_KB = 184 * MiB, WS_VB = 202 * MiB, WS_RB = 238 * MiB, WS_QB = 243 * MiB, WS_GB = 259 * MiB, WS_PB = 291 * MiB,
                 WS_OF = 323 * MiB, WS_OB = 387 * MiB, WS_MIX = 451 * MiB, WS_ACT = 184 * MiB, WS_Y = 515 * MiB, WS_H1B = 660 * MiB, WS_END = 787 * MiB;
static_assert(WS_ACT + (size_t)NPADROWS * DFF <= WS_Y && WS_Y + (size_t)NPADROWS * D <= WS_H1B && WS_H1B + (size_t)NTOK * D * 2 <= WS_END, "ws map");


constexpr int CW_CNT = 0;
constexpr int CW_BAR = 4096;

constexpr int RING_BYTES = 131072;
constexpr int LDSCTL_OFF = 155648;
constexpr int LDS_BYTES = 163840;
constexpr int LC_BAR = 0, LC_TST = 16, LC_CNT = 64;

#define XB_TMO      128
#define XB_XCNT(j)  (256  + 64 * (j))
#define XB_XSUB(j)  (1280 + 64 * (j))
#define XB_XGEN(j)  (2304 + 64 * (j))
#define XB_TOP      3328
#define XB_TOPGEN   3392
#define XCD_BAR_WORDS 3456
#define XB_SPIN_CAP (1u << 18)
__device__ __forceinline__ unsigned xb_ld(unsigned* p)              { return __hip_atomic_load(p, __ATOMIC_RELAXED, __HIP_MEMORY_SCOPE_AGENT); }
__device__ __forceinline__ unsigned xb_add(unsigned* p, unsigned v) { return __hip_atomic_fetch_add(p, v, __ATOMIC_RELAXED, __HIP_MEMORY_SCOPE_AGENT); }
__device__ __forceinline__ unsigned xb_xcc_id() { return (unsigned)__builtin_amdgcn_s_getreg((3 << 11) | 20) & 0xFu; }
#define XB_SPIN(cond, bar) do { unsigned _sp = 0; while (cond) { __builtin_amdgcn_s_sleep(1); \
    if ((++_sp & 255u) == 0u) { if (xb_ld(&(bar)[XB_TMO])) break; if (_sp > XB_SPIN_CAP) { atomicAdd(&(bar)[XB_TMO], 1u); break; } } } } while (0)
struct XcdBarrier { unsigned* bar; unsigned x; volatile LAS unsigned* st; };
__device__ __forceinline__ XcdBarrier xcd_barrier_post(unsigned* bar, volatile LAS unsigned* st) {
    XcdBarrier b; b.bar = bar; b.x = xb_xcc_id(); b.st = st;
    if (threadIdx.x == 0) (void)xb_add(&bar[XB_XCNT(b.x)], 1u);
    return b;
}
__device__ __forceinline__ void xcd_barrier_complete(unsigned* bar, unsigned x, unsigned& nloc, unsigned& nx) {
    const unsigned G = gridDim.x * gridDim.y * gridDim.z;
    unsigned sum, cnt, mine, sp = 0u;
    for (;;) {
        sum = 0u; cnt = 0u; mine = 0u;
#pragma unroll
        for (unsigned j = 0; j < 16; ++j) { const unsigned c = xb_ld(&bar[XB_XCNT(j)]); sum += c; cnt += (c > 0u) ? 1u : 0u; mine = (j == x) ? c : mine; }
        if (sum == G) break;
        __builtin_amdgcn_s_sleep(1);
        if ((++sp & 255u) == 0u) { if (xb_ld(&bar[XB_TMO])) break; if (sp > XB_SPIN_CAP) { atomicAdd(&bar[XB_TMO], 1u); break; } }
    }
    nloc = mine > 0u ? mine : 1u; nx = cnt > 0u ? cnt : 1u;
}
__device__ __forceinline__ void xcd_barrier(const XcdBarrier& b) {
    asm volatile("s_waitcnt vmcnt(0)" ::: "memory");
    __syncthreads();
    if (threadIdx.x == 0) {
        unsigned* bar = b.bar;
        __builtin_amdgcn_s_waitcnt(0);
        unsigned nloc = b.st[0], nx = b.st[1];
        if (nloc == 0u) { xcd_barrier_complete(bar, b.x, nloc, nx); b.st[0] = nloc; b.st[1] = nx; }
        const unsigned old = xb_add(&bar[XB_XSUB(b.x)], 1u);
        const unsigned gen = old / nloc;
        if (old + 1u == (gen + 1u) * nloc) {
            __builtin_amdgcn_fence(__ATOMIC_RELEASE, "agent");
            asm volatile("s_waitcnt vmcnt(0)" ::: "memory");
            const unsigned og = xb_add(&bar[XB_TOP], 1u);
            const unsigned tg = og / nx;
            if (og + 1u == (tg + 1u) * nx) xb_add(&bar[XB_TOPGEN], 1u);
            else XB_SPIN(xb_ld(&bar[XB_TOPGEN]) == tg, bar);
            __builtin_amdgcn_fence(__ATOMIC_ACQUIRE, "agent");
            xb_add(&bar[XB_XGEN(b.x)], 1u);
            asm volatile("s_waitcnt vmcnt(0)" ::: "memory");
        } else {
            XB_SPIN(xb_ld(&bar[XB_XGEN(b.x)]) == gen, bar);
            __builtin_amdgcn_fence(__ATOMIC_ACQUIRE, "agent");
            asm volatile("s_waitcnt vmcnt(0)" ::: "memory");
        }
    }
    __syncthreads();
}

struct Args { const float* in[24]; float* out; unsigned char* ws; int ph_lo, ph_hi; };
struct Frame {
    LAS unsigned char* lds;
    int tid, lane, wave, vcu, G;
    const float* const* in; float* out; unsigned char* ws;
};
#define IN_X 0
#define IN_C 1
#define IN_CTX 2
#define IN_CCTX 3
#define IN_WADA 4
#define IN_BADA 5
#define IN_NMIX 6
#define IN_NMLP 7
#define IN_WIN 8
#define IN_WGKF 9
#define IN_BGKF 10
#define IN_WGKB 11
#define IN_BGKB 12
#define IN_GLANW 13
#define IN_WPOOL 14
#define IN_PSCALE 15
#define IN_WOUT 16
#define IN_WROUTER 17
#define IN_BROUTER 18
#define IN_WGU 19
#define IN_BGU 20
#define IN_WDOWN 21
#define IN_BDOWN 22
#define IN_FNW 23

__device__ __forceinline__ void p0_transpose_item(const float* W, int ldw, int k0, int n0, bf16_t* WT, int ldd, int drow, int dk0, LAS float* scr, int lane) {
#pragma unroll 8
    for (int i = 0; i < 32; ++i) { const int kk = 2 * i + (lane >> 5); scr[kk * 33 + (lane & 31)] = W[(size_t)(k0 + kk) * ldw + n0 + (lane & 31)]; }
    LDS_WAIT(); asm volatile("" ::: "memory");
    const int c = lane & 7;
#pragma unroll
    for (int j = 0; j < 4; ++j) { const int n = (lane >> 3) + 8 * j; const LAS float* s = scr + (8 * c) * 33 + n;
        u32x4 o; o.x = pk2(s[0 * 33], s[1 * 33]); o.y = pk2(s[2 * 33], s[3 * 33]); o.z = pk2(s[4 * 33], s[5 * 33]); o.w = pk2(s[6 * 33], s[7 * 33]);
        *(u32x4*)(WT + (size_t)(drow + n) * ldd + dk0 + k0 + 8 * c) = o; }
    LDS_WAIT(); asm volatile("" ::: "memory");
}
__device__ __forceinline__ int win_drow(int n0) {
    if (n0 < 256) return 4 * 256 + n0;
    if (n0 < 512) return n0 - 256;
    if (n0 < 1024) return 256 + (n0 - 512);
    if (n0 < 1536) return 5 * 256 + (n0 - 1024);
    if (n0 < 1568) return 3 * 256 + (n0 - 1536);
    return 7 * 256 + (n0 - 1568);
}
__device__ __forceinline__ void p0_mod_item(Frame& F, int item, const LAS float* SL, float* mod) {
    const float* w_ada = F.in[IN_WADA]; const float* b_ada = F.in[IN_BADA];
    const int j = item * 8 + (F.lane & 7), kp = F.lane >> 3;
    float acc[17];
#pragma unroll
    for (int r = 0; r < 17; ++r) acc[r] = 0.f;
#pragma unroll 4
    for (int i = 0; i < 128; ++i) { const int k = kp + 8 * i; const float w = w_ada[(size_t)k * NMOD + j];
#pragma unroll
        for (int r = 0; r < 17; ++r) acc[r] += SL[r * 1024 + k] * w; }
#pragma unroll
    for (int r = 0; r < 17; ++r) { float a = acc[r]; a += __shfl_xor(a, 8); a += __shfl_xor(a, 16); a += __shfl_xor(a, 32); if (kp == 0) mod[r * NMOD + j] = a + b_ada[j]; }
}
__device__ __forceinline__ void p0_weff_item(Frame& F, int item, LAS float* scr, bf16_t* Wout_t) {
    const float* w_pool = F.in[IN_WPOOL]; const float* pscale = F.in[IN_PSCALE]; const float* w_out = F.in[IN_WOUT];
    const int g = item >> 6, n0 = (item & 63) * 16, lane = F.lane;
#pragma unroll 4
    for (int q = 0; q < 32; ++q) { const int idx = lane + 64 * q, j = idx >> 4, nn = idx & 15; scr[idx] = w_out[(size_t)(512 + g * 128 + j) * D + n0 + nn] * pscale[g * 128 + j]; }
    LDS_WAIT(); asm volatile("" ::: "memory");
    float a0[16], a1[16];
#pragma unroll
    for (int nn = 0; nn < 16; ++nn) { a0[nn] = 0.f; a1[nn] = 0.f; }
    const float* wp0 = w_pool + (size_t)(g * 128 + lane) * 128; const float* wp1 = wp0 + 64 * 128;
    for (int j = 0; j < 128; ++j) { const float p0 = wp0[j], p1 = wp1[j];
#pragma unroll
        for (int q = 0; q < 4; ++q) { const f32x4 t = *(const LAS f32x4*)(scr + j * 16 + 4 * q);
#pragma unroll
            for (int z = 0; z < 4; ++z) { a0[4 * q + z] += p0 * t[z]; a1[4 * q + z] += p1 * t[z]; } } }
#pragma unroll
    for (int nn = 0; nn < 16; ++nn) { bf16_t* o = Wout_t + (size_t)(n0 + nn) * D + 512 + g * 128 + lane; o[0] = (bf16_t)f2bf(a0[nn]); o[64] = (bf16_t)f2bf(a1[nn]); }
    LDS_WAIT(); asm volatile("" ::: "memory");
}
constexpr int P0_CVT_E = 0;
constexpr float WSCALE = 32.f;
constexpr int CVP = 260;
__device__ __forceinline__ unsigned pk4_fp8s(float a, float b, float c, float d) { int w = 0; w = __builtin_amdgcn_cvt_pk_fp8_f32(a * WSCALE, b * WSCALE, w, false); w = __builtin_amdgcn_cvt_pk_fp8_f32(c * WSCALE, d * WSCALE, w, true); return (unsigned)w; }
struct CvtItem { const float* src; int ldw, k0, n0, e; bool gu; };
__device__ __forceinline__ CvtItem cvt_decode(Frame& F, int item) {
    CvtItem c;
    if (item < 2048) { c.gu = true; c.e = item >> 6; c.k0 = ((item >> 3) & 7) * 128; c.n0 = (item & 7) * 256; c.src = F.in[IN_WGU] + (size_t)c.e * D * 2048; c.ldw = 2048; }
    else { const int r = item - 2048 + P0_CVT_E * 32; c.gu = false; c.e = r >> 5; c.k0 = ((r >> 2) & 7) * 128; c.n0 = (r & 3) * 256; c.src = F.in[IN_WDOWN] + (size_t)c.e * DFF * D; c.ldw = D; }
    return c;
}
template <int MODE>
__device__ __forceinline__ void cvt_expert_items(Frame& F, int first, int stride, int nitems) {
    if (first >= nitems) return;
    LAS float* T = (LAS float*)F.lds;
    int tid = F.tid; asm volatile("" : "+v"(tid));
    f32x4 R[16];
    { const CvtItem c = cvt_decode(F, first);
#pragma unroll
      for (int i = 0; i < 16; ++i) { const int idx = tid + NTHR * i, kk = idx >> 6, n4 = idx & 63; R[i] = __builtin_nontemporal_load((const f32x4*)(c.src + (size_t)(c.k0 + kk) * c.ldw + c.n0 + 4 * n4)); } }
    for (int item = first; item < nitems; item += stride) {
        const CvtItem c = cvt_decode(F, item);
#pragma unroll
        for (int i = 0; i < 16; ++i) { const int idx = tid + NTHR * i, kk = idx >> 6, n4 = idx & 63; *(LAS f32x4*)(T + kk * CVP + 4 * n4) = R[i]; }
        __syncthreads();
        if (MODE != 1 && item + stride < nitems) { const CvtItem cn = cvt_decode(F, item + stride);
#pragma unroll
            for (int i = 0; i < 16; ++i) { const int idx = tid + NTHR * i, kk = idx >> 6, n4 = idx & 63; R[i] = __builtin_nontemporal_load((const f32x4*)(cn.src + (size_t)(cn.k0 + kk) * cn.ldw + cn.n0 + 4 * n4)); } }
        u32x4 o[4];
        { const int n = F.wave * 32 + (F.lane & 31), half = F.lane >> 5;
          const LAS float* col = T + (64 * half) * CVP + n;
#pragma unroll
          for (int q = 0; q < 4; ++q) { unsigned w4[4];
#pragma unroll
              for (int z = 0; z < 4; ++z) { const LAS float* p = col + (16 * q + 4 * z) * CVP; w4[z] = pk4_fp8s(p[0], p[CVP], p[2 * CVP], p[3 * CVP]); }
              o[q] = (u32x4){w4[0], w4[1], w4[2], w4[3]}; }
          __syncthreads();
          LAS unsigned char* OUTL = (LAS unsigned char*)F.lds;
#pragma unroll
          for (int q = 0; q < 4; ++q) *(LAS u32x4*)(OUTL + n * 144 + half * 64 + q * 16) = o[q]; }
        __syncthreads();
#pragma unroll
        for (int i = 0; i < 4; ++i) { const int idx = tid + NTHR * i, n = idx >> 3, ch = idx & 7;
            const u32x4 v = *(const LAS u32x4*)((const LAS unsigned char*)F.lds + n * 144 + ch * 16);
            size_t drow;
            if (c.gu) { const int jn = (c.n0 + n) & 1023; drow = (size_t)c.e * 2048 + (jn >> 7) * 256 + ((c.n0 + n) >= 1024 ? 128 : 0) + (jn & 127); }
            else drow = (size_t)c.e * D + c.n0 + n;
            if (MODE != 2 || v.x == 0x12345678u) *(u32x4*)((unsigned char*)(F.ws + (c.gu ? WS_WGU : WS_WD)) + drow * 1024 + c.k0 + ch * 16) = v; }
        __syncthreads();
    }
}

constexpr int CVH = 64 * CVP * 4;
__device__ __forceinline__ void cvt_dma_issue(Frame& F, int first, int stride, int t) {
    const CvtItem c = cvt_decode(F, first + (t >> 1) * stride); const int half = t & 1;
    LAS unsigned char* buf = F.lds + (t & 1) * CVH;
#pragma unroll
    for (int i = 0; i < 8; ++i) { const int row = 8 * F.wave + i;
        __builtin_amdgcn_global_load_lds((const unsigned*)(c.src + (size_t)(c.k0 + 64 * half + row) * c.ldw + c.n0 + 4 * F.lane), (LAS unsigned*)(buf + row * (CVP * 4)), 16, 0, 2); }
}
#define CVT_LW() asm volatile("s_waitcnt lgkmcnt(0)" ::: "memory")
#define CVT_BAR() do { __builtin_amdgcn_s_barrier(); asm volatile("" ::: "memory"); } while (0)
__device__ __forceinline__ void cvt_expert_items_dma(Frame& F, int first, int stride, int nitems) {
    if (first >= nitems) return;
    const int nh = 2 * ((nitems - first + stride - 1) / stride);
    int tid = F.tid; asm volatile("" : "+v"(tid));
    cvt_dma_issue(F, first, stride, 0); cvt_dma_issue(F, first, stride, 1);
    for (int t = 0; t < nh; ++t) {
        const CvtItem c = cvt_decode(F, first + (t >> 1) * stride); const int half = t & 1;
        LAS unsigned char* buf = F.lds + (t & 1) * CVH; const LAS float* T = (const LAS float*)buf;
        if (t + 1 < nh) asm volatile("s_waitcnt vmcnt(8)" ::: "memory"); else asm volatile("s_waitcnt vmcnt(0)" ::: "memory");
        CVT_BAR();
        u32x4 o0, o1;
        { const int n = F.wave * 32 + (F.lane & 31), kq = F.lane >> 5;
          const LAS float* col = T + (32 * kq) * CVP + n; unsigned w8[8];
#pragma unroll
          for (int z = 0; z < 8; ++z) { const LAS float* p = col + (4 * z) * CVP; w8[z] = pk4_fp8s(p[0], p[CVP], p[2 * CVP], p[3 * CVP]); }
          o0 = (u32x4){w8[0], w8[1], w8[2], w8[3]}; o1 = (u32x4){w8[4], w8[5], w8[6], w8[7]};
          CVT_LW(); CVT_BAR();
          *(LAS u32x4*)(buf + n * 80 + kq * 32) = o0; *(LAS u32x4*)(buf + n * 80 + kq * 32 + 16) = o1; }
        CVT_LW(); CVT_BAR();
#pragma unroll
        for (int i = 0; i < 2; ++i) { const int idx = tid + NTHR * i, n = idx >> 2, ch = idx & 3;
            const u32x4 v = *(const LAS u32x4*)(buf + n * 80 + ch * 16);
            size_t drow;
            if (c.gu) { const int jn = (c.n0 + n) & 1023; drow = (size_t)c.e * 2048 + (jn >> 7) * 256 + ((c.n0 + n) >= 1024 ? 128 : 0) + (jn & 127); }
            else drow = (size_t)c.e * D + c.n0 + n;
            *(u32x4*)((unsigned char*)(F.ws + (c.gu ? WS_WGU : WS_WD)) + drow * 1024 + c.k0 + 64 * half + ch * 16) = v; }
        CVT_LW(); CVT_BAR();
        if (t + 2 < nh) cvt_dma_issue(F, first, stride, t + 2);
    }
}
#undef CVT_LW
#undef CVT_BAR


__device__ __forceinline__ void p0_prologue(Frame& F, bool do_experts) {
    { bf16_t* WRT = (bf16_t*)(F.ws + WS_WRT); const float* wr = F.in[IN_WROUTER];
      for (int idx = F.vcu * NTHR + F.tid; idx < D * NE; idx += F.G * NTHR) { const int k = idx >> 5, e = idx & 31; const float v = wr[idx]; const unsigned hi = f2bf(v);
          WRT[e * D + k] = (bf16_t)hi; WRT[NE * D + e * D + k] = (bf16_t)f2bf(v - bf2f(hi)); } }
    LAS float* SL = (LAS float*)F.lds;
    for (int idx = F.tid; idx < 17 * 1024; idx += NTHR) { const int r = idx >> 10, k = idx & 1023; const float v = r < NB ? F.in[IN_C][r * D + k] : F.in[IN_CCTX][k]; SL[idx] = silu_f(v); }
    __syncthreads();
    LAS float* scr = (LAS float*)(F.lds + 69632 + F.wave * 8448);
    bf16_t* Win_t = (bf16_t*)(F.ws + WS_WIN); bf16_t* Wout_t = (bf16_t*)(F.ws + WS_WOUT); bf16_t* Wgu_t = (bf16_t*)(F.ws + WS_WGU); bf16_t* Wd_t = (bf16_t*)(F.ws + WS_WD);
    float* mod = (float*)(F.ws + WS_MOD);
    constexpr int I_MOD = NMOD / 8, I_WEFF = 4 * 64, I_WIN = 16 * (DIN / 32), I_ZERO = 224, I_WOUT = 8 * 32, I_GU = NE * 16 * 64, I_DN = NE * 16 * 32;
    const int nitems = I_MOD + I_WEFF + I_WIN + I_ZERO + I_WOUT + (do_experts ? I_GU + I_DN : 0);
    const int gw = F.wave * F.G + F.vcu, NGW = F.G * NWAVES;
    for (int it = gw; it < nitems; it += NGW) {
        int r = it;
        if (r < I_MOD) { p0_mod_item(F, r, SL, mod); continue; } r -= I_MOD;
        if (r < I_WEFF) { p0_weff_item(F, r, scr, Wout_t); continue; } r -= I_WEFF;
        if (r < I_WIN) { const int kb = r / (DIN / 32), nb = r % (DIN / 32); p0_transpose_item(F.in[IN_WIN], DIN, 64 * kb, 32 * nb, Win_t, D, win_drow(32 * nb), 0, scr, F.lane); continue; } r -= I_WIN;
        if (r < I_ZERO) { u32x4* o = (u32x4*)(Win_t + (size_t)(3 * 256 + 32 + r) * D) + F.lane * 2; o[0] = (u32x4){0u, 0u, 0u, 0u}; o[1] = (u32x4){0u, 0u, 0u, 0u}; continue; } r -= I_ZERO;
        if (r < I_WOUT) { const int kb = r / 32, nb = r % 32; p0_transpose_item(F.in[IN_WOUT], D, 64 * kb, 32 * nb, Wout_t, D, 32 * nb, 0, scr, F.lane); continue; } r -= I_WOUT;
        if (r < I_GU) { const int e = r / (16 * 64), q = r % (16 * 64), kb = q / 64, nb = q % 64, n0 = 32 * nb, jn = n0 & 1023;
            const int drow = e * 2048 + (jn >> 7) * 256 + (n0 >= 1024 ? 128 : 0) + (jn & 127);
            p0_transpose_item(F.in[IN_WGU] + (size_t)e * D * 2048, 2048, 64 * kb, n0, Wgu_t, D, drow, 0, scr, F.lane); continue; } r -= I_GU;
        { const int e = r / (16 * 32), q = r % (16 * 32), kb = q / 32, nb = q % 32;
            p0_transpose_item(F.in[IN_WDOWN] + (size_t)e * DFF * D, D, 64 * kb, 32 * nb, Wd_t, DFF, e * D + 32 * nb, 0, scr, F.lane); }
    }}

__device__ __forceinline__ void norm_row_bf16(const float* src, const float* wn, const float* sh, const float* sc, bf16_t* dst, int lane) {
    const f32x4* xr = (const f32x4*)src + lane;
    f32x4 v[4]; float s = 0.f;
#pragma unroll
    for (int j = 0; j < 4; ++j) { v[j] = xr[64 * j]; s += (v[j].x * v[j].x + v[j].y * v[j].y) + (v[j].z * v[j].z + v[j].w * v[j].w); }
    const float rstd = rsqrtf(wave_sum(s) * (1.f / D) + EPS);
    u32x2* o8 = (u32x2*)dst + lane;
#pragma unroll
    for (int j = 0; j < 4; ++j) { const f32x4 w = ((const f32x4*)wn)[lane + 64 * j], a = ((const f32x4*)sc)[lane + 64 * j], b = ((const f32x4*)sh)[lane + 64 * j];
        const f32x4 y = v[j] * rstd * w * (a + 1.f) + b; u32x2 p; p.x = pk2(y.x, y.y); p.y = pk2(y.z, y.w); o8[64 * j] = p; }
}
__device__ __forceinline__ void p1_norm1(Frame& F) {
    const float* mod = (const float*)(F.ws + WS_MOD); bf16_t* HN = (bf16_t*)(F.ws + WS_HN1);
    constexpr int RPB = NROW / 256;
    for (int blk = F.vcu; blk < 256; blk += F.G)
        for (int r = F.wave; r < RPB; r += NWAVES) { const int row = blk * RPB + r;
            const float* src = row < NTOK ? F.in[IN_X] + (size_t)row * D : F.in[IN_CTX] + (size_t)(row - NTOK) * D;
            const float* mr = mod + (size_t)(row < NTOK ? row / SEQ : NB) * NMOD;
            norm_row_bf16(src, F.in[IN_NMIX], mr, mr + 1024, HN + (size_t)row * D, F.lane); }
}

typedef __bf16 bf16x2n __attribute__((ext_vector_type(2)));
__device__ __forceinline__ unsigned pkbf(float lo, float hi) { f32x2 v = {lo, hi}; return __builtin_bit_cast(unsigned, __builtin_convertvector(v, bf16x2n)); }
#define MFMA32(a, b, c) __builtin_amdgcn_mfma_f32_32x32x16_bf16((a), (b), (c), 0, 0, 0)
constexpr int GP = 72;
constexpr int GL_QP = 0, GL_KP = 9216, GL_QQ = 18432, GL_KKT = 27648, GL_VT = 36864, GL_DEC = 55296, GL_GSUM = 55552, GL_R = 57600, GL_END = 61696;

__device__ __forceinline__ bf16x8 pack8(const f32x16& x, int s) {
    u32x4 p; p.x = pkbf(x[8 * s + 0], x[8 * s + 1]); p.y = pkbf(x[8 * s + 2], x[8 * s + 3]); p.z = pkbf(x[8 * s + 4], x[8 * s + 5]); p.w = pkbf(x[8 * s + 6], x[8 * s + 7]);
    return __builtin_bit_cast(bf16x8, p);
}
__device__ __forceinline__ bf16x8 ld_perm8(const LAS bf16_t* p) {
    const u32x2 a = *(const LAS u32x2*)p, b = *(const LAS u32x2*)(p + 8); u32x4 r; r.x = a.x; r.y = a.y; r.z = b.x; r.w = b.y; return __builtin_bit_cast(bf16x8, r);
}
__device__ __forceinline__ bf16x8 ld_nat8(const LAS bf16_t* p) { return *(const LAS bf16x8*)p; }

template <int GM>
__device__ __forceinline__ void gla_unit(Frame& F, const int unit) {
    const int b = unit >> 3, h = (unit >> 1) & 3, dir = unit & 1;
    const int w = F.wave, lane = F.lane, tid = F.tid;
    LAS unsigned char* L = F.lds;
    LAS bf16_t* QP = (LAS bf16_t*)(L + GL_QP); LAS bf16_t* KP = (LAS bf16_t*)(L + GL_KP); LAS bf16_t* QQ = (LAS bf16_t*)(L + GL_QQ);
    LAS bf16_t* KKT = (LAS bf16_t*)(L + GL_KKT); LAS bf16_t* VT = (LAS bf16_t*)(L + GL_VT);
    LAS float* DEC = (LAS float*)(L + GL_DEC); LAS float* GSUM = (LAS float*)(L + GL_GSUM); LAS float* RL = (LAS float*)(L + GL_R);
    const bf16_t* QB = (const bf16_t*)(F.ws + WS_QB); const bf16_t* KB = (const bf16_t*)(F.ws + WS_KB); const bf16_t* VB = (const bf16_t*)(F.ws + WS_VB);
    const float* RB = (const float*)(F.ws + WS_RB);
    bf16_t* OD = (bf16_t*)(F.ws + (GM >= 3 ? (dir ? 870 * MiB : 830 * MiB) : (dir ? WS_OB : WS_OF)));
    const float* wgk = F.in[dir ? IN_WGKB : IN_WGKF]; const float* bgk = F.in[dir ? IN_BGKB : IN_BGKF];
    f32x2 wg[8];
#pragma unroll
    for (int j = 0; j < 8; ++j) wg[j] = (f32x2){wgk[(2 * j) * 256 + h * 64 + lane], wgk[(2 * j + 1) * 256 + h * 64 + lane]};
    const float bg = bgk[h * 64 + lane];
    f32x16 S0, S1;
#pragma unroll
    for (int i = 0; i < 16; ++i) { S0[i] = 0.f; S1[i] = 0.f; }
    const int tb = w >> 2, vb = w & 3, c = lane & 31, hh = lane >> 5;
    const int vs = lane, vc = w;
    const int rs = tid >> 3, rc = tid & 7;
    unsigned pq[8], pk[8]; u32x4 pv0, pv1; f32x2 pr;
#define GLA_LOAD(step) do { const int _s = (step); const bool _ctx = _s < 4; const int _ci = _ctx ? _s : _s - 4; const int _ch = dir ? ((_ctx ? 3 : 31) - _ci) : _ci; \
        const int _row0 = _ctx ? NTOK + b * CTX + _ch * 64 : b * SEQ + _ch * 64; \
        _Pragma("unroll") for (int _i = 0; _i < 8; ++_i) { const int _t = 8 * w + _i; const size_t _row = (size_t)(_row0 + (dir ? 63 - _t : _t)); \
            pk[_i] = KB[_row * 256 + h * 64 + lane]; pq[_i] = _ctx ? 0u : (unsigned)QB[_row * 256 + h * 64 + lane]; } \
        { const size_t _row = (size_t)(_row0 + (dir ? 63 - vs : vs)); const u32x4* _vp = (const u32x4*)(VB + _row * 512 + h * 128 + vc * 16); pv0 = _vp[0]; pv1 = _vp[1]; \
          const size_t _rr = (size_t)(_row0 + (dir ? 63 - rs : rs)); pr = *(const f32x2*)(RB + _rr * 32 + dir * 16 + rc * 2); } } while (0)
    GLA_LOAD(0);
    for (int step = 0; step < 36; ++step) {
        const bool isctx = step < 4; const int ci = isctx ? step : step - 4; const int chunk = dir ? ((isctx ? 3 : 31) - ci) : ci;
        const int row0 = isctx ? NTOK + b * CTX + chunk * 64 : b * SEQ + chunk * 64;
        unsigned cq[8], ck[8]; u32x4 cv0 = pv0, cv1 = pv1;
#pragma unroll
        for (int i = 0; i < 8; ++i) { cq[i] = pq[i]; ck[i] = pk[i]; }
        *(LAS f32x2*)(RL + rs * 16 + rc * 2) = pr;
        __syncthreads();
        float cs[8];
        { float run = 0.f;
#pragma unroll
          for (int i = 0; i < 8; ++i) { const LAS f32x4* rp = (const LAS f32x4*)(RL + (8 * w + i) * 16); f32x2 a2 = {bg, 0.f};
#pragma unroll
              for (int q4 = 0; q4 < ((GM == 3) ? 1 : 4); ++q4) { const f32x4 rv = rp[q4]; a2 = __builtin_elementwise_fma((f32x2){rv[0], rv[1]}, wg[2 * q4], a2); a2 = __builtin_elementwise_fma((f32x2){rv[2], rv[3]}, wg[2 * q4 + 1], a2); }
              const float x = a2.x + a2.y;
              const float gk = (GM == 3) ? x * 1e-3f : __builtin_fmaf(__builtin_amdgcn_logf(1.f + __builtin_amdgcn_exp2f(fabsf(x) * -1.44269504089f)), -0.69314718056f / 16.f, fminf(x, 0.f) * (1.f / 16.f));
              run += gk; cs[i] = run; }
          GSUM[w * 64 + lane] = run; }
        __syncthreads();
        { float pre = 0.f, mid = 0.f, tot = 0.f;
#pragma unroll
          for (int g = 0; g < 8; ++g) { const float gsum = GSUM[g * 64 + lane]; if (g < w) pre += gsum; if (g < 4) mid += gsum; tot += gsum; }
          if (w == 0) DEC[lane] = __expf(tot);
          const f32x2 emt = {__expf(mid), __expf(tot - mid)}; const float pm = pre - mid;
          u32x4 kk4;
          float kkf[8];
#pragma unroll
          for (int i = 0; i < ((GM == 4) ? 1 : 8); ++i) { const int t = 8 * w + i; const float dd = pm + cs[i];
              const f32x2 ea = __builtin_elementwise_fma((f32x2){dd, dd}, (f32x2){1.44269504089f, -1.44269504089f}, (f32x2){-3.f, 0.f});
              const f32x2 e = {__builtin_amdgcn_exp2f(ea.x), __builtin_amdgcn_exp2f(ea.y)};
              const f32x2 qk = {bf2f(cq[i]), bf2f(ck[i])};
              const f32x2 o2 = qk * (e * emt); kkf[i] = o2.y;
              if (!isctx) { const f32x2 o1 = qk * e; const unsigned w1 = pkbf(o1.x, o1.y), w2 = pkbf(o2.x, 0.f);
                  QP[t * GP + lane] = (bf16_t)(w1 & 0xffffu); KP[t * GP + lane] = (bf16_t)(w1 >> 16); QQ[t * GP + lane] = (bf16_t)(w2 & 0xffffu); } }
          kk4.x = pkbf(kkf[0], kkf[1]); kk4.y = pkbf(kkf[2], kkf[3]); kk4.z = pkbf(kkf[4], kkf[5]); kk4.w = pkbf(kkf[6], kkf[7]);
          *(LAS u32x4*)(KKT + lane * GP + 8 * w) = kk4;
          const unsigned vw[8] = {cv0.x, cv0.y, cv0.z, cv0.w, cv1.x, cv1.y, cv1.z, cv1.w};
#pragma unroll
          for (int e = 0; e < ((GM == 4) ? 1 : 8); ++e) { VT[(vc * 16 + 2 * e) * GP + vs] = (bf16_t)(vw[e] & 0xffffu); VT[(vc * 16 + 2 * e + 1) * GP + vs] = (bf16_t)(vw[e] >> 16); } }
        if (step + 1 < 36) GLA_LOAD(step + 1);
        __syncthreads();
        if (!isctx && GM != 1) {
            f32x16 O;
#pragma unroll
            for (int i = 0; i < 16; ++i) O[i] = 0.f;
#pragma unroll
            for (int s = 0; s < 2; ++s) { O = MFMA32(ld_perm8(QQ + (32 * tb + c) * GP + 16 * s + 4 * hh), pack8(S0, s), O);
                                          O = MFMA32(ld_perm8(QQ + (32 * tb + c) * GP + 32 + 16 * s + 4 * hh), pack8(S1, s), O); }
#pragma unroll
            for (int sb = 0; sb < 2; ++sb) { if (sb > tb) continue;
                f32x16 X;
#pragma unroll
                for (int i = 0; i < 16; ++i) X[i] = 0.f;
#pragma unroll
                for (int s = 0; s < 4; ++s) X = MFMA32(ld_nat8(KP + (32 * sb + c) * GP + 16 * s + 8 * hh), ld_nat8(QP + (32 * tb + c) * GP + 16 * s + 8 * hh), X);
                if (sb == tb) {
#pragma unroll
                    for (int r = 0; r < 16; ++r) { const int sl = (r & 3) + 8 * (r >> 2) + 4 * hh; X[r] = (sl <= c) ? X[r] : 0.f; } }
#pragma unroll
                for (int s = 0; s < 2; ++s) O = MFMA32(pack8(X, s), ld_perm8(VT + (32 * vb + c) * GP + 32 * sb + 16 * s + 4 * hh), O);
            }
#pragma unroll
            for (int r = 0; r < ((GM == 2) ? 1 : 16); ++r) { const int t = 32 * tb + (r & 3) + 8 * (r >> 2) + 4 * hh; const size_t row = (size_t)(row0 + (dir ? 63 - t : t));
                OD[row * 512 + h * 128 + 32 * vb + c] = (bf16_t)(pkbf(O[r], 0.f) & 0xffffu); }
        }
        if (GM != 1) {
#pragma unroll
            for (int g4 = 0; g4 < 4; ++g4) { const f32x4 d0 = *(const LAS f32x4*)(DEC + 8 * g4 + 4 * hh), d1 = *(const LAS f32x4*)(DEC + 32 + 8 * g4 + 4 * hh);
#pragma unroll
                for (int z = 0; z < 4; ++z) { S0[4 * g4 + z] *= d0[z]; S1[4 * g4 + z] *= d1[z]; } }
#pragma unroll
            for (int s = 0; s < 4; ++s) { const bf16x8 vf = ld_nat8(VT + (32 * vb + c) * GP + 16 * s + 8 * hh);
                S0 = MFMA32(ld_nat8(KKT + c * GP + 16 * s + 8 * hh), vf, S0);
                S1 = MFMA32(ld_nat8(KKT + (32 + c) * GP + 16 * s + 8 * hh), vf, S1); }
        }
    }
#undef GLA_LOAD
    __syncthreads();
}

constexpr int PRS = 72 * 2;
__device__ __forceinline__ int pslot(int x) { return 2 * (x + (x >> 3)); }
template <int G_>
__device__ __forceinline__ void pool_unit_g(Frame& F, const int cblk, const int b) {
    constexpr int g = G_, wdw = 2 << g, lo = wdw >> 1, hi = wdw - 1 - lo;
    LAS f32x4* X = (LAS f32x4*)F.lds;
    LAS f32x4* H = (LAS f32x4*)(F.lds + 73728);
    const bf16_t* PB = (const bf16_t*)(F.ws + WS_PB) + ((size_t)((b * 4 + g) * 16 + cblk) * 2048) * 8;
    bf16_t* MIX = (bf16_t*)(F.ws + WS_MIX);
    int tid = F.tid; asm volatile("" : "+v"(tid));
#pragma unroll
    for (int i = 0; i < 4; ++i) { const int tok = tid + 512 * i, r = tok >> 6, x = tok & 63; const u32x4 v = *(const u32x4*)(PB + (size_t)tok * 8);
        LAS f32x4* p = X + r * PRS + pslot(x);
        p[0] = (f32x4){bflo(v.x), bfhi(v.x), bflo(v.y), bfhi(v.y)}; p[1] = (f32x4){bflo(v.z), bfhi(v.z), bflo(v.w), bfhi(v.w)}; }
    __syncthreads();
    { const int q = tid & 1, cs = (tid >> 1) & 7, r = tid >> 4; const LAS f32x4* xr = X + r * PRS + q; LAS f32x4* hr = H + r * PRS + q;
      const int c0 = 8 * cs; f32x4 s = {0.f, 0.f, 0.f, 0.f};
#pragma unroll
      for (int d = -lo; d <= hi; ++d) { const int x = c0 + d; const bool ok = (x >= 0) && (x < GW); const int xc = x < 0 ? 0 : (x > GW - 1 ? GW - 1 : x); const f32x4 v = xr[pslot(xc)]; s += ok ? v : (f32x4){0.f, 0.f, 0.f, 0.f}; if (((d + lo) & 3) == 3) asm volatile("" ::: "memory"); }
      hr[pslot(c0)] = s;
#pragma unroll
      for (int j = 1; j < 8; ++j) { const int xin = c0 + j + hi, xout = c0 + j - 1 - lo; const bool oki = xin < GW, oko = xout >= 0;
          const f32x4 vi = xr[pslot(oki ? xin : GW - 1)], vo = xr[pslot(oko ? xout : 0)];
          s += oki ? vi : (f32x4){0.f, 0.f, 0.f, 0.f}; s -= oko ? vo : (f32x4){0.f, 0.f, 0.f, 0.f}; hr[pslot(c0 + j)] = s; } }
    __syncthreads();
    { const int q = tid & 1, cc = (tid >> 1) & 63, rs = tid >> 7; const int col = pslot(cc) + q; const int r0s = 8 * rs;
      const int c0 = max(cc - lo, 0), c1 = min(cc + hi + 1, GW); const float ncol = (float)(c1 - c0);
      f32x4 s = {0.f, 0.f, 0.f, 0.f};
#pragma unroll
      for (int d = -lo; d <= hi; ++d) { const int y = r0s + d; const bool ok = (y >= 0) && (y < GROWS); const int yc = y < 0 ? 0 : (y > GROWS - 1 ? GROWS - 1 : y); const f32x4 v = H[yc * PRS + col]; s += ok ? v : (f32x4){0.f, 0.f, 0.f, 0.f}; if (((d + lo) & 3) == 3) asm volatile("" ::: "memory"); }
#pragma unroll
      for (int j = 0; j < 8; ++j) { const int r = r0s + j;
          if (j > 0) { const int yin = r + hi, yout = r - 1 - lo; const bool oki = yin < GROWS, oko = yout >= 0;
              const f32x4 vi = H[(oki ? yin : GROWS - 1) * PRS + col], vo = H[(oko ? yout : 0) * PRS + col];
              s += oki ? vi : (f32x4){0.f, 0.f, 0.f, 0.f}; s -= oko ? vo : (f32x4){0.f, 0.f, 0.f, 0.f}; }
          const int ra = max(r - lo, 0), rb = min(r + hi + 1, GROWS);
          const float inv = 1.f / ((float)(rb - ra) * ncol);
          const f32x4 o = s * inv - X[r * PRS + col];
          u32x2 pw; pw.x = pkbf(o[0], o[1]); pw.y = pkbf(o[2], o[3]);
          *(u32x2*)(MIX + (size_t)(b * SEQ + r * GW + cc) * D + 512 + g * 128 + cblk * 8 + q * 4) = pw; } }
    __syncthreads();
}
__device__ __forceinline__ void pool_unit(Frame& F, const int unit) {
    const int g = unit & 3, cblk = (unit >> 2) & 15, b = unit >> 6;
    if (g == 0) pool_unit_g<0>(F, cblk, b); else if (g == 1) pool_unit_g<1>(F, cblk, b); else if (g == 2) pool_unit_g<2>(F, cblk, b); else pool_unit_g<3>(F, cblk, b);
}

__device__ __forceinline__ void p4_gla_out(Frame& F) {
    const bf16_t* OFp = (const bf16_t*)(F.ws + WS_OF); const bf16_t* OBp = (const bf16_t*)(F.ws + WS_OB); const bf16_t* GB = (const bf16_t*)(F.ws + WS_GB);
    bf16_t* MIX = (bf16_t*)(F.ws + WS_MIX); const float* wn = F.in[IN_GLANW];
    const int lane = F.lane, gw = F.vcu * NWAVES + F.wave, NGW = F.G * NWAVES;
    const f32x4 w0 = *(const f32x4*)(wn + (lane & 15) * 8), w1 = *(const f32x4*)(wn + (lane & 15) * 8 + 4);
    for (int tok = gw; tok < NTOK; tok += NGW) {
        const u32x4 fa = *((const u32x4*)(OFp + (size_t)tok * 512) + lane), fb = *((const u32x4*)(OBp + (size_t)tok * 512) + lane);
        const f32x4 o0 = (f32x4){bflo(fa.x) + bflo(fb.x), bfhi(fa.x) + bfhi(fb.x), bflo(fa.y) + bflo(fb.y), bfhi(fa.y) + bfhi(fb.y)};
        const f32x4 o1 = (f32x4){bflo(fa.z) + bflo(fb.z), bfhi(fa.z) + bfhi(fb.z), bflo(fa.w) + bflo(fb.w), bfhi(fa.w) + bfhi(fb.w)};
        const u32x4 gv = *((const u32x4*)(GB + (size_t)tok * 512) + lane);
        float ss = (o0[0] * o0[0] + o0[1] * o0[1]) + (o0[2] * o0[2] + o0[3] * o0[3]) + (o1[0] * o1[0] + o1[1] * o1[1]) + (o1[2] * o1[2] + o1[3] * o1[3]);
        ss += __shfl_xor(ss, 1); ss += __shfl_xor(ss, 2); ss += __shfl_xor(ss, 4); ss += __shfl_xor(ss, 8);
        const float rstd = rsqrtf(ss * (1.f / 128.f) + EPS);
        const float gg[8] = {bflo(gv.x), bfhi(gv.x), bflo(gv.y), bfhi(gv.y), bflo(gv.z), bfhi(gv.z), bflo(gv.w), bfhi(gv.w)};
        float y[8];
#pragma unroll
        for (int j = 0; j < 4; ++j) { y[j] = o0[j] * rstd * w0[j] * silu_f(gg[j]); y[4 + j] = o1[j] * rstd * w1[j] * silu_f(gg[4 + j]); }
        u32x4 pw; pw.x = pkbf(y[0], y[1]); pw.y = pkbf(y[2], y[3]); pw.z = pkbf(y[4], y[5]); pw.w = pkbf(y[6], y[7]);
        *((u32x4*)(MIX + (size_t)tok * D) + lane) = pw;
    }
}

constexpr int P6_AP = 1032;
constexpr int L6_AH = 0, L6_AL = 32 * P6_AP * 2, L6_LG = 2 * L6_AL;
constexpr int L6_REC = L6_LG + 128 * 33 * 4;
constexpr int L6_RED = 0;
static_assert(L6_REC + 4096 <= LDSCTL_OFF && 8 * 32 * 33 * 4 <= L6_LG, "P6 LDS map");
__device__ __forceinline__ void p6_router(Frame& F) {
    LAS bf16_t* AH = (LAS bf16_t*)(F.lds + L6_AH); LAS bf16_t* AL = (LAS bf16_t*)(F.lds + L6_AL); LAS float* LG = (LAS float*)(F.lds + L6_LG); LAS float* RED = (LAS float*)(F.lds + L6_RED);
    LAS unsigned* REC = (LAS unsigned*)(F.lds + L6_REC); LAS float* RECW = (LAS float*)(F.lds + L6_REC + 2048);
    LAS int* LCNT = (LAS int*)(F.lds + LDSCTL_OFF) + LC_CNT; LAS int* GBASE = LCNT + 32;
    const float* b_router = F.in[IN_BROUTER]; const float* wn = F.in[IN_NMLP];
    const float* mod = (const float*)(F.ws + WS_MOD); const bf16_t* h1 = (const bf16_t*)(F.ws + WS_H1B);
    unsigned char* HN2 = (unsigned char*)(F.ws + WS_HN2);
    int* gcnt = (int*)(F.ws + WS_CTL) + CW_CNT; int* list = (int*)(F.ws + WS_LIST); unsigned* ASG = (unsigned*)(F.ws + WS_ASG); float* TOPW = (float*)(F.ws + WS_TOPW);
    const int lane = F.lane, w = F.wave, tid = F.tid, c = lane & 31, hh = lane >> 5;
    bf16x8 bh[8], bl[8];
    { const bf16_t* WRT = (const bf16_t*)(F.ws + WS_WRT);
#pragma unroll
      for (int s = 0; s < 8; ++s) { bh[s] = *(const bf16x8*)(WRT + c * D + 128 * w + 16 * s + 8 * hh); bl[s] = *(const bf16x8*)(WRT + NE * D + c * D + 128 * w + 16 * s + 8 * hh); } }
    const f32x4 wn4[4] = {((const f32x4*)wn)[lane], ((const f32x4*)wn)[lane + 64], ((const f32x4*)wn)[lane + 128], ((const f32x4*)wn)[lane + 192]};
    for (int tblk = F.vcu; tblk < NTOK / 128; tblk += F.G) {
        if (tid < 32) LCNT[tid] = 0;
        const float* mrow = mod + (size_t)((tblk * 128) >> 11) * NMOD;
        f32x4 sc4[4], sh4[4];
#pragma unroll
        for (int j = 0; j < 4; ++j) { sc4[j] = ((const f32x4*)(mrow + 4096))[lane + 64 * j] + 1.f; sh4[j] = ((const f32x4*)(mrow + 3072))[lane + 64 * j]; }
        u32x2 hn[4];
        { const u32x2* xr = (const u32x2*)(h1 + (size_t)(tblk * 128 + 4 * w) * D) + lane;
#pragma unroll
          for (int j = 0; j < 4; ++j) hn[j] = xr[64 * j]; }
        for (int tile = 0; tile < 4; ++tile) {
#pragma unroll 1
            for (int q = 0; q < 4; ++q) { const int tl = 4 * w + q, tok = tblk * 128 + tile * 32 + tl;
                f32x4 hv[4]; float s = 0.f;
#pragma unroll
                for (int j = 0; j < 4; ++j) { hv[j] = (f32x4){bflo(hn[j].x), bfhi(hn[j].x), bflo(hn[j].y), bfhi(hn[j].y)}; s += (hv[j].x * hv[j].x + hv[j].y * hv[j].y) + (hv[j].z * hv[j].z + hv[j].w * hv[j].w); }
                { const int nq = tile * 4 + q + 1; if (nq < 16) { const int ntok = tblk * 128 + (nq >> 2) * 32 + 4 * w + (nq & 3); const u32x2* xr = (const u32x2*)(h1 + (size_t)ntok * D) + lane;
#pragma unroll
                    for (int j = 0; j < 4; ++j) hn[j] = xr[64 * j]; } }
                const float rstd = rsqrtf(wave_sum(s) * (1.f / D) + EPS);
                unsigned* o4 = (unsigned*)(HN2 + (size_t)tok * D) + lane;
#pragma unroll
                for (int j = 0; j < 4; ++j) { const f32x4 y = hv[j] * rstd * wn4[j] * sc4[j] + sh4[j];
                    o4[64 * j] = pg8::pk4_fp8(y.x, y.y, y.z, y.w);
                    u32x2 hi2; hi2.x = pkbf(y.x, y.y); hi2.y = pkbf(y.z, y.w);
                    u32x2 lo2; lo2.x = pkbf(y.x - bflo(hi2.x), y.y - bfhi(hi2.x)); lo2.y = pkbf(y.z - bflo(hi2.y), y.w - bfhi(hi2.y));
                    *(LAS u32x2*)(AH + tl * P6_AP + 4 * lane + 256 * j) = hi2; *(LAS u32x2*)(AL + tl * P6_AP + 4 * lane + 256 * j) = lo2; } }
            __syncthreads();
            f32x16 Dp;
#pragma unroll
            for (int i = 0; i < 16; ++i) Dp[i] = 0.f;
#pragma unroll
            for (int s = 0; s < 8; ++s) { const bf16x8 ah = *(const LAS bf16x8*)(AH + c * P6_AP + 128 * w + 16 * s + 8 * hh), al = *(const LAS bf16x8*)(AL + c * P6_AP + 128 * w + 16 * s + 8 * hh);
                Dp = MFMA32(ah, bh[s], Dp); Dp = MFMA32(ah, bl[s], Dp); Dp = MFMA32(al, bh[s], Dp); }
            __syncthreads();
#pragma unroll
            for (int r = 0; r < 16; ++r) RED[w * (32 * 33) + ((r & 3) + 8 * (r >> 2) + 4 * hh) * 33 + c] = Dp[r];
            __syncthreads();
            { const int tl = tid >> 4, e0 = tid & 15; float a0 = 0.f, a1 = 0.f;
#pragma unroll
              for (int ww = 0; ww < 8; ++ww) { a0 += RED[ww * (32 * 33) + tl * 33 + e0]; a1 += RED[ww * (32 * 33) + tl * 33 + e0 + 16]; }
              LG[(tile * 32 + tl) * 33 + e0] = a0 + b_router[e0]; LG[(tile * 32 + tl) * 33 + e0 + 16] = a1 + b_router[e0 + 16]; }
            __syncthreads();
        }
        if (tid < 128) { float lgv[32];
#pragma unroll
            for (int e = 0; e < 32; ++e) lgv[e] = LG[tid * 33 + e];
            int se[4]; float sv[4];
#pragma unroll
            for (int r = 0; r < 4; ++r) { float bv = -3.0e38f; int bi = 0;
#pragma unroll
                for (int e = 0; e < 32; ++e) { bool ok = lgv[e] > bv;
#pragma unroll
                    for (int q = 0; q < r; ++q) ok = ok && (se[q] != e);
                    bv = ok ? lgv[e] : bv; bi = ok ? e : bi; }
                se[r] = bi; sv[r] = bv; }
            float ex[4], den = 0.f;
#pragma unroll
            for (int r = 0; r < 4; ++r) { ex[r] = __expf(sv[r] - sv[0]); den += ex[r]; }
            const float inv = 1.f / den;
#pragma unroll
            for (int r = 0; r < 4; ++r) { const int lp = __hip_atomic_fetch_add(&LCNT[se[r]], 1, __ATOMIC_RELAXED, __HIP_MEMORY_SCOPE_WORKGROUP);
                REC[tid * 4 + r] = ((unsigned)se[r] << 16) | (unsigned)lp; RECW[tid * 4 + r] = ex[r] * inv; } }
        __syncthreads();
        { int t2 = tid; asm volatile("" : "+v"(t2)); if (t2 < 32) GBASE[t2] = atomicAdd(&gcnt[64 * t2], LCNT[t2]); }
        __syncthreads();
        { const unsigned rec = REC[tid]; const int e = rec >> 16, pos = GBASE[e] + (int)(rec & 0xffffu), aid = tblk * 512 + tid;
          list[e * NTOK + pos] = aid; ASG[aid] = ((unsigned)e << 16) | (unsigned)pos; TOPW[aid] = RECW[tid]; }
        __syncthreads();
    }
}
__device__ __forceinline__ void moe_tables(Frame& F) {
    LAS int* TST = (LAS int*)(F.lds + LDSCTL_OFF) + LC_TST; LAS int* LCNT = (LAS int*)(F.lds + LDSCTL_OFF) + LC_CNT;
    const int* gcnt = (const int*)(F.ws + WS_CTL) + CW_CNT;
    if (F.tid < 64) {
        const int lane = F.lane; const int c = lane < NE ? gcnt[64 * lane] : 0; const int mt = (c + 255) >> 8; int inc = mt;
#pragma unroll
        for (int o = 1; o < 32; o <<= 1) { const int up = __shfl_up(inc, o); if (lane >= o) inc += up; }
        if (lane < NE) { LCNT[lane] = c; TST[lane] = inc - mt; }
        if (lane == NE - 1) TST[NE] = inc;
    }
    __syncthreads();
}
__device__ __forceinline__ f32x4 fp8x4_to_f32(unsigned w) { const f32x2 lo = __builtin_amdgcn_cvt_pk_f32_fp8((int)w, false), hi = __builtin_amdgcn_cvt_pk_f32_fp8((int)w, true); return (f32x4){lo.x, lo.y, hi.x, hi.y}; }
__device__ __forceinline__ void p9_final(Frame& F) {
    const LAS int* TST = (const LAS int*)(F.lds + LDSCTL_OFF) + LC_TST;
    const unsigned* ASG = (const unsigned*)(F.ws + WS_ASG); const float* TOPW = (const float*)(F.ws + WS_TOPW); const unsigned char* Y = (const unsigned char*)(F.ws + WS_Y);
    const float* mod = (const float*)(F.ws + WS_MOD); const float* fw = F.in[IN_FNW]; float* out = F.out; const bf16_t* H1B = (const bf16_t*)(F.ws + WS_H1B);
    const int lane = F.lane, gw = F.vcu * NWAVES + F.wave, NGW = F.G * NWAVES;
    f32x4 fwv[4];
#pragma unroll
    for (int j = 0; j < 4; ++j) fwv[j] = ((const f32x4*)fw)[lane + 64 * j];
    for (int tok0 = gw; tok0 < NTOK; tok0 += 2 * NGW) {
        int tk[2]; tk[0] = tok0; tk[1] = (tok0 + NGW < NTOK) ? tok0 + NGW : tok0;
        unsigned yv[2][4][4]; float wg[2][4]; u32x2 xv[2][4]; f32x4 gv[2][4];
#pragma unroll
        for (int u = 0; u < 2; ++u) { const u32x4 a4 = *(const u32x4*)(ASG + (size_t)tk[u] * 4); const f32x4 w4 = *(const f32x4*)(TOPW + (size_t)tk[u] * 4);
            const unsigned aa[4] = {a4.x, a4.y, a4.z, a4.w};
#pragma unroll
            for (int r = 0; r < 4; ++r) { const unsigned a = (unsigned)__builtin_amdgcn_readfirstlane((int)aa[r]); wg[u][r] = w4[r];
                const size_t row = (size_t)TST[a >> 16] * 256 + (a & 0xffffu); const unsigned* yp = (const unsigned*)(Y + row * D) + lane;
#pragma unroll
                for (int j = 0; j < 4; ++j) yv[u][r][j] = yp[64 * j]; }
            const u32x2* xr = (const u32x2*)(H1B + (size_t)tk[u] * D) + lane; const f32x4* g2 = (const f32x4*)(mod + (size_t)(tk[u] >> 11) * NMOD + 5120) + lane;
#pragma unroll
            for (int j = 0; j < 4; ++j) { xv[u][j] = xr[64 * j]; gv[u][j] = g2[64 * j]; } }
#pragma unroll
        for (int u = 0; u < 2; ++u) { f32x4 v[4]; float s = 0.f;
#pragma unroll
            for (int j = 0; j < 4; ++j) { f32x4 acc = fp8x4_to_f32(yv[u][0][j]) * wg[u][0];
#pragma unroll
                for (int r = 1; r < 4; ++r) acc += fp8x4_to_f32(yv[u][r][j]) * wg[u][r];
                v[j] = (f32x4){bflo(xv[u][j].x), bfhi(xv[u][j].x), bflo(xv[u][j].y), bfhi(xv[u][j].y)} + gv[u][j] * acc; s += (v[j].x * v[j].x + v[j].y * v[j].y) + (v[j].z * v[j].z + v[j].w * v[j].w); }
            const float rstd = rsqrtf(wave_sum(s) * (1.f / D) + EPS);
            if (u == 0 || tk[1] != tk[0]) { f32x4* xo = (f32x4*)(out + (size_t)tk[u] * D) + lane;
#pragma unroll
                for (int j = 0; j < 4; ++j) xo[64 * j] = v[j] * rstd * fwv[j]; } }
    }
}

#ifndef MK_N_LAUNCHES
#define MK_N_LAUNCHES 1
#endif
constexpr int N_PHASES = 10;
#ifndef PROBE_TWICE
#define PROBE_TWICE -1
#endif
__global__ void __launch_bounds__(NTHR, 2) mk_fwd(Args args) {
    extern __shared__ __attribute__((aligned(16))) unsigned char lds_raw[];
    Frame F;
    F.lds = (LAS unsigned char*)lds_raw;
    F.tid = threadIdx.x; F.lane = F.tid & 63; F.wave = __builtin_amdgcn_readfirstlane(F.tid >> 6);
    F.G = gridDim.x; { const int bx = blockIdx.x; F.vcu = (F.G % 8 == 0) ? (bx % 8) * (F.G / 8) + bx / 8 : bx; }
    F.in = args.in; F.out = args.out; F.ws = args.ws;
    for (int u = F.tid; u < (LDS_BYTES - LDSCTL_OFF) / 4; u += NTHR) ((LAS unsigned*)(F.lds + LDSCTL_OFF))[u] = 0u;
    __syncthreads();
    const int lo = args.ph_lo, hi = args.ph_hi;
    XcdBarrier bar; bar.bar = (unsigned*)(F.ws + WS_CTL) + CW_BAR; bar.x = 0; bar.st = nullptr;
    if (hi - lo > 1) bar = xcd_barrier_post((unsigned*)(F.ws + WS_CTL) + CW_BAR, (volatile LAS unsigned*)(F.lds + LDSCTL_OFF) + LC_BAR);
#define IN(k) (lo <= (k) && (k) < hi)
#define SEAM(k) do { if (IN(k) && IN((k) + 1)) xcd_barrier(bar); } while (0)
    if (IN(0)) { p0_prologue(F, false); } SEAM(0);
    if (IN(1)) { p1_norm1(F); } SEAM(1);
    if (IN(2)) for (int rep_ = 0; rep_ < (PROBE_TWICE == 2 ? 2 : 1); ++rep_) { if (rep_) xcd_barrier(bar);
        pg8::SchedInProj S{F.G, (int)blockIdx.x};
        pg8::EpiInProj E{(bf16_t*)(F.ws + WS_KB), (bf16_t*)(F.ws + WS_VB), (bf16_t*)(F.ws + WS_QB), (bf16_t*)(F.ws + WS_GB), (bf16_t*)(F.ws + WS_PB), (float*)(F.ws + WS_RB)};
        pg8::gemm_phase<pg8::EpiInProj, pg8::SchedInProj, true, false>(F.lds, (const char*)(F.ws + WS_HN1), (const char*)(F.ws + WS_WIN), D * 2, S, E);
    } SEAM(2);
    if (IN(3)) {
        const int bx = blockIdx.x, nG = (F.G + 1) >> 1, nP = F.G - nG;
        constexpr int CVT_N = 2048 + 1024, CVT_ODD = 2432, CVT_ODD2 = CVT_ODD + 256;
        if ((bx & 1) == 0) { for (int u = bx >> 1; u < NB * 8; u += nG) gla_unit<0>(F, u);
#if PROBE_TWICE >= 380 && PROBE_TWICE < 390
                             for (int u = bx >> 1; u < NB * 8; u += nG) gla_unit<PROBE_TWICE - 380>(F, u);
#endif
                             cvt_expert_items_dma(F, CVT_ODD2 + (bx >> 1), nG, CVT_N); }
        else { for (int u = bx >> 1; u < NB * 64; u += nP) pool_unit(F, u);
#if PROBE_TWICE == 37
               for (int u = bx >> 1; u < NB * 64; u += nP) pool_unit(F, u);
#endif
               cvt_expert_items_dma(F, bx >> 1, nP, CVT_ODD);
               if ((bx >> 1) >= 64) cvt_expert_items_dma(F, CVT_ODD + (bx >> 1) - 64, 64, CVT_ODD2);
#if PROBE_TWICE == 36
               __syncthreads(); cvt_expert_items_dma(F, bx >> 1, nP, CVT_ODD);
#endif
               __syncthreads();
               for (int rep_ = 0; rep_ < (PROBE_TWICE == 35 ? 2 : 1); ++rep_)
               { pg8::SchedInProjG S{nP, bx >> 1};
                 pg8::EpiInProj E{(bf16_t*)(F.ws + WS_KB), (bf16_t*)(F.ws + WS_VB), (bf16_t*)(F.ws + WS_QB), (bf16_t*)(F.ws + WS_GB), (bf16_t*)(F.ws + WS_PB), (float*)(F.ws + WS_RB)};
                 pg8::gemm_phase<pg8::EpiInProj, pg8::SchedInProjG, true, false>(F.lds, (const char*)(F.ws + WS_HN1), (const char*)(F.ws + WS_WIN), D * 2, S, E); } }
    } SEAM(3);
    if (IN(4)) { p4_gla_out(F); } SEAM(4);
    if (IN(5)) {
        pg8::SchedPlain S{F.G, (int)blockIdx.x, NTOK / 256, D / 256};
        pg8::EpiResid E{F.in[IN_X], (const float*)(F.ws + WS_MOD), (bf16_t*)(F.ws + WS_H1B)};
        pg8::gemm_phase<pg8::EpiResid, pg8::SchedPlain, true, false>(F.lds, (const char*)(F.ws + WS_MIX), (const char*)(F.ws + WS_WOUT), D * 2, S, E);
    } SEAM(5);
    if (IN(6)) { p6_router(F); } SEAM(6);
    const LAS int* TST = (const LAS int*)(F.lds + LDSCTL_OFF) + LC_TST; const LAS int* LCN = (const LAS int*)(F.lds + LDSCTL_OFF) + LC_CNT;
    if (IN(7)) {
        moe_tables(F);
        pg8::SchedMoE<8, true> S{F.G, (int)blockIdx.x, TST, LCN, (const int*)(F.ws + WS_LIST)};
        pg8::EpiSwiglu<true> E{(void*)(F.ws + WS_ACT), F.in[IN_BGU], 1.f / WSCALE};
        pg8::gemm_phase<pg8::EpiSwiglu<true>, pg8::SchedMoE<8, true>, true, true>(F.lds, (const char*)(F.ws + WS_HN2), (const char*)(F.ws + WS_WGU), D, S, E);
    } SEAM(7);
    if (IN(8)) {
        moe_tables(F);
        pg8::SchedMoE<4, false> S{F.G, (int)blockIdx.x, TST, LCN, nullptr};
        pg8::EpiDown E{(unsigned char*)(F.ws + WS_Y), F.in[IN_BDOWN], 1.f / WSCALE};
        pg8::gemm_phase<pg8::EpiDown, pg8::SchedMoE<4, false>, true, true>(F.lds, (const char*)(F.ws + WS_ACT), (const char*)(F.ws + WS_WD), DFF, S, E);
    } SEAM(8);
    if (IN(9)) { moe_tables(F); p9_final(F); }
#undef IN
#undef SEAM
}

extern "C" void kernel_launch(void* const* d_in, const int* in_sizes, int n_in, void* d_out, int out_size, void* d_ws, size_t ws_size, hipStream_t stream) {
    static int grid = 0;
    if (grid == 0) {
        if (n_in != 24 || ws_size < WS_END || out_size != NTOK * D) { fprintf(stderr, "kernel_launch: unexpected n_in %d / ws_size %zu / out %d\n", n_in, ws_size, out_size); grid = -1; return; }
        int dev = 0, cus = 0, per_cu = 0;
        if (hipGetDevice(&dev) != hipSuccess || hipDeviceGetAttribute(&cus, hipDeviceAttributeMultiprocessorCount, dev) != hipSuccess) { grid = -1; return; }
        if (hipFuncSetAttribute((const void*)mk_fwd, hipFuncAttributeMaxDynamicSharedMemorySize, LDS_BYTES) != hipSuccess) { fprintf(stderr, "kernel_launch: hipFuncSetAttribute failed\n"); grid = -1; return; }
        if (hipOccupancyMaxActiveBlocksPerMultiprocessor(&per_cu, (const void*)mk_fwd, NTHR, LDS_BYTES) != hipSuccess || per_cu < 1) { fprintf(stderr, "kernel_launch: occupancy query says %d workgroups per CU\n", per_cu); (void)hipGetLastError(); grid = -1; return; }
        (void)hipGetLastError();
        grid = cus;
    }
    if (grid < 0) return;
    (void)hipMemsetAsync((char*)d_ws + WS_CTL, 0, 1 * MiB, stream);
    Args a{};
    for (int i = 0; i < 24; ++i) a.in[i] = (const float*)d_in[i];
    a.out = (float*)d_out; a.ws = (unsigned char*)d_ws;
    if (MK_N_LAUNCHES == 1) {
        a.ph_lo = 0; a.ph_hi = N_PHASES;
        void* kargs[] = {&a};
        const hipError_t e = hipLaunchCooperativeKernel((const void*)mk_fwd, dim3(grid), dim3(NTHR), kargs, LDS_BYTES, stream);
        if (e != hipSuccess) fprintf(stderr, "kernel_launch: cooperative launch failed: %s (grid %d)\n", hipGetErrorString(e), grid);
    } else {
        for (int ph = 0; ph < N_PHASES; ++ph) { a.ph_lo = ph; a.ph_hi = ph + 1; hipLaunchKernelGGL(mk_fwd, dim3(grid), dim3(NTHR), LDS_BYTES, stream, a); }
    }
}
```

```cpp
#include <hip/hip_runtime.h>
#include <stdint.h>
#include <stdio.h>

#define LAS __attribute__((address_space(3)))
#define GAS __attribute__((address_space(1)))
typedef unsigned short bf16_t;
typedef short bf16x8 __attribute__((ext_vector_type(8)));
typedef float f32x4 __attribute__((ext_vector_type(4)));
typedef float f32x2 __attribute__((ext_vector_type(2)));
typedef float f32x16 __attribute__((ext_vector_type(16)));
typedef unsigned u32x4 __attribute__((ext_vector_type(4)));
typedef unsigned u32x2 __attribute__((ext_vector_type(2)));

constexpr int D = 1024, NB = 16, SEQ = 2048, CTX = 256;
constexpr int NTOK = NB * SEQ, NCTX = NB * CTX, NROW = NTOK + NCTX;
constexpr int DIN = 2080, NE = 32, DFF = 1024;
constexpr int GW = 64, GROWS = 32;
constexpr int NMOD = 6144;
constexpr float EPS = 1e-6f;
constexpr int NWAVES = 8, NTHR = 512;
constexpr int WIN_N = 2304;
constexpr int NPADROWS = NTOK * 4 + NE * 256;

__device__ __forceinline__ unsigned f2bf(float f) { unsigned u = __builtin_bit_cast(unsigned, f); return (u + 0x7fffu + ((u >> 16) & 1u)) >> 16; }
__device__ __forceinline__ unsigned pk2(float lo, float hi) { return f2bf(lo) | (f2bf(hi) << 16); }
__device__ __forceinline__ float bf2f(unsigned v) { return __builtin_bit_cast(float, v << 16); }
__device__ __forceinline__ float bflo(unsigned w) { return __builtin_bit_cast(float, w << 16); }
__device__ __forceinline__ float bfhi(unsigned w) { return __builtin_bit_cast(float, w & 0xffff0000u); }
__device__ __forceinline__ unsigned cvt_pk_bf16(float lo, float hi) { unsigned r; asm volatile("v_cvt_pk_bf16_f32 %0, %1, %2" : "=v"(r) : "v"(lo), "v"(hi)); return r; }
__device__ __forceinline__ float wave_sum(float v) {
#pragma unroll
    for (int o = 1; o < 64; o <<= 1) v += __shfl_xor(v, o);
    return v;
}
__device__ __forceinline__ float silu_f(float x) { return x / (1.f + __expf(-x)); }
__device__ __forceinline__ float logsigmoid_f(float x) { return fminf(x, 0.f) - log1pf(expf(-fabsf(x))); }
#define LDS_WAIT() asm volatile("s_waitcnt lgkmcnt(0)" ::: "memory")
#define VM_WAIT() asm volatile("s_waitcnt vmcnt(0)" ::: "memory")

namespace pg8 {
constexpr int BM = 256, BK = 64, HALF = 128, HTB = HALF * BK * 2  , STAGE_BYTES = 8 * HTB, NXCD = 8, WGM = 8;
__host__ __device__ __forceinline__ int lds_byte(int r, int c) { const int st = (r >> 4) * 2 + (c >> 5), rr = r & 15, cc = c & 31, ob = rr * 64 + cc * 2; return st * 1024 + (ob ^ (((ob >> 9) & 1) << 5)); }
__host__ __device__ __forceinline__ void stage_rc(int b, int& R, int& C) { const int st = b / 1024, sb = b % 1024, swz = sb ^ (((sb >> 9) & 1) << 5); R = (st >> 1) * 16 + swz / 64; C = (st & 1) * 32 + (swz % 64) / 2; }
__host__ __device__ __forceinline__ int perm32(int rho) { const int n = rho >> 4, i = rho & 15; return 8 * (i >> 2) + 4 * n + (i & 3); }

struct Unit { int pm, pn, arow, bt, nvalid, e; };

typedef int i32x8 __attribute__((ext_vector_type(8)));
typedef int i32x4v __attribute__((ext_vector_type(4)));
__device__ __forceinline__ i32x8 cat8(const bf16x8 a, const bf16x8 b) { const i32x4v x = __builtin_bit_cast(i32x4v, a), y = __builtin_bit_cast(i32x4v, b); return __builtin_shufflevector(x, y, 0, 1, 2, 3, 4, 5, 6, 7); }
__device__ __forceinline__ bf16x8 lo8(const i32x8 v) { return __builtin_bit_cast(bf16x8, (i32x4v)__builtin_shufflevector(v, v, 0, 1, 2, 3)); }
__device__ __forceinline__ bf16x8 hi8(const i32x8 v) { return __builtin_bit_cast(bf16x8, (i32x4v)__builtin_shufflevector(v, v, 4, 5, 6, 7)); }
template <class Epi, class Sched, bool ALIGN_EPI, bool FP8>
__device__ __forceinline__ void gemm_phase(LAS unsigned char* lds, const char* Abase, const char* Bbase, const int pitch, const Sched& S, const Epi& E) {
    const int tid = threadIdx.x, wid = __builtin_amdgcn_readfirstlane(tid >> 6), lane = tid & 63, wr = wid >> 2, wc = wid & 3, fr = lane & 15, fq = lane >> 4;
    const int nt = pitch / 128;
    unsigned voffB[2];
#pragma unroll
    for (int i = 0; i < 2; ++i) { int R, C; stage_rc(tid * 16 + i * 8192, R, C); const int Rb = (R & ~31) + perm32(R & 31);
        voffB[i] = (unsigned)(Rb * pitch) + (unsigned)C * 2u; }
    const size_t kstep = (size_t)(BK * 2);
    const size_t hstep = (size_t)HALF * pitch;
    const unsigned ldsw = (unsigned)wid * 1024u;
    const int aoff = lds_byte(wr * 64 + fr, fq * 8), boff = lds_byte(wc * 32 + fr, fq * 8);
#define PG8_SA(b, h) (((b) * 2 + (h)) * HTB)
#define PG8_SB(b, h) ((4 + (b) * 2 + (h)) * HTB)
#define PG8_STAGE_B(bufoff, gbase) do { _Pragma("unroll") for (int _i = 0; _i < 2; ++_i) \
        __builtin_amdgcn_global_load_lds((const unsigned*)((const char*)(gbase) + voffB[_i]), (LAS unsigned*)(lds + (bufoff) + ldsw + _i * 8192), 16, 0, 0); } while (0)
#define PG8_STAGE_A(bufoff, ao, kb) do { _Pragma("unroll") for (int _i = 0; _i < 2; ++_i) \
        __builtin_amdgcn_global_load_lds((const unsigned*)(Abase + (size_t)(ao)[_i] + (size_t)(kb)), (LAS unsigned*)(lds + (bufoff) + ldsw + _i * 8192), 16, 0, 0); } while (0)
#define PG8_LDA(dst, b, h) do { _Pragma("unroll") for (int m = 0; m < 4; ++m) dst[m] = cat8(*(const LAS bf16x8*)(lds + PG8_SA(b, h) + aoff + m * 2048), *(const LAS bf16x8*)(lds + PG8_SA(b, h) + aoff + m * 2048 + 1024)); } while (0)
#define PG8_LDB(dst, b, h) do { _Pragma("unroll") for (int n = 0; n < 2; ++n) dst[n] = cat8(*(const LAS bf16x8*)(lds + PG8_SB(b, h) + boff + n * 2048), *(const LAS bf16x8*)(lds + PG8_SB(b, h) + boff + n * 2048 + 1024)); } while (0)
#define PG8_MMA(ai, bj, At, Bt) do { __builtin_amdgcn_s_setprio(1); _Pragma("unroll") for (int m = 0; m < 4; ++m) _Pragma("unroll") for (int n = 0; n < 2; ++n) { \
        if constexpr (FP8) { acc[ai][bj][m][n] = __builtin_amdgcn_mfma_scale_f32_16x16x128_f8f6f4(Bt[n], At[m], acc[ai][bj][m][n], 0, 0, 0, 0x7f7f7f7f, 0, 0x7f7f7f7f); } \
        else { acc[ai][bj][m][n] = __builtin_amdgcn_mfma_f32_16x16x32_bf16(lo8(Bt[n]), lo8(At[m]), acc[ai][bj][m][n], 0, 0, 0); \
               acc[ai][bj][m][n] = __builtin_amdgcn_mfma_f32_16x16x32_bf16(hi8(Bt[n]), hi8(At[m]), acc[ai][bj][m][n], 0, 0, 0); } } \
        __builtin_amdgcn_s_setprio(0); } while (0)
#define PG8_WAIT_V(n) asm volatile("s_waitcnt vmcnt(" #n ")" ::: "memory")
#define PG8_WAIT_L(n) asm volatile("s_waitcnt lgkmcnt(" #n ")" ::: "memory")
#define PG8_BAR __builtin_amdgcn_s_barrier()
#define PG8_SCHED __builtin_amdgcn_sched_barrier(0)
    Unit cur, nxt; int ui = 0;
    if (!S.next(0, cur)) return;
    f32x4 acc[2][2][4][2];
#pragma unroll
    for (int a = 0; a < 2; ++a)
#pragma unroll
        for (int b = 0; b < 2; ++b)
#pragma unroll
            for (int m = 0; m < 4; ++m)
#pragma unroll
                for (int n = 0; n < 2; ++n) acc[a][b][m][n] = (f32x4){0.f, 0.f, 0.f, 0.f};
    i32x8 At[4], B0[2], B1[2];
    unsigned aoc[2][2];
    LAS u32x4* nxslot = (LAS u32x4*)(lds + STAGE_BYTES) + tid;
#pragma unroll
    for (int h = 0; h < 2; ++h)
#pragma unroll
        for (int i = 0; i < 2; ++i) { int R2, C2; stage_rc(tid * 16 + i * 8192, R2, C2); aoc[h][i] = S.arow(cur, h * HALF + R2) * (unsigned)pitch + (unsigned)C2 * 2u; }
    const char* cB = Bbase + (size_t)cur.bt * pitch;
    PG8_STAGE_B(PG8_SB(0, 0), cB); PG8_STAGE_B(PG8_SB(0, 1), cB + hstep); PG8_STAGE_A(PG8_SA(0, 0), aoc[0], 0); PG8_STAGE_A(PG8_SA(0, 1), aoc[1], 0);
    if (wr == 1) PG8_BAR;
    PG8_WAIT_V(2); PG8_BAR;
    PG8_STAGE_B(PG8_SB(1, 0), cB + kstep); PG8_STAGE_A(PG8_SA(1, 0), aoc[0], kstep); PG8_STAGE_B(PG8_SB(1, 1), cB + hstep + kstep);
    PG8_WAIT_V(6); PG8_BAR;
    for (;;) {
        const bool has_next = S.next(ui + 1, nxt);
        int tq = tid; asm volatile("" : "+v"(tq));
        { unsigned nx4[4];
#pragma unroll
          for (int h = 0; h < 2; ++h)
#pragma unroll
              for (int i = 0; i < 2; ++i) { int R2, C2; stage_rc(tq * 16 + i * 8192, R2, C2); nx4[h * 2 + i] = has_next ? S.arow(nxt, h * HALF + R2) * (unsigned)pitch + (unsigned)C2 * 2u : aoc[h][i]; }
          *nxslot = (u32x4){nx4[0], nx4[1], nx4[2], nx4[3]}; }
        const char* nB = has_next ? Bbase + (size_t)nxt.bt * pitch : cB;
#pragma nounroll
        for (int t = 0; t < nt; t += 2) {
            const bool last = (t == nt - 2);
            const size_t k1 = (size_t)(t + 1) * kstep;
            const size_t k2 = last ? (size_t)0 : (size_t)(t + 2) * kstep, k3 = k2 + kstep;
            const char* b2 = last ? nB : cB + (size_t)(t + 2) * kstep; const char* b3 = b2 + kstep;
            PG8_LDB(B0, 0, 0); PG8_LDB(B1, 0, 1); PG8_SCHED; PG8_LDA(At, 0, 0); PG8_STAGE_A(PG8_SA(1, 1), aoc[1], k1);
            if (last) { const u32x4 nx = *nxslot; aoc[0][0] = nx.x; aoc[0][1] = nx.y; aoc[1][0] = nx.z; aoc[1][1] = nx.w; }
            PG8_WAIT_V(8); PG8_WAIT_L(0); PG8_BAR; PG8_MMA(0, 0, At, B0); PG8_MMA(0, 1, At, B1); PG8_BAR; PG8_SCHED;
            PG8_LDA(At, 0, 1); PG8_STAGE_B(PG8_SB(0, 0), b2); PG8_STAGE_B(PG8_SB(0, 1), b2 + hstep); PG8_STAGE_A(PG8_SA(0, 0), aoc[0], k2);
            PG8_WAIT_V(8); PG8_WAIT_L(0); PG8_BAR; PG8_MMA(1, 0, At, B0); PG8_MMA(1, 1, At, B1); PG8_BAR; PG8_SCHED;
            PG8_LDB(B0, 1, 0); PG8_LDB(B1, 1, 1); PG8_SCHED; PG8_LDA(At, 1, 0); PG8_STAGE_A(PG8_SA(0, 1), aoc[1], k2);
            PG8_WAIT_V(8); PG8_WAIT_L(0); PG8_BAR; PG8_MMA(0, 0, At, B0); PG8_MMA(0, 1, At, B1); PG8_BAR; PG8_SCHED;
            PG8_LDA(At, 1, 1); PG8_STAGE_B(PG8_SB(1, 0), b3); PG8_STAGE_B(PG8_SB(1, 1), b3 + hstep); PG8_STAGE_A(PG8_SA(1, 0), aoc[0], k3);
            PG8_WAIT_V(8); PG8_WAIT_L(0); PG8_BAR; PG8_MMA(1, 0, At, B0); PG8_MMA(1, 1, At, B1); PG8_BAR; PG8_SCHED;
        }
        if constexpr (ALIGN_EPI) { if (wr == 0) PG8_BAR; }
        E(acc, cur, wr, wc, fr, fq);
        if (!has_next) break;
#pragma unroll
        for (int a = 0; a < 2; ++a)
#pragma unroll
            for (int b = 0; b < 2; ++b)
#pragma unroll
                for (int m = 0; m < 4; ++m)
#pragma unroll
                    for (int n = 0; n < 2; ++n) acc[a][b][m][n] = (f32x4){0.f, 0.f, 0.f, 0.f};
        cur = nxt; cB = nB; ++ui;
        if constexpr (ALIGN_EPI) { if (wr == 1) PG8_BAR; }
    }
    PG8_WAIT_V(0);
    if constexpr (!ALIGN_EPI) { if (wr == 0) PG8_BAR; }
    PG8_BAR;
#undef PG8_SA
#undef PG8_SB
#undef PG8_STAGE_A
#undef PG8_STAGE_B
#undef PG8_LDA
#undef PG8_LDB
#undef PG8_MMA
#undef PG8_WAIT_V
#undef PG8_WAIT_L
#undef PG8_BAR
#undef PG8_SCHED
}

__device__ __forceinline__ int xcd_remap(int L, int nwg) { const int q = nwg / NXCD, r = nwg % NXCD, xcd = L % NXCD, off = L / NXCD; return (xcd < r ? xcd * (q + 1) : r * (q + 1) + (xcd - r) * q) + off; }

constexpr int NG2 = 64;
struct SchedInProj {
    int G, c;
    __device__ __forceinline__ bool next(int i, Unit& u) const {
        constexpr int NLAT = 128 * 7, NCTX = 16 * 4, NWG = NLAT + NCTX + NG2;
        const int L = i * G + c; if (L >= NWG) return false;
        const int wgid = xcd_remap(L, NWG); int pm, pn;
        if (wgid < NLAT) { const int nig = WGM * 7, gid = wgid / nig, j = (wgid % nig) / WGM; pm = gid * WGM + (wgid % nig) % WGM; pn = j < 5 ? j : j + 2; }
        else if (wgid < NLAT + NCTX) { const int w = wgid - NLAT, nig = WGM * 4, gid = w / nig; pm = 128 + gid * WGM + (w % nig) % WGM; pn = (w % nig) / WGM; }
        else { const int w = wgid - NLAT - NCTX; pm = w >> 1; pn = 5 + (w & 1); }
        u.pm = pm; u.pn = pn; u.arow = pm * BM; u.bt = pn * BM; u.nvalid = BM; u.e = 0; return true;
    }
    __device__ __forceinline__ unsigned arow(const Unit& u, int rloc) const { return (unsigned)(u.arow + rloc); }
};
struct SchedInProjG {
    int nwg, c;
    __device__ __forceinline__ bool next(int i, Unit& u) const {
        const int L = NG2 + i * nwg + c; if (L >= 256) return false;
        u.pm = L >> 1; u.pn = 5 + (L & 1); u.arow = u.pm * BM; u.bt = u.pn * BM; u.nvalid = BM; u.e = 0; return true;
    }
    __device__ __forceinline__ unsigned arow(const Unit& u, int rloc) const { return (unsigned)(u.arow + rloc); }
};
struct SchedPlain {
    int G, c, nM, nN;
    __device__ __forceinline__ bool next(int i, Unit& u) const {
        const int nwg = nM * nN, L = i * G + c; if (L >= nwg) return false;
        const int wgid = xcd_remap(L, nwg), nig = WGM * nN, gid = wgid / nig, fm = gid * WGM, gsz = (nM - fm) < WGM ? (nM - fm) : WGM;
        u.pm = fm + ((wgid % nig) % gsz); u.pn = (wgid % nig) / gsz; u.arow = u.pm * BM; u.bt = u.pn * BM; u.nvalid = BM; u.e = 0; return true;
    }
    __device__ __forceinline__ unsigned arow(const Unit& u, int rloc) const { return (unsigned)(u.arow + rloc); }
};
template <int NT, bool GATHER>
struct SchedMoE {
    int G, c; const LAS int* tst; const LAS int* cnt; const int* list;
    __device__ __forceinline__ bool next(int i, Unit& u) const {
        const int nwg = tst[NE] * NT, L = i * G + c; if (L >= nwg) return false;
        const int wgid = xcd_remap(L, nwg);
        int e = 0;
#pragma unroll
        for (int s = 16; s >= 1; s >>= 1) { if (tst[e + s] * NT <= wgid) e += s; }
        const int t0 = tst[e], mt = tst[e + 1] - t0, w = wgid - t0 * NT, nig = WGM * NT, gid = w / nig, fm = gid * WGM, gsz = (mt - fm) < WGM ? (mt - fm) : WGM;
        const int m = fm + ((w % nig) % gsz), n = (w % nig) / gsz;
        u.pm = t0 + m; u.pn = n; u.e = e; u.bt = (e * NT + n) * BM;
        if (GATHER) { u.arow = e * NTOK + m * BM; const int left = cnt[e] - m * BM; u.nvalid = left < BM ? left : BM; }
        else { u.arow = u.pm * BM; u.nvalid = BM; }
        return true;
    }
    __device__ __forceinline__ unsigned arow(const Unit& u, int rloc) const {
        if (GATHER) { const int tok = (rloc < u.nvalid) ? (list[u.arow + rloc] >> 2) : 0; return (unsigned)tok; }
        return (unsigned)(u.arow + rloc);
    }
};

struct EpiInProj {
    bf16_t *KB, *VB, *QB, *GB, *PB; float* RB;
    __device__ __forceinline__ void operator()(const f32x4 (&acc)[2][2][4][2], const Unit& u, int wr, int wc, int fr, int fq) const {
        const int pn = u.pn, row0 = u.pm * BM + wr * 64 + fr;
        if (pn == 3) {
            if (wc != 0) return;
#pragma unroll
            for (int ai = 0; ai < 2; ++ai)
#pragma unroll
                for (int m = 0; m < 4; ++m) { float* rp = RB + (size_t)(row0 + ai * HALF + m * 16) * 32 + 8 * fq;
                    *(f32x4*)rp = acc[ai][0][m][0]; *(f32x4*)(rp + 4) = acc[ai][0][m][1]; }
            return;
        }
        if (pn >= 7) {
#pragma unroll
            for (int ai = 0; ai < 2; ++ai)
#pragma unroll
                for (int m = 0; m < 4; ++m) { const int row = row0 + ai * HALF + m * 16, b = row >> 11, t = row & 2047;
#pragma unroll
                    for (int bj = 0; bj < 2; ++bj) { const int g = (pn - 7) * 2 + bj, cblk = wc * 4 + fq;
                        const f32x4 v0 = acc[ai][bj][m][0], v1 = acc[ai][bj][m][1]; u32x4 w; w.x = cvt_pk_bf16(v0[0], v0[1]); w.y = cvt_pk_bf16(v0[2], v0[3]); w.z = cvt_pk_bf16(v1[0], v1[1]); w.w = cvt_pk_bf16(v1[2], v1[3]);
                        *(u32x4*)(PB + ((((size_t)(b * 4 + g) * 16 + cblk) * 2048 + t) * 8)) = w; } }
            return;
        }
        bf16_t* base; int ldc, coff;
        if (pn == 0) { base = KB; ldc = 256; coff = 0; } else if (pn <= 2) { base = VB; ldc = 512; coff = (pn - 1) * 256; }
        else if (pn == 4) { base = QB; ldc = 256; coff = 0; } else { base = GB; ldc = 512; coff = (pn - 5) * 256; }
        const int col0 = coff + wc * 32 + 8 * fq;
#pragma unroll
        for (int ai = 0; ai < 2; ++ai)
#pragma unroll
            for (int m = 0; m < 4; ++m) { bf16_t* rowp = base + (size_t)(row0 + ai * HALF + m * 16) * ldc + col0;
#pragma unroll
                for (int bj = 0; bj < 2; ++bj) { const f32x4 v0 = acc[ai][bj][m][0], v1 = acc[ai][bj][m][1];
                    u32x4 w; w.x = cvt_pk_bf16(v0[0], v0[1]); w.y = cvt_pk_bf16(v0[2], v0[3]); w.z = cvt_pk_bf16(v1[0], v1[1]); w.w = cvt_pk_bf16(v1[2], v1[3]);
                    *(u32x4*)(rowp + bj * HALF) = w; } }
    }
};
typedef __bf16 bf16x2v __attribute__((ext_vector_type(2)));
__device__ __forceinline__ unsigned pk2n(float lo, float hi) { f32x2 v = {lo, hi}; return __builtin_bit_cast(unsigned, __builtin_convertvector(v, bf16x2v)); }
struct EpiResid {
    const float* x; const float* mod; bf16_t* out;
    __device__ __forceinline__ void operator()(const f32x4 (&acc)[2][2][4][2], const Unit& u, int wr, int wc, int fr, int fq) const {
        const int row0 = u.pm * BM + wr * 64 + fr, col0 = u.pn * BM + wc * 32 + 8 * fq;
        const float* g1 = mod + (size_t)(row0 >> 11) * NMOD + 2048 + col0;
        f32x4 gv[2][2];
#pragma unroll
        for (int bj = 0; bj < 2; ++bj)
#pragma unroll
            for (int n = 0; n < 2; ++n) gv[bj][n] = *(const f32x4*)(g1 + bj * HALF + 4 * n);
        f32x4 xa[2][2], xb[2][2];
#define RES_LOAD(dst, g_) do { const size_t _o = (size_t)(row0 + ((g_) >> 2) * HALF + ((g_) & 3) * 16) * D + col0; \
            _Pragma("unroll") for (int bj = 0; bj < 2; ++bj) _Pragma("unroll") for (int n = 0; n < 2; ++n) dst[bj][n] = *(const f32x4*)(x + _o + bj * HALF + 4 * n); } while (0)
#define RES_STORE(src, g_) do { const size_t _o = (size_t)(row0 + ((g_) >> 2) * HALF + ((g_) & 3) * 16) * D + col0; \
            _Pragma("unroll") for (int bj = 0; bj < 2; ++bj) { const f32x4 _a = src[bj][0] + gv[bj][0] * acc[(g_) >> 2][bj][(g_) & 3][0], _b = src[bj][1] + gv[bj][1] * acc[(g_) >> 2][bj][(g_) & 3][1]; \
                u32x4 _w; _w.x = pk2n(_a.x, _a.y); _w.y = pk2n(_a.z, _a.w); _w.z = pk2n(_b.x, _b.y); _w.w = pk2n(_b.z, _b.w); *(u32x4*)(out + _o + bj * HALF) = _w; } } while (0)
        RES_LOAD(xa, 0);
#pragma unroll
        for (int g2 = 0; g2 < 8; g2 += 2) { RES_LOAD(xb, g2 + 1); RES_STORE(xa, g2); if (g2 + 2 < 8) RES_LOAD(xa, g2 + 2); RES_STORE(xb, g2 + 1); }
#undef RES_LOAD
#undef RES_STORE
    }
};
__device__ __forceinline__ unsigned pk4_fp8(float a, float b, float c, float d) { int w = 0; w = __builtin_amdgcn_cvt_pk_fp8_f32(a, b, w, false); w = __builtin_amdgcn_cvt_pk_fp8_f32(c, d, w, true); return (unsigned)w; }
template <bool FP8>
struct EpiSwiglu {
    void* act; const float* bgu; float ascale;
    __device__ __forceinline__ void operator()(const f32x4 (&acc)[2][2][4][2], const Unit& u, int wr, int wc, int fr, int fq) const {
        const int row0 = u.pm * BM + wr * 64 + fr, cc = u.pn * HALF + wc * 32 + 8 * fq;
        const float* bg = bgu + (size_t)u.e * 2048 + cc;
        f32x4 bgv[2], buv[2];
#pragma unroll
        for (int n = 0; n < 2; ++n) { bgv[n] = *(const f32x4*)(bg + 4 * n); buv[n] = *(const f32x4*)(bg + 1024 + 4 * n); }
#pragma unroll
        for (int ai = 0; ai < 2; ++ai)
#pragma unroll
            for (int m = 0; m < 4; ++m) { float r[8];
#pragma unroll
                for (int n = 0; n < 2; ++n) { const f32x4 gq = acc[ai][0][m][n] * ascale + bgv[n], uq = acc[ai][1][m][n] * ascale + buv[n];
#pragma unroll
                    for (int j = 0; j < 4; j += 2) { f32x2 gt = {fminf(gq[j], 7.f), fminf(gq[j + 1], 7.f)};
                        f32x2 up1 = {fminf(fmaxf(uq[j], -7.f), 7.f), fminf(fmaxf(uq[j + 1], -7.f), 7.f)}; up1 = up1 + 1.f;
                        const f32x2 z = gt * (-1.702f * 1.44269504089f);
                        f32x2 d = {__builtin_amdgcn_exp2f(z.x), __builtin_amdgcn_exp2f(z.y)}; d = d + 1.f;
                        const f32x2 rc = {__builtin_amdgcn_rcpf(d.x), __builtin_amdgcn_rcpf(d.y)};
                        const f32x2 o = (up1 * gt) * rc; r[4 * n + j] = o.x; r[4 * n + j + 1] = o.y; } }
                if constexpr (FP8) { u32x2 w; w.x = pk4_fp8(r[0], r[1], r[2], r[3]); w.y = pk4_fp8(r[4], r[5], r[6], r[7]);
                    *(u32x2*)((unsigned char*)act + (size_t)(row0 + ai * HALF + m * 16) * DFF + cc) = w; }
                else { u32x4 w; w.x = cvt_pk_bf16(r[0], r[1]); w.y = cvt_pk_bf16(r[2], r[3]); w.z = cvt_pk_bf16(r[4], r[5]); w.w = cvt_pk_bf16(r[6], r[7]);
                    *(u32x4*)((bf16_t*)act + (size_t)(row0 + ai * HALF + m * 16) * DFF + cc) = w; } }
    }
};
struct EpiDown {
    unsigned char* y; const float* bd; float ascale;
    __device__ __forceinline__ void operator()(const f32x4 (&acc)[2][2][4][2], const Unit& u, int wr, int wc, int fr, int fq) const {
        const int row0 = u.pm * BM + wr * 64 + fr, col0 = u.pn * BM + wc * 32 + 8 * fq;
        const float* bp = bd + (size_t)u.e * D + col0;
        f32x4 bv[2][2];
#pragma unroll
        for (int bj = 0; bj < 2; ++bj)
#pragma unroll
            for (int n = 0; n < 2; ++n) bv[bj][n] = *(const f32x4*)(bp + bj * HALF + 4 * n);
#pragma unroll
        for (int ai = 0; ai < 2; ++ai)
#pragma unroll
            for (int m = 0; m < 4; ++m) { unsigned char* rowp = y + (size_t)(row0 + ai * HALF + m * 16) * D + col0;
#pragma unroll
                for (int bj = 0; bj < 2; ++bj) { const f32x4 v0 = acc[ai][bj][m][0] * ascale + bv[bj][0], v1 = acc[ai][bj][m][1] * ascale + bv[bj][1];
                    u32x2 w; w.x = pk4_fp8(v0[0], v0[1], v0[2], v0[3]); w.y = pk4_fp8(v1[0], v1[1], v1[2], v1[3]);
                    *(u32x2*)(rowp + bj * HALF) = w; } }
    }
};
}

constexpr size_t MiB = 1u << 20;
constexpr size_t WS_CTL = 0, WS_MOD = 1 * MiB, WS_TOPW = 2 * MiB, WS_ASG = 3 * MiB, WS_WRT = 3 * MiB + 512 * 1024, WS_LIST = 4 * MiB, WS_WIN = 8 * MiB, WS_WOUT = 13 * MiB,
                 WS_WGU = 16 * MiB, WS_WD = 80 * MiB, WS_HN1 = 112 * MiB, WS_HN2 = 112 * MiB,
                 WS_KB = 184 * MiB, WS_VB = 202 * MiB, WS_RB = 238 * MiB, WS_QB = 243 * MiB, WS_GB = 259 * MiB, WS_PB = 291 * MiB,
                 WS_OF = 323 * MiB, WS_OB = 387 * MiB, WS_MIX = 451 * MiB, WS_ACT = 184 * MiB, WS_Y = 515 * MiB, WS_H1B = 660 * MiB, WS_END = 787 * MiB;
static_assert(WS_ACT + (size_t)NPADROWS * DFF <= WS_Y && WS_Y + (size_t)NPADROWS * D <= WS_H1B && WS_H1B + (size_t)NTOK * D * 2 <= WS_END, "ws map");


constexpr int CW_CNT = 0;
constexpr int CW_BAR = 4096;

constexpr int RING_BYTES = 131072;
constexpr int LDSCTL_OFF = 155648;
constexpr int LDS_BYTES = 163840;
constexpr int LC_BAR = 0, LC_TST = 16, LC_CNT = 64;

#define XB_TMO      128
#define XB_XCNT(j)  (256  + 64 * (j))
#define XB_XSUB(j)  (1280 + 64 * (j))
#define XB_XGEN(j)  (2304 + 64 * (j))
#define XB_TOP      3328
#define XB_TOPGEN   3392
#define XCD_BAR_WORDS 3456
#define XB_SPIN_CAP (1u << 18)
__device__ __forceinline__ unsigned xb_ld(unsigned* p)              { return __hip_atomic_load(p, __ATOMIC_RELAXED, __HIP_MEMORY_SCOPE_AGENT); }
__device__ __forceinline__ unsigned xb_add(unsigned* p, unsigned v) { return __hip_atomic_fetch_add(p, v, __ATOMIC_RELAXED, __HIP_MEMORY_SCOPE_AGENT); }
__device__ __forceinline__ unsigned xb_xcc_id() { return (unsigned)__builtin_amdgcn_s_getreg((3 << 11) | 20) & 0xFu; }
#define XB_SPIN(cond, bar) do { unsigned _sp = 0; while (cond) { __builtin_amdgcn_s_sleep(1); \
    if ((++_sp & 255u) == 0u) { if (xb_ld(&(bar)[XB_TMO])) break; if (_sp > XB_SPIN_CAP) { atomicAdd(&(bar)[XB_TMO], 1u); break; } } } } while (0)
struct XcdBarrier { unsigned* bar; unsigned x; volatile LAS unsigned* st; };
__device__ __forceinline__ XcdBarrier xcd_barrier_post(unsigned* bar, volatile LAS unsigned* st) {
    XcdBarrier b; b.bar = bar; b.x = xb_xcc_id(); b.st = st;
    if (threadIdx.x == 0) (void)xb_add(&bar[XB_XCNT(b.x)], 1u);
    return b;
}
__device__ __forceinline__ void xcd_barrier_complete(unsigned* bar, unsigned x, unsigned& nloc, unsigned& nx) {
    const unsigned G = gridDim.x * gridDim.y * gridDim.z;
    unsigned sum, cnt, mine, sp = 0u;
    for (;;) {
        sum = 0u; cnt = 0u; mine = 0u;
#pragma unroll
        for (unsigned j = 0; j < 16; ++j) { const unsigned c = xb_ld(&bar[XB_XCNT(j)]); sum += c; cnt += (c > 0u) ? 1u : 0u; mine = (j == x) ? c : mine; }
        if (sum == G) break;
        __builtin_amdgcn_s_sleep(1);
        if ((++sp & 255u) == 0u) { if (xb_ld(&bar[XB_TMO])) break; if (sp > XB_SPIN_CAP) { atomicAdd(&bar[XB_TMO], 1u); break; } }
    }
    nloc = mine > 0u ? mine : 1u; nx = cnt > 0u ? cnt : 1u;
}
__device__ __forceinline__ void xcd_barrier(const XcdBarrier& b) {
    asm volatile("s_waitcnt vmcnt(0)" ::: "memory");
    __syncthreads();
    if (threadIdx.x == 0) {
        unsigned* bar = b.bar;
        __builtin_amdgcn_s_waitcnt(0);
        unsigned nloc = b.st[0], nx = b.st[1];
        if (nloc == 0u) { xcd_barrier_complete(bar, b.x, nloc, nx); b.st[0] = nloc; b.st[1] = nx; }
        const unsigned old = xb_add(&bar[XB_XSUB(b.x)], 1u);
        const unsigned gen = old / nloc;
        if (old + 1u == (gen + 1u) * nloc) {
            __builtin_amdgcn_fence(__ATOMIC_RELEASE, "agent");
            asm volatile("s_waitcnt vmcnt(0)" ::: "memory");
            const unsigned og = xb_add(&bar[XB_TOP], 1u);
            const unsigned tg = og / nx;
            if (og + 1u == (tg + 1u) * nx) xb_add(&bar[XB_TOPGEN], 1u);
            else XB_SPIN(xb_ld(&bar[XB_TOPGEN]) == tg, bar);
            __builtin_amdgcn_fence(__ATOMIC_ACQUIRE, "agent");
            xb_add(&bar[XB_XGEN(b.x)], 1u);
            asm volatile("s_waitcnt vmcnt(0)" ::: "memory");
        } else {
            XB_SPIN(xb_ld(&bar[XB_XGEN(b.x)]) == gen, bar);
            __builtin_amdgcn_fence(__ATOMIC_ACQUIRE, "agent");
            asm volatile("s_waitcnt vmcnt(0)" ::: "memory");
        }
    }
    __syncthreads();
}

struct Args { const float* in[24]; float* out; unsigned char* ws; int ph_lo, ph_hi; };
struct Frame {
    LAS unsigned char* lds;
    int tid, lane, wave, vcu, G;
    const float* const* in; float* out; unsigned char* ws;
};
#define IN_X 0
#define IN_C 1
#define IN_CTX 2
#define IN_CCTX 3
#define IN_WADA 4
#define IN_BADA 5
#define IN_NMIX 6
#define IN_NMLP 7
#define IN_WIN 8
#define IN_WGKF 9
#define IN_BGKF 10
#define IN_WGKB 11
#define IN_BGKB 12
#define IN_GLANW 13
#define IN_WPOOL 14
#define IN_PSCALE 15
#define IN_WOUT 16
#define IN_WROUTER 17
#define IN_BROUTER 18
#define IN_WGU 19
#define IN_BGU 20
#define IN_WDOWN 21
#define IN_BDOWN 22
#define IN_FNW 23

__device__ __forceinline__ void p0_transpose_item(const float* W, int ldw, int k0, int n0, bf16_t* WT, int ldd, int drow, int dk0, LAS float* scr, int lane) {
#pragma unroll 8
    for (int i = 0; i < 32; ++i) { const int kk = 2 * i + (lane >> 5); scr[kk * 33 + (lane & 31)] = W[(size_t)(k0 + kk) * ldw + n0 + (lane & 31)]; }
    LDS_WAIT(); asm volatile("" ::: "memory");
    const int c = lane & 7;
#pragma unroll
    for (int j = 0; j < 4; ++j) { const int n = (lane >> 3) + 8 * j; const LAS float* s = scr + (8 * c) * 33 + n;
        u32x4 o; o.x = pk2(s[0 * 33], s[1 * 33]); o.y = pk2(s[2 * 33], s[3 * 33]); o.z = pk2(s[4 * 33], s[5 * 33]); o.w = pk2(s[6 * 33], s[7 * 33]);
        *(u32x4*)(WT + (size_t)(drow + n) * ldd + dk0 + k0 + 8 * c) = o; }
    LDS_WAIT(); asm volatile("" ::: "memory");
}
__device__ __forceinline__ int win_drow(int n0) {
    if (n0 < 256) return 4 * 256 + n0;
    if (n0 < 512) return n0 - 256;
    if (n0 < 1024) return 256 + (n0 - 512);
    if (n0 < 1536) return 5 * 256 + (n0 - 1024);
    if (n0 < 1568) return 3 * 256 + (n0 - 1536);
    return 7 * 256 + (n0 - 1568);
}
__device__ __forceinline__ void p0_mod_item(Frame& F, int item, const LAS float* SL, float* mod) {
    const float* w_ada = F.in[IN_WADA]; const float* b_ada = F.in[IN_BADA];
    const int j = item * 8 + (F.lane & 7), kp = F.lane >> 3;
    float acc[17];
#pragma unroll
    for (int r = 0; r < 17; ++r) acc[r] = 0.f;
#pragma unroll 4
    for (int i = 0; i < 128; ++i) { const int k = kp + 8 * i; const float w = w_ada[(size_t)k * NMOD + j];
#pragma unroll
        for (int r = 0; r < 17; ++r) acc[r] += SL[r * 1024 + k] * w; }
#pragma unroll
    for (int r = 0; r < 17; ++r) { float a = acc[r]; a += __shfl_xor(a, 8); a += __shfl_xor(a, 16); a += __shfl_xor(a, 32); if (kp == 0) mod[r * NMOD + j] = a + b_ada[j]; }
}
__device__ __forceinline__ void p0_weff_item(Frame& F, int item, LAS float* scr, bf16_t* Wout_t) {
    const float* w_pool = F.in[IN_WPOOL]; const float* pscale = F.in[IN_PSCALE]; const float* w_out = F.in[IN_WOUT];
    const int g = item >> 6, n0 = (item & 63) * 16, lane = F.lane;
#pragma unroll 4
    for (int q = 0; q < 32; ++q) { const int idx = lane + 64 * q, j = idx >> 4, nn = idx & 15; scr[idx] = w_out[(size_t)(512 + g * 128 + j) * D + n0 + nn] * pscale[g * 128 + j]; }
    LDS_WAIT(); asm volatile("" ::: "memory");
    float a0[16], a1[16];
#pragma unroll
    for (int nn = 0; nn < 16; ++nn) { a0[nn] = 0.f; a1[nn] = 0.f; }
    const float* wp0 = w_pool + (size_t)(g * 128 + lane) * 128; const float* wp1 = wp0 + 64 * 128;
    for (int j = 0; j < 128; ++j) { const float p0 = wp0[j], p1 = wp1[j];
#pragma unroll
        for (int q = 0; q < 4; ++q) { const f32x4 t = *(const LAS f32x4*)(scr + j * 16 + 4 * q);
#pragma unroll
            for (int z = 0; z < 4; ++z) { a0[4 * q + z] += p0 * t[z]; a1[4 * q + z] += p1 * t[z]; } } }
#pragma unroll
    for (int nn = 0; nn < 16; ++nn) { bf16_t* o = Wout_t + (size_t)(n0 + nn) * D + 512 + g * 128 + lane; o[0] = (bf16_t)f2bf(a0[nn]); o[64] = (bf16_t)f2bf(a1[nn]); }
    LDS_WAIT(); asm volatile("" ::: "memory");
}
constexpr int P0_CVT_E = 0;
constexpr float WSCALE = 32.f;
constexpr int CVP = 260;
__device__ __forceinline__ unsigned pk4_fp8s(float a, float b, float c, float d) { int w = 0; w = __builtin_amdgcn_cvt_pk_fp8_f32(a * WSCALE, b * WSCALE, w, false); w = __builtin_amdgcn_cvt_pk_fp8_f32(c * WSCALE, d * WSCALE, w, true); return (unsigned)w; }
struct CvtItem { const float* src; int ldw, k0, n0, e; bool gu; };
__device__ __forceinline__ CvtItem cvt_decode(Frame& F, int item) {
    CvtItem c;
    if (item < 2048) { c.gu = true; c.e = item >> 6; c.k0 = ((item >> 3) & 7) * 128; c.n0 = (item & 7) * 256; c.src = F.in[IN_WGU] + (size_t)c.e * D * 2048; c.ldw = 2048; }
    else { const int r = item - 2048 + P0_CVT_E * 32; c.gu = false; c.e = r >> 5; c.k0 = ((r >> 2) & 7) * 128; c.n0 = (r & 3) * 256; c.src = F.in[IN_WDOWN] + (size_t)c.e * DFF * D; c.ldw = D; }
    return c;
}
template <int MODE>
__device__ __forceinline__ void cvt_expert_items(Frame& F, int first, int stride, int nitems) {
    if (first >= nitems) return;
    LAS float* T = (LAS float*)F.lds;
    int tid = F.tid; asm volatile("" : "+v"(tid));
    f32x4 R[16];
    { const CvtItem c = cvt_decode(F, first);
#pragma unroll
      for (int i = 0; i < 16; ++i) { const int idx = tid + NTHR * i, kk = idx >> 6, n4 = idx & 63; R[i] = __builtin_nontemporal_load((const f32x4*)(c.src + (size_t)(c.k0 + kk) * c.ldw + c.n0 + 4 * n4)); } }
    for (int item = first; item < nitems; item += stride) {
        const CvtItem c = cvt_decode(F, item);
#pragma unroll
        for (int i = 0; i < 16; ++i) { const int idx = tid + NTHR * i, kk = idx >> 6, n4 = idx & 63; *(LAS f32x4*)(T + kk * CVP + 4 * n4) = R[i]; }
        __syncthreads();
        if (MODE != 1 && item + stride < nitems) { const CvtItem cn = cvt_decode(F, item + stride);
#pragma unroll
            for (int i = 0; i < 16; ++i) { const int idx = tid + NTHR * i, kk = idx >> 6, n4 = idx & 63; R[i] = __builtin_nontemporal_load((const f32x4*)(cn.src + (size_t)(cn.k0 + kk) * cn.ldw + cn.n0 + 4 * n4)); } }
        u32x4 o[4];
        { const int n = F.wave * 32 + (F.lane & 31), half = F.lane >> 5;
          const LAS float* col = T + (64 * half) * CVP + n;
#pragma unroll
          for (int q = 0; q < 4; ++q) { unsigned w4[4];
#pragma unroll
              for (int z = 0; z < 4; ++z) { const LAS float* p = col + (16 * q + 4 * z) * CVP; w4[z] = pk4_fp8s(p[0], p[CVP], p[2 * CVP], p[3 * CVP]); }
              o[q] = (u32x4){w4[0], w4[1], w4[2], w4[3]}; }
          __syncthreads();
          LAS unsigned char* OUTL = (LAS unsigned char*)F.lds;
#pragma unroll
          for (int q = 0; q < 4; ++q) *(LAS u32x4*)(OUTL + n * 144 + half * 64 + q * 16) = o[q]; }
        __syncthreads();
#pragma unroll
        for (int i = 0; i < 4; ++i) { const int idx = tid + NTHR * i, n = idx >> 3, ch = idx & 7;
            const u32x4 v = *(const LAS u32x4*)((const LAS unsigned char*)F.lds + n * 144 + ch * 16);
            size_t drow;
            if (c.gu) { const int jn = (c.n0 + n) & 1023; drow = (size_t)c.e * 2048 + (jn >> 7) * 256 + ((c.n0 + n) >= 1024 ? 128 : 0) + (jn & 127); }
            else drow = (size_t)c.e * D + c.n0 + n;
            if (MODE != 2 || v.x == 0x12345678u) *(u32x4*)((unsigned char*)(F.ws + (c.gu ? WS_WGU : WS_WD)) + drow * 1024 + c.k0 + ch * 16) = v; }
        __syncthreads();
    }
}

constexpr int CVH = 64 * CVP * 4;
__device__ __forceinline__ void cvt_dma_issue(Frame& F, int first, int stride, int t) {
    const CvtItem c = cvt_decode(F, first + (t >> 1) * stride); const int half = t & 1;
    LAS unsigned char* buf = F.lds + (t & 1) * CVH;
#pragma unroll
    for (int i = 0; i < 8; ++i) { const int row = 8 * F.wave + i;
        __builtin_amdgcn_global_load_lds((const unsigned*)(c.src + (size_t)(c.k0 + 64 * half + row) * c.ldw + c.n0 + 4 * F.lane), (LAS unsigned*)(buf + row * (CVP * 4)), 16, 0, 2); }
}
#define CVT_LW() asm volatile("s_waitcnt lgkmcnt(0)" ::: "memory")
#define CVT_BAR() do { __builtin_amdgcn_s_barrier(); asm volatile("" ::: "memory"); } while (0)
__device__ __forceinline__ void cvt_expert_items_dma(Frame& F, int first, int stride, int nitems) {
    if (first >= nitems) return;
    const int nh = 2 * ((nitems - first + stride - 1) / stride);
    int tid = F.tid; asm volatile("" : "+v"(tid));
    cvt_dma_issue(F, first, stride, 0); cvt_dma_issue(F, first, stride, 1);
    for (int t = 0; t < nh; ++t) {
        const CvtItem c = cvt_decode(F, first + (t >> 1) * stride); const int half = t & 1;
        LAS unsigned char* buf = F.lds + (t & 1) * CVH; const LAS float* T = (const LAS float*)buf;
        if (t + 1 < nh) asm volatile("s_waitcnt vmcnt(8)" ::: "memory"); else asm volatile("s_waitcnt vmcnt(0)" ::: "memory");
        CVT_BAR();
        u32x4 o0, o1;
        { const int n = F.wave * 32 + (F.lane & 31), kq = F.lane >> 5;
          const LAS float* col = T + (32 * kq) * CVP + n; unsigned w8[8];
#pragma unroll
          for (int z = 0; z < 8; ++z) { const LAS float* p = col + (4 * z) * CVP; w8[z] = pk4_fp8s(p[0], p[CVP], p[2 * CVP], p[3 * CVP]); }
          o0 = (u32x4){w8[0], w8[1], w8[2], w8[3]}; o1 = (u32x4){w8[4], w8[5], w8[6], w8[7]};
          CVT_LW(); CVT_BAR();
          *(LAS u32x4*)(buf + n * 80 + kq * 32) = o0; *(LAS u32x4*)(buf + n * 80 + kq * 32 + 16) = o1; }
        CVT_LW(); CVT_BAR();
#pragma unroll
        for (int i = 0; i < 2; ++i) { const int idx = tid + NTHR * i, n = idx >> 2, ch = idx & 3;
            const u32x4 v = *(const LAS u32x4*)(buf + n * 80 + ch * 16);
            size_t drow;
            if (c.gu) { const int jn = (c.n0 + n) & 1023; drow = (size_t)c.e * 2048 + (jn >> 7) * 256 + ((c.n0 + n) >= 1024 ? 128 : 0) + (jn & 127); }
            else drow = (size_t)c.e * D + c.n0 + n;
            *(u32x4*)((unsigned char*)(F.ws + (c.gu ? WS_WGU : WS_WD)) + drow * 1024 + c.k0 + 64 * half + ch * 16) = v; }
        CVT_LW(); CVT_BAR();
        if (t + 2 < nh) cvt_dma_issue(F, first, stride, t + 2);
    }
}
#undef CVT_LW
#undef CVT_BAR


__device__ __forceinline__ void p0_prologue(Frame& F, bool do_experts) {
    { bf16_t* WRT = (bf16_t*)(F.ws + WS_WRT); const float* wr = F.in[IN_WROUTER];
      for (int idx = F.vcu * NTHR + F.tid; idx < D * NE; idx += F.G * NTHR) { const int k = idx >> 5, e = idx & 31; const float v = wr[idx]; const unsigned hi = f2bf(v);
          WRT[e * D + k] = (bf16_t)hi; WRT[NE * D + e * D + k] = (bf16_t)f2bf(v - bf2f(hi)); } }
    LAS float* SL = (LAS float*)F.lds;
    for (int idx = F.tid; idx < 17 * 1024; idx += NTHR) { const int r = idx >> 10, k = idx & 1023; const float v = r < NB ? F.in[IN_C][r * D + k] : F.in[IN_CCTX][k]; SL[idx] = silu_f(v); }
    __syncthreads();
    LAS float* scr = (LAS float*)(F.lds + 69632 + F.wave * 8448);
    bf16_t* Win_t = (bf16_t*)(F.ws + WS_WIN); bf16_t* Wout_t = (bf16_t*)(F.ws + WS_WOUT); bf16_t* Wgu_t = (bf16_t*)(F.ws + WS_WGU); bf16_t* Wd_t = (bf16_t*)(F.ws + WS_WD);
    float* mod = (float*)(F.ws + WS_MOD);
    constexpr int I_MOD = NMOD / 8, I_WEFF = 4 * 64, I_WIN = 16 * (DIN / 32), I_ZERO = 224, I_WOUT = 8 * 32, I_GU = NE * 16 * 64, I_DN = NE * 16 * 32;
    const int nitems = I_MOD + I_WEFF + I_WIN + I_ZERO + I_WOUT + (do_experts ? I_GU + I_DN : 0);
    const int gw = F.wave * F.G + F.vcu, NGW = F.G * NWAVES;
    for (int it = gw; it < nitems; it += NGW) {
        int r = it;
        if (r < I_MOD) { p0_mod_item(F, r, SL, mod); continue; } r -= I_MOD;
        if (r < I_WEFF) { p0_weff_item(F, r, scr, Wout_t); continue; } r -= I_WEFF;
        if (r < I_WIN) { const int kb = r / (DIN / 32), nb = r % (DIN / 32); p0_transpose_item(F.in[IN_WIN], DIN, 64 * kb, 32 * nb, Win_t, D, win_drow(32 * nb), 0, scr, F.lane); continue; } r -= I_WIN;
        if (r < I_ZERO) { u32x4* o = (u32x4*)(Win_t + (size_t)(3 * 256 + 32 + r) * D) + F.lane * 2; o[0] = (u32x4){0u, 0u, 0u, 0u}; o[1] = (u32x4){0u, 0u, 0u, 0u}; continue; } r -= I_ZERO;
        if (r < I_WOUT) { const int kb = r / 32, nb = r % 32; p0_transpose_item(F.in[IN_WOUT], D, 64 * kb, 32 * nb, Wout_t, D, 32 * nb, 0, scr, F.lane); continue; } r -= I_WOUT;
        if (r < I_GU) { const int e = r / (16 * 64), q = r % (16 * 64), kb = q / 64, nb = q % 64, n0 = 32 * nb, jn = n0 & 1023;
            const int drow = e * 2048 + (jn >> 7) * 256 + (n0 >= 1024 ? 128 : 0) + (jn & 127);
            p0_transpose_item(F.in[IN_WGU] + (size_t)e * D * 2048, 2048, 64 * kb, n0, Wgu_t, D, drow, 0, scr, F.lane); continue; } r -= I_GU;
        { const int e = r / (16 * 32), q = r % (16 * 32), kb = q / 32, nb = q % 32;
            p0_transpose_item(F.in[IN_WDOWN] + (size_t)e * DFF * D, D, 64 * kb, 32 * nb, Wd_t, DFF, e * D + 32 * nb, 0, scr, F.lane); }
    }}

__device__ __forceinline__ void norm_row_bf16(const float* src, const float* wn, const float* sh, const float* sc, bf16_t* dst, int lane) {
    const f32x4* xr = (const f32x4*)src + lane;
    f32x4 v[4]; float s = 0.f;
#pragma unroll
    for (int j = 0; j < 4; ++j) { v[j] = xr[64 * j]; s += (v[j].x * v[j].x + v[j].y * v[j].y) + (v[j].z * v[j].z + v[j].w * v[j].w); }
    const float rstd = rsqrtf(wave_sum(s) * (1.f / D) + EPS);
    u32x2* o8 = (u32x2*)dst + lane;
#pragma unroll
    for (int j = 0; j < 4; ++j) { const f32x4 w = ((const f32x4*)wn)[lane + 64 * j], a = ((const f32x4*)sc)[lane + 64 * j], b = ((const f32x4*)sh)[lane + 64 * j];
        const f32x4 y = v[j] * rstd * w * (a + 1.f) + b; u32x2 p; p.x = pk2(y.x, y.y); p.y = pk2(y.z, y.w); o8[64 * j] = p; }
}
__device__ __forceinline__ void p1_norm1(Frame& F) {
    const float* mod = (const float*)(F.ws + WS_MOD); bf16_t* HN = (bf16_t*)(F.ws + WS_HN1);
    constexpr int RPB = NROW / 256;
    for (int blk = F.vcu; blk < 256; blk += F.G)
        for (int r = F.wave; r < RPB; r += NWAVES) { const int row = blk * RPB + r;
            const float* src = row < NTOK ? F.in[IN_X] + (size_t)row * D : F.in[IN_CTX] + (size_t)(row - NTOK) * D;
            const float* mr = mod + (size_t)(row < NTOK ? row / SEQ : NB) * NMOD;
            norm_row_bf16(src, F.in[IN_NMIX], mr, mr + 1024, HN + (size_t)row * D, F.lane); }
}

typedef __bf16 bf16x2n __attribute__((ext_vector_type(2)));
__device__ __forceinline__ unsigned pkbf(float lo, float hi) { f32x2 v = {lo, hi}; return __builtin_bit_cast(unsigned, __builtin_convertvector(v, bf16x2n)); }
#define MFMA32(a, b, c) __builtin_amdgcn_mfma_f32_32x32x16_bf16((a), (b), (c), 0, 0, 0)
constexpr int GP = 72;
constexpr int GL_QP = 0, GL_KP = 9216, GL_QQ = 18432, GL_KKT = 27648, GL_VT = 36864, GL_DEC = 55296, GL_GSUM = 55552, GL_R = 57600, GL_END = 61696;

__device__ __forceinline__ bf16x8 pack8(const f32x16& x, int s) {
    u32x4 p; p.x = pkbf(x[8 * s + 0], x[8 * s + 1]); p.y = pkbf(x[8 * s + 2], x[8 * s + 3]); p.z = pkbf(x[8 * s + 4], x[8 * s + 5]); p.w = pkbf(x[8 * s + 6], x[8 * s + 7]);
    return __builtin_bit_cast(bf16x8, p);
}
__device__ __forceinline__ bf16x8 ld_perm8(const LAS bf16_t* p) {
    const u32x2 a = *(const LAS u32x2*)p, b = *(const LAS u32x2*)(p + 8); u32x4 r; r.x = a.x; r.y = a.y; r.z = b.x; r.w = b.y; return __builtin_bit_cast(bf16x8, r);
}
__device__ __forceinline__ bf16x8 ld_nat8(const LAS bf16_t* p) { return *(const LAS bf16x8*)p; }

template <int GM>
__device__ __forceinline__ void gla_unit(Frame& F, const int unit) {
    const int b = unit >> 3, h = (unit >> 1) & 3, dir = unit & 1;
    const int w = F.wave, lane = F.lane, tid = F.tid;
    LAS unsigned char* L = F.lds;
    LAS bf16_t* QP = (LAS bf16_t*)(L + GL_QP); LAS bf16_t* KP = (LAS bf16_t*)(L + GL_KP); LAS bf16_t* QQ = (LAS bf16_t*)(L + GL_QQ);
    LAS bf16_t* KKT = (LAS bf16_t*)(L + GL_KKT); LAS bf16_t* VT = (LAS bf16_t*)(L + GL_VT);
    LAS float* DEC = (LAS float*)(L + GL_DEC); LAS float* GSUM = (LAS float*)(L + GL_GSUM); LAS float* RL = (LAS float*)(L + GL_R);
    const bf16_t* QB = (const bf16_t*)(F.ws + WS_QB); const bf16_t* KB = (const bf16_t*)(F.ws + WS_KB); const bf16_t* VB = (const bf16_t*)(F.ws + WS_VB);
    const float* RB = (const float*)(F.ws + WS_RB);
    bf16_t* OD = (bf16_t*)(F.ws + (GM >= 3 ? (dir ? 870 * MiB : 830 * MiB) : (dir ? WS_OB : WS_OF)));
    const float* wgk = F.in[dir ? IN_WGKB : IN_WGKF]; const float* bgk = F.in[dir ? IN_BGKB : IN_BGKF];
    f32x2 wg[8];
#pragma unroll
    for (int j = 0; j < 8; ++j) wg[j] = (f32x2){wgk[(2 * j) * 256 + h * 64 + lane], wgk[(2 * j + 1) * 256 + h * 64 + lane]};
    const float bg = bgk[h * 64 + lane];
    f32x16 S0, S1;
#pragma unroll
    for (int i = 0; i < 16; ++i) { S0[i] = 0.f; S1[i] = 0.f; }
    const int tb = w >> 2, vb = w & 3, c = lane & 31, hh = lane >> 5;
    const int vs = lane, vc = w;
    const int rs = tid >> 3, rc = tid & 7;
    unsigned pq[8], pk[8]; u32x4 pv0, pv1; f32x2 pr;
#define GLA_LOAD(step) do { const int _s = (step); const bool _ctx = _s < 4; const int _ci = _ctx ? _s : _s - 4; const int _ch = dir ? ((_ctx ? 3 : 31) - _ci) : _ci; \
        const int _row0 = _ctx ? NTOK + b * CTX + _ch * 64 : b * SEQ + _ch * 64; \
        _Pragma("unroll") for (int _i = 0; _i < 8; ++_i) { const int _t = 8 * w + _i; const size_t _row = (size_t)(_row0 + (dir ? 63 - _t : _t)); \
            pk[_i] = KB[_row * 256 + h * 64 + lane]; pq[_i] = _ctx ? 0u : (unsigned)QB[_row * 256 + h * 64 + lane]; } \
        { const size_t _row = (size_t)(_row0 + (dir ? 63 - vs : vs)); const u32x4* _vp = (const u32x4*)(VB + _row * 512 + h * 128 + vc * 16); pv0 = _vp[0]; pv1 = _vp[1]; \
          const size_t _rr = (size_t)(_row0 + (dir ? 63 - rs : rs)); pr = *(const f32x2*)(RB + _rr * 32 + dir * 16 + rc * 2); } } while (0)
    GLA_LOAD(0);
    for (int step = 0; step < 36; ++step) {
        const bool isctx = step < 4; const int ci = isctx ? step : step - 4; const int chunk = dir ? ((isctx ? 3 : 31) - ci) : ci;
        const int row0 = isctx ? NTOK + b * CTX + chunk * 64 : b * SEQ + chunk * 64;
        unsigned cq[8], ck[8]; u32x4 cv0 = pv0, cv1 = pv1;
#pragma unroll
        for (int i = 0; i < 8; ++i) { cq[i] = pq[i]; ck[i] = pk[i]; }
        *(LAS f32x2*)(RL + rs * 16 + rc * 2) = pr;
        __syncthreads();
        float cs[8];
        { float run = 0.f;
#pragma unroll
          for (int i = 0; i < 8; ++i) { const LAS f32x4* rp = (const LAS f32x4*)(RL + (8 * w + i) * 16); f32x2 a2 = {bg, 0.f};
#pragma unroll
              for (int q4 = 0; q4 < ((GM == 3) ? 1 : 4); ++q4) { const f32x4 rv = rp[q4]; a2 = __builtin_elementwise_fma((f32x2){rv[0], rv[1]}, wg[2 * q4], a2); a2 = __builtin_elementwise_fma((f32x2){rv[2], rv[3]}, wg[2 * q4 + 1], a2); }
              const float x = a2.x + a2.y;
              const float gk = (GM == 3) ? x * 1e-3f : __builtin_fmaf(__builtin_amdgcn_logf(1.f + __builtin_amdgcn_exp2f(fabsf(x) * -1.44269504089f)), -0.69314718056f / 16.f, fminf(x, 0.f) * (1.f / 16.f));
              run += gk; cs[i] = run; }
          GSUM[w * 64 + lane] = run; }
        __syncthreads();
        { float pre = 0.f, mid = 0.f, tot = 0.f;
#pragma unroll
          for (int g = 0; g < 8; ++g) { const float gsum = GSUM[g * 64 + lane]; if (g < w) pre += gsum; if (g < 4) mid += gsum; tot += gsum; }
          if (w == 0) DEC[lane] = __expf(tot);
          const f32x2 emt = {__expf(mid), __expf(tot - mid)}; const float pm = pre - mid;
          u32x4 kk4;
          float kkf[8];
#pragma unroll
          for (int i = 0; i < ((GM == 4) ? 1 : 8); ++i) { const int t = 8 * w + i; const float dd = pm + cs[i];
              const f32x2 ea = __builtin_elementwise_fma((f32x2){dd, dd}, (f32x2){1.44269504089f, -1.44269504089f}, (f32x2){-3.f, 0.f});
              const f32x2 e = {__builtin_amdgcn_exp2f(ea.x), __builtin_amdgcn_exp2f(ea.y)};
              const f32x2 qk = {bf2f(cq[i]), bf2f(ck[i])};
              const f32x2 o2 = qk * (e * emt); kkf[i] = o2.y;
              if (!isctx) { const f32x2 o1 = qk * e; const unsigned w1 = pkbf(o1.x, o1.y), w2 = pkbf(o2.x, 0.f);
                  QP[t * GP + lane] = (bf16_t)(w1 & 0xffffu); KP[t * GP + lane] = (bf16_t)(w1 >> 16); QQ[t * GP + lane] = (bf16_t)(w2 & 0xffffu); } }
          kk4.x = pkbf(kkf[0], kkf[1]); kk4.y = pkbf(kkf[2], kkf[3]); kk4.z = pkbf(kkf[4], kkf[5]); kk4.w = pkbf(kkf[6], kkf[7]);
          *(LAS u32x4*)(KKT + lane * GP + 8 * w) = kk4;
          const unsigned vw[8] = {cv0.x, cv0.y, cv0.z, cv0.w, cv1.x, cv1.y, cv1.z, cv1.w};
#pragma unroll
          for (int e = 0; e < ((GM == 4) ? 1 : 8); ++e) { VT[(vc * 16 + 2 * e) * GP + vs] = (bf16_t)(vw[e] & 0xffffu); VT[(vc * 16 + 2 * e + 1) * GP + vs] = (bf16_t)(vw[e] >> 16); } }
        if (step + 1 < 36) GLA_LOAD(step + 1);
        __syncthreads();
        if (!isctx && GM != 1) {
            f32x16 O;
#pragma unroll
            for (int i = 0; i < 16; ++i) O[i] = 0.f;
#pragma unroll
            for (int s = 0; s < 2; ++s) { O = MFMA32(ld_perm8(QQ + (32 * tb + c) * GP + 16 * s + 4 * hh), pack8(S0, s), O);
                                          O = MFMA32(ld_perm8(QQ + (32 * tb + c) * GP + 32 + 16 * s + 4 * hh), pack8(S1, s), O); }
#pragma unroll
            for (int sb = 0; sb < 2; ++sb) { if (sb > tb) continue;
                f32x16 X;
#pragma unroll
                for (int i = 0; i < 16; ++i) X[i] = 0.f;
#pragma unroll
                for (int s = 0; s < 4; ++s) X = MFMA32(ld_nat8(KP + (32 * sb + c) * GP + 16 * s + 8 * hh), ld_nat8(QP + (32 * tb + c) * GP + 16 * s + 8 * hh), X);
                if (sb == tb) {
#pragma unroll
                    for (int r = 0; r < 16; ++r) { const int sl = (r & 3) + 8 * (r >> 2) + 4 * hh; X[r] = (sl <= c) ? X[r] : 0.f; } }
#pragma unroll
                for (int s = 0; s < 2; ++s) O = MFMA32(pack8(X, s), ld_perm8(VT + (32 * vb + c) * GP + 32 * sb + 16 * s + 4 * hh), O);
            }
#pragma unroll
            for (int r = 0; r < ((GM == 2) ? 1 : 16); ++r) { const int t = 32 * tb + (r & 3) + 8 * (r >> 2) + 4 * hh; const size_t row = (size_t)(row0 + (dir ? 63 - t : t));
                OD[row * 512 + h * 128 + 32 * vb + c] = (bf16_t)(pkbf(O[r], 0.f) & 0xffffu); }
        }
        if (GM != 1) {
#pragma unroll
            for (int g4 = 0; g4 < 4; ++g4) { const f32x4 d0 = *(const LAS f32x4*)(DEC + 8 * g4 + 4 * hh), d1 = *(const LAS f32x4*)(DEC + 32 + 8 * g4 + 4 * hh);
#pragma unroll
                for (int z = 0; z < 4; ++z) { S0[4 * g4 + z] *= d0[z]; S1[4 * g4 + z] *= d1[z]; } }
#pragma unroll
            for (int s = 0; s < 4; ++s) { const bf16x8 vf = ld_nat8(VT + (32 * vb + c) * GP + 16 * s + 8 * hh);
                S0 = MFMA32(ld_nat8(KKT + c * GP + 16 * s + 8 * hh), vf, S0);
                S1 = MFMA32(ld_nat8(KKT + (32 + c) * GP + 16 * s + 8 * hh), vf, S1); }
        }
    }
#undef GLA_LOAD
    __syncthreads();
}

constexpr int PRS = 72 * 2;
__device__ __forceinline__ int pslot(int x) { return 2 * (x + (x >> 3)); }
template <int G_>
__device__ __forceinline__ void pool_unit_g(Frame& F, const int cblk, const int b) {
    constexpr int g = G_, wdw = 2 << g, lo = wdw >> 1, hi = wdw - 1 - lo;
    LAS f32x4* X = (LAS f32x4*)F.lds;
    LAS f32x4* H = (LAS f32x4*)(F.lds + 73728);
    const bf16_t* PB = (const bf16_t*)(F.ws + WS_PB) + ((size_t)((b * 4 + g) * 16 + cblk) * 2048) * 8;
    bf16_t* MIX = (bf16_t*)(F.ws + WS_MIX);
    int tid = F.tid; asm volatile("" : "+v"(tid));
#pragma unroll
    for (int i = 0; i < 4; ++i) { const int tok = tid + 512 * i, r = tok >> 6, x = tok & 63; const u32x4 v = *(const u32x4*)(PB + (size_t)tok * 8);
        LAS f32x4* p = X + r * PRS + pslot(x);
        p[0] = (f32x4){bflo(v.x), bfhi(v.x), bflo(v.y), bfhi(v.y)}; p[1] = (f32x4){bflo(v.z), bfhi(v.z), bflo(v.w), bfhi(v.w)}; }
    __syncthreads();
    { const int q = tid & 1, cs = (tid >> 1) & 7, r = tid >> 4; const LAS f32x4* xr = X + r * PRS + q; LAS f32x4* hr = H + r * PRS + q;
      const int c0 = 8 * cs; f32x4 s = {0.f, 0.f, 0.f, 0.f};
#pragma unroll
      for (int d = -lo; d <= hi; ++d) { const int x = c0 + d; const bool ok = (x >= 0) && (x < GW); const int xc = x < 0 ? 0 : (x > GW - 1 ? GW - 1 : x); const f32x4 v = xr[pslot(xc)]; s += ok ? v : (f32x4){0.f, 0.f, 0.f, 0.f}; if (((d + lo) & 3) == 3) asm volatile("" ::: "memory"); }
      hr[pslot(c0)] = s;
#pragma unroll
      for (int j = 1; j < 8; ++j) { const int xin = c0 + j + hi, xout = c0 + j - 1 - lo; const bool oki = xin < GW, oko = xout >= 0;
          const f32x4 vi = xr[pslot(oki ? xin : GW - 1)], vo = xr[pslot(oko ? xout : 0)];
          s += oki ? vi : (f32x4){0.f, 0.f, 0.f, 0.f}; s -= oko ? vo : (f32x4){0.f, 0.f, 0.f, 0.f}; hr[pslot(c0 + j)] = s; } }
    __syncthreads();
    { const int q = tid & 1, cc = (tid >> 1) & 63, rs = tid >> 7; const int col = pslot(cc) + q; const int r0s = 8 * rs;
      const int c0 = max(cc - lo, 0), c1 = min(cc + hi + 1, GW); const float ncol = (float)(c1 - c0);
      f32x4 s = {0.f, 0.f, 0.f, 0.f};
#pragma unroll
      for (int d = -lo; d <= hi; ++d) { const int y = r0s + d; const bool ok = (y >= 0) && (y < GROWS); const int yc = y < 0 ? 0 : (y > GROWS - 1 ? GROWS - 1 : y); const f32x4 v = H[yc * PRS + col]; s += ok ? v : (f32x4){0.f, 0.f, 0.f, 0.f}; if (((d + lo) & 3) == 3) asm volatile("" ::: "memory"); }
#pragma unroll
      for (int j = 0; j < 8; ++j) { const int r = r0s + j;
          if (j > 0) { const int yin = r + hi, yout = r - 1 - lo; const bool oki = yin < GROWS, oko = yout >= 0;
              const f32x4 vi = H[(oki ? yin : GROWS - 1) * PRS + col], vo = H[(oko ? yout : 0) * PRS + col];
              s += oki ? vi : (f32x4){0.f, 0.f, 0.f, 0.f}; s -= oko ? vo : (f32x4){0.f, 0.f, 0.f, 0.f}; }
          const int ra = max(r - lo, 0), rb = min(r + hi + 1, GROWS);
          const float inv = 1.f / ((float)(rb - ra) * ncol);
          const f32x4 o = s * inv - X[r * PRS + col];
          u32x2 pw; pw.x = pkbf(o[0], o[1]); pw.y = pkbf(o[2], o[3]);
          *(u32x2*)(MIX + (size_t)(b * SEQ + r * GW + cc) * D + 512 + g * 128 + cblk * 8 + q * 4) = pw; } }
    __syncthreads();
}
__device__ __forceinline__ void pool_unit(Frame& F, const int unit) {
    const int g = unit & 3, cblk = (unit >> 2) & 15, b = unit >> 6;
    if (g == 0) pool_unit_g<0>(F, cblk, b); else if (g == 1) pool_unit_g<1>(F, cblk, b); else if (g == 2) pool_unit_g<2>(F, cblk, b); else pool_unit_g<3>(F, cblk, b);
}

__device__ __forceinline__ void p4_gla_out(Frame& F) {
    const bf16_t* OFp = (const bf16_t*)(F.ws + WS_OF); const bf16_t* OBp = (const bf16_t*)(F.ws + WS_OB); const bf16_t* GB = (const bf16_t*)(F.ws + WS_GB);
    bf16_t* MIX = (bf16_t*)(F.ws + WS_MIX); const float* wn = F.in[IN_GLANW];
    const int lane = F.lane, gw = F.vcu * NWAVES + F.wave, NGW = F.G * NWAVES;
    const f32x4 w0 = *(const f32x4*)(wn + (lane & 15) * 8), w1 = *(const f32x4*)(wn + (lane & 15) * 8 + 4);
    for (int tok = gw; tok < NTOK; tok += NGW) {
        const u32x4 fa = *((const u32x4*)(OFp + (size_t)tok * 512) + lane), fb = *((const u32x4*)(OBp + (size_t)tok * 512) + lane);
        const f32x4 o0 = (f32x4){bflo(fa.x) + bflo(fb.x), bfhi(fa.x) + bfhi(fb.x), bflo(fa.y) + bflo(fb.y), bfhi(fa.y) + bfhi(fb.y)};
        const f32x4 o1 = (f32x4){bflo(fa.z) + bflo(fb.z), bfhi(fa.z) + bfhi(fb.z), bflo(fa.w) + bflo(fb.w), bfhi(fa.w) + bfhi(fb.w)};
        const u32x4 gv = *((const u32x4*)(GB + (size_t)tok * 512) + lane);
        float ss = (o0[0] * o0[0] + o0[1] * o0[1]) + (o0[2] * o0[2] + o0[3] * o0[3]) + (o1[0] * o1[0] + o1[1] * o1[1]) + (o1[2] * o1[2] + o1[3] * o1[3]);
        ss += __shfl_xor(ss, 1); ss += __shfl_xor(ss, 2); ss += __shfl_xor(ss, 4); ss += __shfl_xor(ss, 8);
        const float rstd = rsqrtf(ss * (1.f / 128.f) + EPS);
        const float gg[8] = {bflo(gv.x), bfhi(gv.x), bflo(gv.y), bfhi(gv.y), bflo(gv.z), bfhi(gv.z), bflo(gv.w), bfhi(gv.w)};
        float y[8];
#pragma unroll
        for (int j = 0; j < 4; ++j) { y[j] = o0[j] * rstd * w0[j] * silu_f(gg[j]); y[4 + j] = o1[j] * rstd * w1[j] * silu_f(gg[4 + j]); }
        u32x4 pw; pw.x = pkbf(y[0], y[1]); pw.y = pkbf(y[2], y[3]); pw.z = pkbf(y[4], y[5]); pw.w = pkbf(y[6], y[7]);
        *((u32x4*)(MIX + (size_t)tok * D) + lane) = pw;
    }
}

constexpr int P6_AP = 1032;
constexpr int L6_AH = 0, L6_AL = 32 * P6_AP * 2, L6_LG = 2 * L6_AL;
constexpr int L6_REC = L6_LG + 128 * 33 * 4;
constexpr int L6_RED = 0;
static_assert(L6_REC + 4096 <= LDSCTL_OFF && 8 * 32 * 33 * 4 <= L6_LG, "P6 LDS map");
template <int PRB = 0>
__device__ __forceinline__ void p6_router(Frame& F) {
    LAS bf16_t* AH = (LAS bf16_t*)(F.lds + L6_AH); LAS bf16_t* AL = (LAS bf16_t*)(F.lds + L6_AL); LAS float* LG = (LAS float*)(F.lds + L6_LG); LAS float* RED = (LAS float*)(F.lds + L6_RED);
    LAS unsigned* REC = (LAS unsigned*)(F.lds + L6_REC); LAS float* RECW = (LAS float*)(F.lds + L6_REC + 2048);
    LAS int* LCNT = (LAS int*)(F.lds + LDSCTL_OFF) + LC_CNT; LAS int* GBASE = LCNT + 32;
    const float* b_router = F.in[IN_BROUTER]; const float* wn = F.in[IN_NMLP];
    const float* mod = (const float*)(F.ws + WS_MOD); const bf16_t* h1 = (const bf16_t*)(F.ws + WS_H1B);
    unsigned char* HN2 = (unsigned char*)(F.ws + WS_HN2);
    int* gcnt = (int*)(F.ws + WS_CTL) + CW_CNT + (PRB ? 65536 : 0); int* list = (int*)(F.ws + (PRB ? 830 * MiB : WS_LIST)); unsigned* ASG = (unsigned*)(F.ws + (PRB ? 900 * MiB : WS_ASG)); float* TOPW = (float*)(F.ws + (PRB ? 905 * MiB : WS_TOPW));
    const int lane = F.lane, w = F.wave, tid = F.tid, c = lane & 31, hh = lane >> 5;
    bf16x8 bh[8], bl[8];
    { const bf16_t* WRT = (const bf16_t*)(F.ws + WS_WRT);
#pragma unroll
      for (int s = 0; s < 8; ++s) { bh[s] = *(const bf16x8*)(WRT + c * D + 128 * w + 16 * s + 8 * hh); bl[s] = *(const bf16x8*)(WRT + NE * D + c * D + 128 * w + 16 * s + 8 * hh); } }
    const f32x4 wn4[4] = {((const f32x4*)wn)[lane], ((const f32x4*)wn)[lane + 64], ((const f32x4*)wn)[lane + 128], ((const f32x4*)wn)[lane + 192]};
    for (int tblk = F.vcu; tblk < NTOK / 128; tblk += F.G) {
        if (tid < 32) LCNT[tid] = 0;
        const float* mrow = mod + (size_t)((tblk * 128) >> 11) * NMOD;
        f32x4 sc4[4], sh4[4];
#pragma unroll
        for (int j = 0; j < 4; ++j) { sc4[j] = ((const f32x4*)(mrow + 4096))[lane + 64 * j] + 1.f; sh4[j] = ((const f32x4*)(mrow + 3072))[lane + 64 * j]; }
        u32x2 hn[4][4];
#pragma unroll
        for (int q = 0; q < 4; ++q) { const u32x2* xr = (const u32x2*)(h1 + (size_t)(tblk * 128 + 4 * w + q) * D) + lane;
#pragma unroll
          for (int j = 0; j < 4; ++j) hn[q][j] = xr[64 * j]; }
        for (int tile = 0; tile < 4; ++tile) {
#pragma unroll
            for (int q = 0; q < 4; ++q) { const int tl = 4 * w + q, tok = tblk * 128 + tile * 32 + tl;
                f32x4 hv[4]; float s = 0.f;
#pragma unroll
                for (int j = 0; j < 4; ++j) { hv[j] = (f32x4){bflo(hn[q][j].x), bfhi(hn[q][j].x), bflo(hn[q][j].y), bfhi(hn[q][j].y)}; s += (hv[j].x * hv[j].x + hv[j].y * hv[j].y) + (hv[j].z * hv[j].z + hv[j].w * hv[j].w); }
                if (tile < 3) { const u32x2* xr = (const u32x2*)(h1 + (size_t)(tok + 32) * D) + lane;
#pragma unroll
                    for (int j = 0; j < 4; ++j) hn[q][j] = xr[64 * j]; }
                const float rstd = rsqrtf(wave_sum(s) * (1.f / D) + EPS);
                unsigned* o4 = (unsigned*)(HN2 + (size_t)tok * D) + lane;
#pragma unroll
                for (int j = 0; j < 4; ++j) { const f32x4 y = hv[j] * rstd * wn4[j] * sc4[j] + sh4[j];
                    o4[64 * j] = pg8::pk4_fp8(y.x, y.y, y.z, y.w);
                    u32x2 hi2; hi2.x = pkbf(y.x, y.y); hi2.y = pkbf(y.z, y.w);
                    u32x2 lo2; lo2.x = pkbf(y.x - bflo(hi2.x), y.y - bfhi(hi2.x)); lo2.y = pkbf(y.z - bflo(hi2.y), y.w - bfhi(hi2.y));
                    *(LAS u32x2*)(AH + tl * P6_AP + 4 * lane + 256 * j) = hi2; *(LAS u32x2*)(AL + tl * P6_AP + 4 * lane + 256 * j) = lo2; } }
            __syncthreads();
            f32x16 Dp;
#pragma unroll
            for (int i = 0; i < 16; ++i) Dp[i] = 0.f;
#pragma unroll
            for (int s = 0; s < 8; ++s) { const bf16x8 ah = *(const LAS bf16x8*)(AH + c * P6_AP + 128 * w + 16 * s + 8 * hh), al = *(const LAS bf16x8*)(AL + c * P6_AP + 128 * w + 16 * s + 8 * hh);
                Dp = MFMA32(ah, bh[s], Dp); Dp = MFMA32(ah, bl[s], Dp); Dp = MFMA32(al, bh[s], Dp); }
            __syncthreads();
#pragma unroll
            for (int r = 0; r < 16; ++r) RED[w * (32 * 33) + ((r & 3) + 8 * (r >> 2) + 4 * hh) * 33 + c] = Dp[r];
            __syncthreads();
            { const int tl = tid >> 4, e0 = tid & 15; float a0 = 0.f, a1 = 0.f;
#pragma unroll
              for (int ww = 0; ww < 8; ++ww) { a0 += RED[ww * (32 * 33) + tl * 33 + e0]; a1 += RED[ww * (32 * 33) + tl * 33 + e0 + 16]; }
              LG[(tile * 32 + tl) * 33 + e0] = a0 + b_router[e0]; LG[(tile * 32 + tl) * 33 + e0 + 16] = a1 + b_router[e0 + 16]; }
            __syncthreads();
        }
        if (tid < 128) { float lgv[32];
#pragma unroll
            for (int e = 0; e < 32; ++e) lgv[e] = LG[tid * 33 + e];
            int se[4]; float sv[4];
#pragma unroll
            for (int r = 0; r < 4; ++r) { float bv = -3.0e38f; int bi = 0;
#pragma unroll
                for (int e = 0; e < 32; ++e) { bool ok = lgv[e] > bv;
#pragma unroll
                    for (int q = 0; q < r; ++q) ok = ok && (se[q] != e);
                    bv = ok ? lgv[e] : bv; bi = ok ? e : bi; }
                se[r] = bi; sv[r] = bv; }
            float ex[4], den = 0.f;
#pragma unroll
            for (int r = 0; r < 4; ++r) { ex[r] = __expf(sv[r] - sv[0]); den += ex[r]; }
            const float inv = 1.f / den;
#pragma unroll
            for (int r = 0; r < 4; ++r) { const int lp = __hip_atomic_fetch_add(&LCNT[se[r]], 1, __ATOMIC_RELAXED, __HIP_MEMORY_SCOPE_WORKGROUP);
                REC[tid * 4 + r] = ((unsigned)se[r] << 16) | (unsigned)lp; RECW[tid * 4 + r] = ex[r] * inv; } }
        __syncthreads();
        { int t2 = tid; asm volatile("" : "+v"(t2)); if (t2 < 32) GBASE[t2] = atomicAdd(&gcnt[64 * t2], LCNT[t2]); }
        __syncthreads();
        { const unsigned rec = REC[tid]; const int e = rec >> 16, pos = GBASE[e] + (int)(rec & 0xffffu), aid = tblk * 512 + tid;
          list[e * NTOK + pos] = aid; ASG[aid] = ((unsigned)e << 16) | (unsigned)pos; TOPW[aid] = RECW[tid]; }
        __syncthreads();
    }
}
__device__ __forceinline__ void moe_tables(Frame& F) {
    LAS int* TST = (LAS int*)(F.lds + LDSCTL_OFF) + LC_TST; LAS int* LCNT = (LAS int*)(F.lds + LDSCTL_OFF) + LC_CNT;
    const int* gcnt = (const int*)(F.ws + WS_CTL) + CW_CNT;
    if (F.tid < 64) {
        const int lane = F.lane; const int c = lane < NE ? gcnt[64 * lane] : 0; const int mt = (c + 255) >> 8; int inc = mt;
#pragma unroll
        for (int o = 1; o < 32; o <<= 1) { const int up = __shfl_up(inc, o); if (lane >= o) inc += up; }
        if (lane < NE) { LCNT[lane] = c; TST[lane] = inc - mt; }
        if (lane == NE - 1) TST[NE] = inc;
    }
    __syncthreads();
}
__device__ __forceinline__ f32x4 fp8x4_to_f32(unsigned w) { const f32x2 lo = __builtin_amdgcn_cvt_pk_f32_fp8((int)w, false), hi = __builtin_amdgcn_cvt_pk_f32_fp8((int)w, true); return (f32x4){lo.x, lo.y, hi.x, hi.y}; }
__device__ __forceinline__ void p9_final(Frame& F) {
    const LAS int* TST = (const LAS int*)(F.lds + LDSCTL_OFF) + LC_TST;
    const unsigned* ASG = (const unsigned*)(F.ws + WS_ASG); const float* TOPW = (const float*)(F.ws + WS_TOPW); const unsigned char* Y = (const unsigned char*)(F.ws + WS_Y);
    const float* mod = (const float*)(F.ws + WS_MOD); const float* fw = F.in[IN_FNW]; float* out = F.out; const bf16_t* H1B = (const bf16_t*)(F.ws + WS_H1B);
    const int lane = F.lane, gw = F.vcu * NWAVES + F.wave, NGW = F.G * NWAVES;
    f32x4 fwv[4];
#pragma unroll
    for (int j = 0; j < 4; ++j) fwv[j] = ((const f32x4*)fw)[lane + 64 * j];
    for (int tok0 = gw; tok0 < NTOK; tok0 += 2 * NGW) {
        int tk[2]; tk[0] = tok0; tk[1] = (tok0 + NGW < NTOK) ? tok0 + NGW : tok0;
        unsigned yv[2][4][4]; float wg[2][4]; u32x2 xv[2][4]; f32x4 gv[2][4];
#pragma unroll
        for (int u = 0; u < 2; ++u) { const u32x4 a4 = *(const u32x4*)(ASG + (size_t)tk[u] * 4); const f32x4 w4 = *(const f32x4*)(TOPW + (size_t)tk[u] * 4);
            const unsigned aa[4] = {a4.x, a4.y, a4.z, a4.w};
#pragma unroll
            for (int r = 0; r < 4; ++r) { const unsigned a = (unsigned)__builtin_amdgcn_readfirstlane((int)aa[r]); wg[u][r] = w4[r];
                const size_t row = (size_t)TST[a >> 16] * 256 + (a & 0xffffu); const unsigned* yp = (const unsigned*)(Y + row * D) + lane;
#pragma unroll
                for (int j = 0; j < 4; ++j) yv[u][r][j] = yp[64 * j]; }
            const u32x2* xr = (const u32x2*)(H1B + (size_t)tk[u] * D) + lane; const f32x4* g2 = (const f32x4*)(mod + (size_t)(tk[u] >> 11) * NMOD + 5120) + lane;
#pragma unroll
            for (int j = 0; j < 4; ++j) { xv[u][j] = xr[64 * j]; gv[u][j] = g2[64 * j]; } }
#pragma unroll
        for (int u = 0; u < 2; ++u) { f32x4 v[4]; float s = 0.f;
#pragma unroll
            for (int j = 0; j < 4; ++j) { f32x4 acc = fp8x4_to_f32(yv[u][0][j]) * wg[u][0];
#pragma unroll
                for (int r = 1; r < 4; ++r) acc += fp8x4_to_f32(yv[u][r][j]) * wg[u][r];
                v[j] = (f32x4){bflo(xv[u][j].x), bfhi(xv[u][j].x), bflo(xv[u][j].y), bfhi(xv[u][j].y)} + gv[u][j] * acc; s += (v[j].x * v[j].x + v[j].y * v[j].y) + (v[j].z * v[j].z + v[j].w * v[j].w); }
            const float rstd = rsqrtf(wave_sum(s) * (1.f / D) + EPS);
            if (u == 0 || tk[1] != tk[0]) { f32x4* xo = (f32x4*)(out + (size_t)tk[u] * D) + lane;
#pragma unroll
                for (int j = 0; j < 4; ++j) xo[64 * j] = v[j] * rstd * fwv[j]; } }
    }
}

#ifndef MK_N_LAUNCHES
#define MK_N_LAUNCHES 1
#endif
constexpr int N_PHASES = 10;
#ifndef PROBE_TWICE
#define PROBE_TWICE -1
#endif
__global__ void __launch_bounds__(NTHR, 2) mk_fwd(Args args) {
    extern __shared__ __attribute__((aligned(16))) unsigned char lds_raw[];
    Frame F;
    F.lds = (LAS unsigned char*)lds_raw;
    F.tid = threadIdx.x; F.lane = F.tid & 63; F.wave = __builtin_amdgcn_readfirstlane(F.tid >> 6);
    F.G = gridDim.x; { const int bx = blockIdx.x; F.vcu = (F.G % 8 == 0) ? (bx % 8) * (F.G / 8) + bx / 8 : bx; }
    F.in = args.in; F.out = args.out; F.ws = args.ws;
    for (int u = F.tid; u < (LDS_BYTES - LDSCTL_OFF) / 4; u += NTHR) ((LAS unsigned*)(F.lds + LDSCTL_OFF))[u] = 0u;
    __syncthreads();
    const int lo = args.ph_lo, hi = args.ph_hi;
    XcdBarrier bar; bar.bar = (unsigned*)(F.ws + WS_CTL) + CW_BAR; bar.x = 0; bar.st = nullptr;
    if (hi - lo > 1) bar = xcd_barrier_post((unsigned*)(F.ws + WS_CTL) + CW_BAR, (volatile LAS unsigned*)(F.lds + LDSCTL_OFF) + LC_BAR);
#define IN(k) (lo <= (k) && (k) < hi)
#define SEAM(k) do { if (IN(k) && IN((k) + 1)) xcd_barrier(bar); } while (0)
    if (IN(0)) { p0_prologue(F, false); } SEAM(0);
    if (IN(1)) { p1_norm1(F); } SEAM(1);
    if (IN(2)) for (int rep_ = 0; rep_ < (PROBE_TWICE == 2 ? 2 : 1); ++rep_) { if (rep_) xcd_barrier(bar);
        pg8::SchedInProj S{F.G, (int)blockIdx.x};
        pg8::EpiInProj E{(bf16_t*)(F.ws + WS_KB), (bf16_t*)(F.ws + WS_VB), (bf16_t*)(F.ws + WS_QB), (bf16_t*)(F.ws + WS_GB), (bf16_t*)(F.ws + WS_PB), (float*)(F.ws + WS_RB)};
        pg8::gemm_phase<pg8::EpiInProj, pg8::SchedInProj, true, false>(F.lds, (const char*)(F.ws + WS_HN1), (const char*)(F.ws + WS_WIN), D * 2, S, E);
    } SEAM(2);
    if (IN(3)) {
        const int bx = blockIdx.x, nG = (F.G + 1) >> 1, nP = F.G - nG;
        constexpr int CVT_N = 2048 + 1024, CVT_ODD = 2432, CVT_ODD2 = CVT_ODD + 256;
        if ((bx & 1) == 0) { for (int u = bx >> 1; u < NB * 8; u += nG) gla_unit<0>(F, u);
#if PROBE_TWICE >= 380 && PROBE_TWICE < 390
                             for (int u = bx >> 1; u < NB * 8; u += nG) gla_unit<PROBE_TWICE - 380>(F, u);
#endif
                             cvt_expert_items_dma(F, CVT_ODD2 + (bx >> 1), nG, CVT_N); }
        else { for (int u = bx >> 1; u < NB * 64; u += nP) pool_unit(F, u);
#if PROBE_TWICE == 37
               for (int u = bx >> 1; u < NB * 64; u += nP) pool_unit(F, u);
#endif
               cvt_expert_items_dma(F, bx >> 1, nP, CVT_ODD);
               if ((bx >> 1) >= 64) cvt_expert_items_dma(F, CVT_ODD + (bx >> 1) - 64, 64, CVT_ODD2);
#if PROBE_TWICE == 36
               __syncthreads(); cvt_expert_items_dma(F, bx >> 1, nP, CVT_ODD);
#endif
               __syncthreads();
               for (int rep_ = 0; rep_ < (PROBE_TWICE == 35 ? 2 : 1); ++rep_)
               { pg8::SchedInProjG S{nP, bx >> 1};
                 pg8::EpiInProj E{(bf16_t*)(F.ws + WS_KB), (bf16_t*)(F.ws + WS_VB), (bf16_t*)(F.ws + WS_QB), (bf16_t*)(F.ws + WS_GB), (bf16_t*)(F.ws + WS_PB), (float*)(F.ws + WS_RB)};
                 pg8::gemm_phase<pg8::EpiInProj, pg8::SchedInProjG, true, false>(F.lds, (const char*)(F.ws + WS_HN1), (const char*)(F.ws + WS_WIN), D * 2, S, E); } }
    } SEAM(3);
    if (IN(4)) { p4_gla_out(F); } SEAM(4);
    if (IN(5)) {
        pg8::SchedPlain S{F.G, (int)blockIdx.x, NTOK / 256, D / 256};
        pg8::EpiResid E{F.in[IN_X], (const float*)(F.ws + WS_MOD), (bf16_t*)(F.ws + WS_H1B)};
        pg8::gemm_phase<pg8::EpiResid, pg8::SchedPlain, true, false>(F.lds, (const char*)(F.ws + WS_MIX), (const char*)(F.ws + WS_WOUT), D * 2, S, E);
    } SEAM(5);
    if (IN(6)) { p6_router<0>(F);
#if PROBE_TWICE == 6
                 __syncthreads(); p6_router<1>(F);
#endif
    } SEAM(6);
    const LAS int* TST = (const LAS int*)(F.lds + LDSCTL_OFF) + LC_TST; const LAS int* LCN = (const LAS int*)(F.lds + LDSCTL_OFF) + LC_CNT;
    if (IN(7)) {
        moe_tables(F);
        pg8::SchedMoE<8, true> S{F.G, (int)blockIdx.x, TST, LCN, (const int*)(F.ws + WS_LIST)};
        pg8::EpiSwiglu<true> E{(void*)(F.ws + WS_ACT), F.in[IN_BGU], 1.f / WSCALE};
        pg8::gemm_phase<pg8::EpiSwiglu<true>, pg8::SchedMoE<8, true>, true, true>(F.lds, (const char*)(F.ws + WS_HN2), (const char*)(F.ws + WS_WGU), D, S, E);
    } SEAM(7);
    if (IN(8)) {
        moe_tables(F);
        pg8::SchedMoE<4, false> S{F.G, (int)blockIdx.x, TST, LCN, nullptr};
        pg8::EpiDown E{(unsigned char*)(F.ws + WS_Y), F.in[IN_BDOWN], 1.f / WSCALE};
        pg8::gemm_phase<pg8::EpiDown, pg8::SchedMoE<4, false>, true, true>(F.lds, (const char*)(F.ws + WS_ACT), (const char*)(F.ws + WS_WD), DFF, S, E);
    } SEAM(8);
    if (IN(9)) { moe_tables(F); p9_final(F); }
#undef IN
#undef SEAM
}

extern "C" void kernel_launch(void* const* d_in, const int* in_sizes, int n_in, void* d_out, int out_size, void* d_ws, size_t ws_size, hipStream_t stream) {
    static int grid = 0;
    if (grid == 0) {
        if (n_in != 24 || ws_size < WS_END || out_size != NTOK * D) { fprintf(stderr, "kernel_launch: unexpected n_in %d / ws_size %zu / out %d\n", n_in, ws_size, out_size); grid = -1; return; }
        int dev = 0, cus = 0, per_cu = 0;
        if (hipGetDevice(&dev) != hipSuccess || hipDeviceGetAttribute(&cus, hipDeviceAttributeMultiprocessorCount, dev) != hipSuccess) { grid = -1; return; }
        if (hipFuncSetAttribute((const void*)mk_fwd, hipFuncAttributeMaxDynamicSharedMemorySize, LDS_BYTES) != hipSuccess) { fprintf(stderr, "kernel_launch: hipFuncSetAttribute failed\n"); grid = -1; return; }
        if (hipOccupancyMaxActiveBlocksPerMultiprocessor(&per_cu, (const void*)mk_fwd, NTHR, LDS_BYTES) != hipSuccess || per_cu < 1) { fprintf(stderr, "kernel_launch: occupancy query says %d workgroups per CU\n", per_cu); (void)hipGetLastError(); grid = -1; return; }
        (void)hipGetLastError();
        grid = cus;
    }
    if (grid < 0) return;
    (void)hipMemsetAsync((char*)d_ws + WS_CTL, 0, 1 * MiB, stream);
    Args a{};
    for (int i = 0; i < 24; ++i) a.in[i] = (const float*)d_in[i];
    a.out = (float*)d_out; a.ws = (unsigned char*)d_ws;
    if (MK_N_LAUNCHES == 1) {
        a.ph_lo = 0; a.ph_hi = N_PHASES;
        void* kargs[] = {&a};
        const hipError_t e = hipLaunchCooperativeKernel((const void*)mk_fwd, dim3(grid), dim3(NTHR), kargs, LDS_BYTES, stream);
        if (e != hipSuccess) fprintf(stderr, "kernel_launch: cooperative launch failed: %s (grid %d)\n", hipGetErrorString(e), grid);
    } else {
        for (int ph = 0; ph < N_PHASES; ++ph) { a.ph_lo = ph; a.ph_hi = ph + 1; hipLaunchKernelGGL(mk_fwd, dim3(grid), dim3(NTHR), LDS_BYTES, stream, a); }
    }
}
```

```cpp
#include <hip/hip_runtime.h>
#include <stdint.h>
#include <stdio.h>

#define LAS __attribute__((address_space(3)))
#define GAS __attribute__((address_space(1)))
typedef unsigned short bf16_t;
typedef short bf16x8 __attribute__((ext_vector_type(8)));
typedef float f32x4 __attribute__((ext_vector_type(4)));
typedef float f32x2 __attribute__((ext_vector_type(2)));
typedef float f32x16 __attribute__((ext_vector_type(16)));
typedef unsigned u32x4 __attribute__((ext_vector_type(4)));
typedef unsigned u32x2 __attribute__((ext_vector_type(2)));

constexpr int D = 1024, NB = 16, SEQ = 2048, CTX = 256;
constexpr int NTOK = NB * SEQ, NCTX = NB * CTX, NROW = NTOK + NCTX;
constexpr int DIN = 2080, NE = 32, DFF = 1024;
constexpr int GW = 64, GROWS = 32;
constexpr int NMOD = 6144;
constexpr float EPS = 1e-6f;
constexpr int NWAVES = 8, NTHR = 512;
constexpr int WIN_N = 2304;
constexpr int NPADROWS = NTOK * 4 + NE * 256;

__device__ __forceinline__ unsigned f2bf(float f) { unsigned u = __builtin_bit_cast(unsigned, f); return (u + 0x7fffu + ((u >> 16) & 1u)) >> 16; }
__device__ __forceinline__ unsigned pk2(float lo, float hi) { return f2bf(lo) | (f2bf(hi) << 16); }
__device__ __forceinline__ float bf2f(unsigned v) { return __builtin_bit_cast(float, v << 16); }
__device__ __forceinline__ float bflo(unsigned w) { return __builtin_bit_cast(float, w << 16); }
__device__ __forceinline__ float bfhi(unsigned w) { return __builtin_bit_cast(float, w & 0xffff0000u); }
__device__ __forceinline__ unsigned cvt_pk_bf16(float lo, float hi) { unsigned r; asm volatile("v_cvt_pk_bf16_f32 %0, %1, %2" : "=v"(r) : "v"(lo), "v"(hi)); return r; }
__device__ __forceinline__ float wave_sum(float v) {
#pragma unroll
    for (int o = 1; o < 64; o <<= 1) v += __shfl_xor(v, o);
    return v;
}
__device__ __forceinline__ float silu_f(float x) { return x / (1.f + __expf(-x)); }
__device__ __forceinline__ float logsigmoid_f(float x) { return fminf(x, 0.f) - log1pf(expf(-fabsf(x))); }
#define LDS_WAIT() asm volatile("s_waitcnt lgkmcnt(0)" ::: "memory")
#define VM_WAIT() asm volatile("s_waitcnt vmcnt(0)" ::: "memory")

namespace pg8 {
constexpr int BM = 256, BK = 64, HALF = 128, HTB = HALF * BK * 2  , STAGE_BYTES = 8 * HTB, NXCD = 8, WGM = 8;
__host__ __device__ __forceinline__ int lds_byte(int r, int c) { const int st = (r >> 4) * 2 + (c >> 5), rr = r & 15, cc = c & 31, ob = rr * 64 + cc * 2; return st * 1024 + (ob ^ (((ob >> 9) & 1) << 5)); }
__host__ __device__ __forceinline__ void stage_rc(int b, int& R, int& C) { const int st = b / 1024, sb = b % 1024, swz = sb ^ (((sb >> 9) & 1) << 5); R = (st >> 1) * 16 + swz / 64; C = (st & 1) * 32 + (swz % 64) / 2; }
__host__ __device__ __forceinline__ int perm32(int rho) { const int n = rho >> 4, i = rho & 15; return 8 * (i >> 2) + 4 * n + (i & 3); }

struct Unit { int pm, pn, arow, bt, nvalid, e; };

typedef int i32x8 __attribute__((ext_vector_type(8)));
typedef int i32x4v __attribute__((ext_vector_type(4)));
__device__ __forceinline__ i32x8 cat8(const bf16x8 a, const bf16x8 b) { const i32x4v x = __builtin_bit_cast(i32x4v, a), y = __builtin_bit_cast(i32x4v, b); return __builtin_shufflevector(x, y, 0, 1, 2, 3, 4, 5, 6, 7); }
__device__ __forceinline__ bf16x8 lo8(const i32x8 v) { return __builtin_bit_cast(bf16x8, (i32x4v)__builtin_shufflevector(v, v, 0, 1, 2, 3)); }
__device__ __forceinline__ bf16x8 hi8(const i32x8 v) { return __builtin_bit_cast(bf16x8, (i32x4v)__builtin_shufflevector(v, v, 4, 5, 6, 7)); }
template <class Epi, class Sched, bool ALIGN_EPI, bool FP8>
__device__ __forceinline__ void gemm_phase(LAS unsigned char* lds, const char* Abase, const char* Bbase, const int pitch, const Sched& S, const Epi& E) {
    const int tid = threadIdx.x, wid = __builtin_amdgcn_readfirstlane(tid >> 6), lane = tid & 63, wr = wid >> 2, wc = wid & 3, fr = lane & 15, fq = lane >> 4;
    const int nt = pitch / 128;
    unsigned voffB[2];
#pragma unroll
    for (int i = 0; i < 2; ++i) { int R, C; stage_rc(tid * 16 + i * 8192, R, C); const int Rb = (R & ~31) + perm32(R & 31);
        voffB[i] = (unsigned)(Rb * pitch) + (unsigned)C * 2u; }
    const size_t kstep = (size_t)(BK * 2);
    const size_t hstep = (size_t)HALF * pitch;
    const unsigned ldsw = (unsigned)wid * 1024u;
    const int aoff = lds_byte(wr * 64 + fr, fq * 8), boff = lds_byte(wc * 32 + fr, fq * 8);
#define PG8_SA(b, h) (((b) * 2 + (h)) * HTB)
#define PG8_SB(b, h) ((4 + (b) * 2 + (h)) * HTB)
#define PG8_STAGE_B(bufoff, gbase) do { _Pragma("unroll") for (int _i = 0; _i < 2; ++_i) \
        __builtin_amdgcn_global_load_lds((const unsigned*)((const char*)(gbase) + voffB[_i]), (LAS unsigned*)(lds + (bufoff) + ldsw + _i * 8192), 16, 0, 0); } while (0)
#define PG8_STAGE_A(bufoff, ao, kb) do { _Pragma("unroll") for (int _i = 0; _i < 2; ++_i) \
        __builtin_amdgcn_global_load_lds((const unsigned*)(Abase + (size_t)(ao)[_i] + (size_t)(kb)), (LAS unsigned*)(lds + (bufoff) + ldsw + _i * 8192), 16, 0, 0); } while (0)
#define PG8_LDA(dst, b, h) do { _Pragma("unroll") for (int m = 0; m < 4; ++m) dst[m] = cat8(*(const LAS bf16x8*)(lds + PG8_SA(b, h) + aoff + m * 2048), *(const LAS bf16x8*)(lds + PG8_SA(b, h) + aoff + m * 2048 + 1024)); } while (0)
#define PG8_LDB(dst, b, h) do { _Pragma("unroll") for (int n = 0; n < 2; ++n) dst[n] = cat8(*(const LAS bf16x8*)(lds + PG8_SB(b, h) + boff + n * 2048), *(const LAS bf16x8*)(lds + PG8_SB(b, h) + boff + n * 2048 + 1024)); } while (0)
#define PG8_MMA(ai, bj, At, Bt) do { __builtin_amdgcn_s_setprio(1); _Pragma("unroll") for (int m = 0; m < 4; ++m) _Pragma("unroll") for (int n = 0; n < 2; ++n) { \
        if constexpr (FP8) { acc[ai][bj][m][n] = __builtin_amdgcn_mfma_scale_f32_16x16x128_f8f6f4(Bt[n], At[m], acc[ai][bj][m][n], 0, 0, 0, 0x7f7f7f7f, 0, 0x7f7f7f7f); } \
        else { acc[ai][bj][m][n] = __builtin_amdgcn_mfma_f32_16x16x32_bf16(lo8(Bt[n]), lo8(At[m]), acc[ai][bj][m][n], 0, 0, 0); \
               acc[ai][bj][m][n] = __builtin_amdgcn_mfma_f32_16x16x32_bf16(hi8(Bt[n]), hi8(At[m]), acc[ai][bj][m][n], 0, 0, 0); } } \
        __builtin_amdgcn_s_setprio(0); } while (0)
#define PG8_WAIT_V(n) asm volatile("s_waitcnt vmcnt(" #n ")" ::: "memory")
#define PG8_WAIT_L(n) asm volatile("s_waitcnt lgkmcnt(" #n ")" ::: "memory")
#define PG8_BAR __builtin_amdgcn_s_barrier()
#define PG8_SCHED __builtin_amdgcn_sched_barrier(0)
    Unit cur, nxt; int ui = 0;
    if (!S.next(0, cur)) return;
    f32x4 acc[2][2][4][2];
#pragma unroll
    for (int a = 0; a < 2; ++a)
#pragma unroll
        for (int b = 0; b < 2; ++b)
#pragma unroll
            for (int m = 0; m < 4; ++m)
#pragma unroll
                for (int n = 0; n < 2; ++n) acc[a][b][m][n] = (f32x4){0.f, 0.f, 0.f, 0.f};
    i32x8 At[4], B0[2], B1[2];
    unsigned aoc[2][2];
    LAS u32x4* nxslot = (LAS u32x4*)(lds + STAGE_BYTES) + tid;
#pragma unroll
    for (int h = 0; h < 2; ++h)
#pragma unroll
        for (int i = 0; i < 2; ++i) { int R2, C2; stage_rc(tid * 16 + i * 8192, R2, C2); aoc[h][i] = S.arow(cur, h * HALF + R2) * (unsigned)pitch + (unsigned)C2 * 2u; }
    const char* cB = Bbase + (size_t)cur.bt * pitch;
    PG8_STAGE_B(PG8_SB(0, 0), cB); PG8_STAGE_B(PG8_SB(0, 1), cB + hstep); PG8_STAGE_A(PG8_SA(0, 0), aoc[0], 0); PG8_STAGE_A(PG8_SA(0, 1), aoc[1], 0);
    if (wr == 1) PG8_BAR;
    PG8_WAIT_V(2); PG8_BAR;
    PG8_STAGE_B(PG8_SB(1, 0), cB + kstep); PG8_STAGE_A(PG8_SA(1, 0), aoc[0], kstep); PG8_STAGE_B(PG8_SB(1, 1), cB + hstep + kstep);
    PG8_WAIT_V(6); PG8_BAR;
    for (;;) {
        const bool has_next = S.next(ui + 1, nxt);
        int tq = tid; asm volatile("" : "+v"(tq));
        { unsigned nx4[4];
#pragma unroll
          for (int h = 0; h < 2; ++h)
#pragma unroll
              for (int i = 0; i < 2; ++i) { int R2, C2; stage_rc(tq * 16 + i * 8192, R2, C2); nx4[h * 2 + i] = has_next ? S.arow(nxt, h * HALF + R2) * (unsigned)pitch + (unsigned)C2 * 2u : aoc[h][i]; }
          *nxslot = (u32x4){nx4[0], nx4[1], nx4[2], nx4[3]}; }
        const char* nB = has_next ? Bbase + (size_t)nxt.bt * pitch : cB;
#pragma nounroll
        for (int t = 0; t < nt; t += 2) {
            const bool last = (t == nt - 2);
            const size_t k1 = (size_t)(t + 1) * kstep;
            const size_t k2 = last ? (size_t)0 : (size_t)(t + 2) * kstep, k3 = k2 + kstep;
            const char* b2 = last ? nB : cB + (size_t)(t + 2) * kstep; const char* b3 = b2 + kstep;
            PG8_LDB(B0, 0, 0); PG8_LDB(B1, 0, 1); PG8_SCHED; PG8_LDA(At, 0, 0); PG8_STAGE_A(PG8_SA(1, 1), aoc[1], k1);
            if (last) { const u32x4 nx = *nxslot; aoc[0][0] = nx.x; aoc[0][1] = nx.y; aoc[1][0] = nx.z; aoc[1][1] = nx.w; }
            PG8_WAIT_V(8); PG8_WAIT_L(0); PG8_BAR; PG8_MMA(0, 0, At, B0); PG8_MMA(0, 1, At, B1); PG8_BAR; PG8_SCHED;
            PG8_LDA(At, 0, 1); PG8_STAGE_B(PG8_SB(0, 0), b2); PG8_STAGE_B(PG8_SB(0, 1), b2 + hstep); PG8_STAGE_A(PG8_SA(0, 0), aoc[0], k2);
            PG8_WAIT_V(8); PG8_WAIT_L(0); PG8_BAR; PG8_MMA(1, 0, At, B0); PG8_MMA(1, 1, At, B1); PG8_BAR; PG8_SCHED;
            PG8_LDB(B0, 1, 0); PG8_LDB(B1, 1, 1); PG8_SCHED; PG8_LDA(At, 1, 0); PG8_STAGE_A(PG8_SA(0, 1), aoc[1], k2);
            PG8_WAIT_V(8); PG8_WAIT_L(0); PG8_BAR; PG8_MMA(0, 0, At, B0); PG8_MMA(0, 1, At, B1); PG8_BAR; PG8_SCHED;
            PG8_LDA(At, 1, 1); PG8_STAGE_B(PG8_SB(1, 0), b3); PG8_STAGE_B(PG8_SB(1, 1), b3 + hstep); PG8_STAGE_A(PG8_SA(1, 0), aoc[0], k3);
            PG8_WAIT_V(8); PG8_WAIT_L(0); PG8_BAR; PG8_MMA(1, 0, At, B0); PG8_MMA(1, 1, At, B1); PG8_BAR; PG8_SCHED;
        }
        if constexpr (ALIGN_EPI) { if (wr == 0) PG8_BAR; }
        E(acc, cur, wr, wc, fr, fq);
        if (!has_next) break;
#pragma unroll
        for (int a = 0; a < 2; ++a)
#pragma unroll
            for (int b = 0; b < 2; ++b)
#pragma unroll
                for (int m = 0; m < 4; ++m)
#pragma unroll
                    for (int n = 0; n < 2; ++n) acc[a][b][m][n] = (f32x4){0.f, 0.f, 0.f, 0.f};
        cur = nxt; cB = nB; ++ui;
        if constexpr (ALIGN_EPI) { if (wr == 1) PG8_BAR; }
    }
    PG8_WAIT_V(0);
    if constexpr (!ALIGN_EPI) { if (wr == 0) PG8_BAR; }
    PG8_BAR;
#undef PG8_SA
#undef PG8_SB
#undef PG8_STAGE_A
#undef PG8_STAGE_B
#undef PG8_LDA
#undef PG8_LDB
#undef PG8_MMA
#undef PG8_WAIT_V
#undef PG8_WAIT_L
#undef PG8_BAR
#undef PG8_SCHED
}

__device__ __forceinline__ int xcd_remap(int L, int nwg) { const int q = nwg / NXCD, r = nwg % NXCD, xcd = L % NXCD, off = L / NXCD; return (xcd < r ? xcd * (q + 1) : r * (q + 1) + (xcd - r) * q) + off; }

constexpr int NG2 = 64;
struct SchedInProj {
    int G, c;
    __device__ __forceinline__ bool next(int i, Unit& u) const {
        constexpr int NLAT = 128 * 7, NCTX = 16 * 4, NWG = NLAT + NCTX + NG2;
        const int L = i * G + c; if (L >= NWG) return false;
        const int wgid = xcd_remap(L, NWG); int pm, pn;
        if (wgid < NLAT) { const int nig = WGM * 7, gid = wgid / nig, j = (wgid % nig) / WGM; pm = gid * WGM + (wgid % nig) % WGM; pn = j < 5 ? j : j + 2; }
        else if (wgid < NLAT + NCTX) { const int w = wgid - NLAT, nig = WGM * 4, gid = w / nig; pm = 128 + gid * WGM + (w % nig) % WGM; pn = (w % nig) / WGM; }
        else { const int w = wgid - NLAT - NCTX; pm = w >> 1; pn = 5 + (w & 1); }
        u.pm = pm; u.pn = pn; u.arow = pm * BM; u.bt = pn * BM; u.nvalid = BM; u.e = 0; return true;
    }
    __device__ __forceinline__ unsigned arow(const Unit& u, int rloc) const { return (unsigned)(u.arow + rloc); }
};
struct SchedInProjG {
    int nwg, c;
    __device__ __forceinline__ bool next(int i, Unit& u) const {
        const int L = NG2 + i * nwg + c; if (L >= 256) return false;
        u.pm = L >> 1; u.pn = 5 + (L & 1); u.arow = u.pm * BM; u.bt = u.pn * BM; u.nvalid = BM; u.e = 0; return true;
    }
    __device__ __forceinline__ unsigned arow(const Unit& u, int rloc) const { return (unsigned)(u.arow + rloc); }
};
struct SchedPlain {
    int G, c, nM, nN;
    __device__ __forceinline__ bool next(int i, Unit& u) const {
        const int nwg = nM * nN, L = i * G + c; if (L >= nwg) return false;
        const int wgid = xcd_remap(L, nwg), nig = WGM * nN, gid = wgid / nig, fm = gid * WGM, gsz = (nM - fm) < WGM ? (nM - fm) : WGM;
        u.pm = fm + ((wgid % nig) % gsz); u.pn = (wgid % nig) / gsz; u.arow = u.pm * BM; u.bt = u.pn * BM; u.nvalid = BM; u.e = 0; return true;
    }
    __device__ __forceinline__ unsigned arow(const Unit& u, int rloc) const { return (unsigned)(u.arow + rloc); }
};
template <int NT, bool GATHER>
struct SchedMoE {
    int G, c; const LAS int* tst; const LAS int* cnt; const int* list;
    __device__ __forceinline__ bool next(int i, Unit& u) const {
        const int nwg = tst[NE] * NT, L = i * G + c; if (L >= nwg) return false;
        const int wgid = xcd_remap(L, nwg);
        int e = 0;
#pragma unroll
        for (int s = 16; s >= 1; s >>= 1) { if (tst[e + s] * NT <= wgid) e += s; }
        const int t0 = tst[e], mt = tst[e + 1] - t0, w = wgid - t0 * NT, nig = WGM * NT, gid = w / nig, fm = gid * WGM, gsz = (mt - fm) < WGM ? (mt - fm) : WGM;
        const int m = fm + ((w % nig) % gsz), n = (w % nig) / gsz;
        u.pm = t0 + m; u.pn = n; u.e = e; u.bt = (e * NT + n) * BM;
        if (GATHER) { u.arow = e * NTOK + m * BM; const int left = cnt[e] - m * BM; u.nvalid = left < BM ? left : BM; }
        else { u.arow = u.pm * BM; u.nvalid = BM; }
        return true;
    }
    __device__ __forceinline__ unsigned arow(const Unit& u, int rloc) const {
        if (GATHER) { const int tok = (rloc < u.nvalid) ? (list[u.arow + rloc] >> 2) : 0; return (unsigned)tok; }
        return (unsigned)(u.arow + rloc);
    }
};

struct EpiInProj {
    bf16_t *KB, *VB, *QB, *GB, *PB; float* RB;
    __device__ __forceinline__ void operator()(const f32x4 (&acc)[2][2][4][2], const Unit& u, int wr, int wc, int fr, int fq) const {
        const int pn = u.pn, row0 = u.pm * BM + wr * 64 + fr;
        if (pn == 3) {
            if (wc != 0) return;
#pragma unroll
            for (int ai = 0; ai < 2; ++ai)
#pragma unroll
                for (int m = 0; m < 4; ++m) { float* rp = RB + (size_t)(row0 + ai * HALF + m * 16) * 32 + 8 * fq;
                    *(f32x4*)rp = acc[ai][0][m][0]; *(f32x4*)(rp + 4) = acc[ai][0][m][1]; }
            return;
        }
        if (pn >= 7) {
#pragma unroll
            for (int ai = 0; ai < 2; ++ai)
#pragma unroll
                for (int m = 0; m < 4; ++m) { const int row = row0 + ai * HALF + m * 16, b = row >> 11, t = row & 2047;
#pragma unroll
                    for (int bj = 0; bj < 2; ++bj) { const int g = (pn - 7) * 2 + bj, cblk = wc * 4 + fq;
                        const f32x4 v0 = acc[ai][bj][m][0], v1 = acc[ai][bj][m][1]; u32x4 w; w.x = cvt_pk_bf16(v0[0], v0[1]); w.y = cvt_pk_bf16(v0[2], v0[3]); w.z = cvt_pk_bf16(v1[0], v1[1]); w.w = cvt_pk_bf16(v1[2], v1[3]);
                        *(u32x4*)(PB + ((((size_t)(b * 4 + g) * 16 + cblk) * 2048 + t) * 8)) = w; } }
            return;
        }
        bf16_t* base; int ldc, coff;
        if (pn == 0) { base = KB; ldc = 256; coff = 0; } else if (pn <= 2) { base = VB; ldc = 512; coff = (pn - 1) * 256; }
        else if (pn == 4) { base = QB; ldc = 256; coff = 0; } else { base = GB; ldc = 512; coff = (pn - 5) * 256; }
        const int col0 = coff + wc * 32 + 8 * fq;
#pragma unroll
        for (int ai = 0; ai < 2; ++ai)
#pragma unroll
            for (int m = 0; m < 4; ++m) { bf16_t* rowp = base + (size_t)(row0 + ai * HALF + m * 16) * ldc + col0;
#pragma unroll
                for (int bj = 0; bj < 2; ++bj) { const f32x4 v0 = acc[ai][bj][m][0], v1 = acc[ai][bj][m][1];
                    u32x4 w; w.x = cvt_pk_bf16(v0[0], v0[1]); w.y = cvt_pk_bf16(v0[2], v0[3]); w.z = cvt_pk_bf16(v1[0], v1[1]); w.w = cvt_pk_bf16(v1[2], v1[3]);
                    *(u32x4*)(rowp + bj * HALF) = w; } }
    }
};
typedef __bf16 bf16x2v __attribute__((ext_vector_type(2)));
__device__ __forceinline__ unsigned pk2n(float lo, float hi) { f32x2 v = {lo, hi}; return __builtin_bit_cast(unsigned, __builtin_convertvector(v, bf16x2v)); }
struct EpiResid {
    const float* x; const float* mod; bf16_t* out;
    __device__ __forceinline__ void operator()(const f32x4 (&acc)[2][2][4][2], const Unit& u, int wr, int wc, int fr, int fq) const {
        const int row0 = u.pm * BM + wr * 64 + fr, col0 = u.pn * BM + wc * 32 + 8 * fq;
        const float* g1 = mod + (size_t)(row0 >> 11) * NMOD + 2048 + col0;
        f32x4 gv[2][2];
#pragma unroll
        for (int bj = 0; bj < 2; ++bj)
#pragma unroll
            for (int n = 0; n < 2; ++n) gv[bj][n] = *(const f32x4*)(g1 + bj * HALF + 4 * n);
        f32x4 xa[2][2], xb[2][2];
#define RES_LOAD(dst, g_) do { const size_t _o = (size_t)(row0 + ((g_) >> 2) * HALF + ((g_) & 3) * 16) * D + col0; \
            _Pragma("unroll") for (int bj = 0; bj < 2; ++bj) _Pragma("unroll") for (int n = 0; n < 2; ++n) dst[bj][n] = *(const f32x4*)(x + _o + bj * HALF + 4 * n); } while (0)
#define RES_STORE(src, g_) do { const size_t _o = (size_t)(row0 + ((g_) >> 2) * HALF + ((g_) & 3) * 16) * D + col0; \
            _Pragma("unroll") for (int bj = 0; bj < 2; ++bj) { const f32x4 _a = src[bj][0] + gv[bj][0] * acc[(g_) >> 2][bj][(g_) & 3][0], _b = src[bj][1] + gv[bj][1] * acc[(g_) >> 2][bj][(g_) & 3][1]; \
                u32x4 _w; _w.x = pk2n(_a.x, _a.y); _w.y = pk2n(_a.z, _a.w); _w.z = pk2n(_b.x, _b.y); _w.w = pk2n(_b.z, _b.w); *(u32x4*)(out + _o + bj * HALF) = _w; } } while (0)
        RES_LOAD(xa, 0);
#pragma unroll
        for (int g2 = 0; g2 < 8; g2 += 2) { RES_LOAD(xb, g2 + 1); RES_STORE(xa, g2); if (g2 + 2 < 8) RES_LOAD(xa, g2 + 2); RES_STORE(xb, g2 + 1); }
#undef RES_LOAD
#undef RES_STORE
    }
};
__device__ __forceinline__ unsigned pk4_fp8(float a, float b, float c, float d) { int w = 0; w = __builtin_amdgcn_cvt_pk_fp8_f32(a, b, w, false); w = __builtin_amdgcn_cvt_pk_fp8_f32(c, d, w, true); return (unsigned)w; }
template <bool FP8>
struct EpiSwiglu {
    void* act; const float* bgu; float ascale;
    __device__ __forceinline__ void operator()(const f32x4 (&acc)[2][2][4][2], const Unit& u, int wr, int wc, int fr, int fq) const {
        const int row0 = u.pm * BM + wr * 64 + fr, cc = u.pn * HALF + wc * 32 + 8 * fq;
        const float* bg = bgu + (size_t)u.e * 2048 + cc;
        f32x4 bgv[2], buv[2];
#pragma unroll
        for (int n = 0; n < 2; ++n) { bgv[n] = *(const f32x4*)(bg + 4 * n); buv[n] = *(const f32x4*)(bg + 1024 + 4 * n); }
#pragma unroll
        for (int ai = 0; ai < 2; ++ai)
#pragma unroll
            for (int m = 0; m < 4; ++m) { float r[8];
#pragma unroll
                for (int n = 0; n < 2; ++n) { const f32x4 gq = acc[ai][0][m][n] * ascale + bgv[n], uq = acc[ai][1][m][n] * ascale + buv[n];
#pragma unroll
                    for (int j = 0; j < 4; j += 2) { f32x2 gt = {fminf(gq[j], 7.f), fminf(gq[j + 1], 7.f)};
                        f32x2 up1 = {fminf(fmaxf(uq[j], -7.f), 7.f), fminf(fmaxf(uq[j + 1], -7.f), 7.f)}; up1 = up1 + 1.f;
                        const f32x2 z = gt * (-1.702f * 1.44269504089f);
                        f32x2 d = {__builtin_amdgcn_exp2f(z.x), __builtin_amdgcn_exp2f(z.y)}; d = d + 1.f;
                        const f32x2 rc = {__builtin_amdgcn_rcpf(d.x), __builtin_amdgcn_rcpf(d.y)};
                        const f32x2 o = (up1 * gt) * rc; r[4 * n + j] = o.x; r[4 * n + j + 1] = o.y; } }
                if constexpr (FP8) { u32x2 w; w.x = pk4_fp8(r[0], r[1], r[2], r[3]); w.y = pk4_fp8(r[4], r[5], r[6], r[7]);
                    *(u32x2*)((unsigned char*)act + (size_t)(row0 + ai * HALF + m * 16) * DFF + cc) = w; }
                else { u32x4 w; w.x = cvt_pk_bf16(r[0], r[1]); w.y = cvt_pk_bf16(r[2], r[3]); w.z = cvt_pk_bf16(r[4], r[5]); w.w = cvt_pk_bf16(r[6], r[7]);
                    *(u32x4*)((bf16_t*)act + (size_t)(row0 + ai * HALF + m * 16) * DFF + cc) = w; } }
    }
};
struct EpiDown {
    unsigned char* y; const float* bd; float ascale;
    __device__ __forceinline__ void operator()(const f32x4 (&acc)[2][2][4][2], const Unit& u, int wr, int wc, int fr, int fq) const {
        const int row0 = u.pm * BM + wr * 64 + fr, col0 = u.pn * BM + wc * 32 + 8 * fq;
        const float* bp = bd + (size_t)u.e * D + col0;
        f32x4 bv[2][2];
#pragma unroll
        for (int bj = 0; bj < 2; ++bj)
#pragma unroll
            for (int n = 0; n < 2; ++n) bv[bj][n] = *(const f32x4*)(bp + bj * HALF + 4 * n);
#pragma unroll
        for (int ai = 0; ai < 2; ++ai)
#pragma unroll
            for (int m = 0; m < 4; ++m) { unsigned char* rowp = y + (size_t)(row0 + ai * HALF + m * 16) * D + col0;
#pragma unroll
                for (int bj = 0; bj < 2; ++bj) { const f32x4 v0 = acc[ai][bj][m][0] * ascale + bv[bj][0], v1 = acc[ai][bj][m][1] * ascale + bv[bj][1];
                    u32x2 w; w.x = pk4_fp8(v0[0], v0[1], v0[2], v0[3]); w.y = pk4_fp8(v1[0], v1[1], v1[2], v1[3]);
                    *(u32x2*)(rowp + bj * HALF) = w; } }
    }
};
}

constexpr size_t MiB = 1u << 20;
constexpr size_t WS_CTL = 0, WS_MOD = 1 * MiB, WS_TOPW = 2 * MiB, WS_ASG = 3 * MiB, WS_WRT = 3 * MiB + 512 * 1024, WS_LIST = 4 * MiB, WS_WIN = 8 * MiB, WS_WOUT = 13 * MiB,
                 WS_WGU = 16 * MiB, WS_WD = 80 * MiB, WS_HN1 = 112 * MiB, WS_HN2 = 112 * MiB,
                 WS_KB = 184 * MiB, WS_VB = 202 * MiB, WS_RB = 238 * MiB, WS_QB = 243 * MiB, WS_GB = 259 * MiB, WS_PB = 291 * MiB,
                 WS_OF = 323 * MiB, WS_OB = 387 * MiB, WS_MIX = 451 * MiB, WS_ACT = 184 * MiB, WS_Y = 515 * MiB, WS_H1B = 660 * MiB, WS_END = 787 * MiB;
static_assert(WS_ACT + (size_t)NPADROWS * DFF <= WS_Y && WS_Y + (size_t)NPADROWS * D <= WS_H1B && WS_H1B + (size_t)NTOK * D * 2 <= WS_END, "ws map");


constexpr int CW_CNT = 0;
constexpr int CW_BAR = 4096;

constexpr int RING_BYTES = 131072;
constexpr int LDSCTL_OFF = 155648;
constexpr int LDS_BYTES = 163840;
constexpr int LC_BAR = 0, LC_TST = 16, LC_CNT = 64;

#define XB_TMO      128
#define XB_XCNT(j)  (256  + 64 * (j))
#define XB_XSUB(j)  (1280 + 64 * (j))
#define XB_XGEN(j)  (2304 + 64 * (j))
#define XB_TOP      3328
#define XB_TOPGEN   3392
#define XCD_BAR_WORDS 3456
#define XB_SPIN_CAP (1u << 18)
__device__ __forceinline__ unsigned xb_ld(unsigned* p)              { return __hip_atomic_load(p, __ATOMIC_RELAXED, __HIP_MEMORY_SCOPE_AGENT); }
__device__ __forceinline__ unsigned xb_add(unsigned* p, unsigned v) { return __hip_atomic_fetch_add(p, v, __ATOMIC_RELAXED, __HIP_MEMORY_SCOPE_AGENT); }
__device__ __forceinline__ unsigned xb_xcc_id() { return (unsigned)__builtin_amdgcn_s_getreg((3 << 11) | 20) & 0xFu; }
#define XB_SPIN(cond, bar) do { unsigned _sp = 0; while (cond) { __builtin_amdgcn_s_sleep(1); \
    if ((++_sp & 255u) == 0u) { if (xb_ld(&(bar)[XB_TMO])) break; if (_sp > XB_SPIN_CAP) { atomicAdd(&(bar)[XB_TMO], 1u); break; } } } } while (0)
struct XcdBarrier { unsigned* bar; unsigned x; volatile LAS unsigned* st; };
__device__ __forceinline__ XcdBarrier xcd_barrier_post(unsigned* bar, volatile LAS unsigned* st) {
    XcdBarrier b; b.bar = bar; b.x = xb_xcc_id(); b.st = st;
    if (threadIdx.x == 0) (void)xb_add(&bar[XB_XCNT(b.x)], 1u);
    return b;
}
__device__ __forceinline__ void xcd_barrier_complete(unsigned* bar, unsigned x, unsigned& nloc, unsigned& nx) {
    const unsigned G = gridDim.x * gridDim.y * gridDim.z;
    unsigned sum, cnt, mine, sp = 0u;
    for (;;) {
        sum = 0u; cnt = 0u; mine = 0u;
#pragma unroll
        for (unsigned j = 0; j < 16; ++j) { const unsigned c = xb_ld(&bar[XB_XCNT(j)]); sum += c; cnt += (c > 0u) ? 1u : 0u; mine = (j == x) ? c : mine; }
        if (sum == G) break;
        __builtin_amdgcn_s_sleep(1);
        if ((++sp & 255u) == 0u) { if (xb_ld(&bar[XB_TMO])) break; if (sp > XB_SPIN_CAP) { atomicAdd(&bar[XB_TMO], 1u); break; } }
    }
    nloc = mine > 0u ? mine : 1u; nx = cnt > 0u ? cnt : 1u;
}
__device__ __forceinline__ void xcd_barrier(const XcdBarrier& b) {
    asm volatile("s_waitcnt vmcnt(0)" ::: "memory");
    __syncthreads();
    if (threadIdx.x == 0) {
        unsigned* bar = b.bar;
        __builtin_amdgcn_s_waitcnt(0);
        unsigned nloc = b.st[0], nx = b.st[1];
        if (nloc == 0u) { xcd_barrier_complete(bar, b.x, nloc, nx); b.st[0] = nloc; b.st[1] = nx; }
        const unsigned old = xb_add(&bar[XB_XSUB(b.x)], 1u);
        const unsigned gen = old / nloc;
        if (old + 1u == (gen + 1u) * nloc) {
            __builtin_amdgcn_fence(__ATOMIC_RELEASE, "agent");
            asm volatile("s_waitcnt vmcnt(0)" ::: "memory");
            const unsigned og = xb_add(&bar[XB_TOP], 1u);
            const unsigned tg = og / nx;
            if (og + 1u == (tg + 1u) * nx) xb_add(&bar[XB_TOPGEN], 1u);
            else XB_SPIN(xb_ld(&bar[XB_TOPGEN]) == tg, bar);
            __builtin_amdgcn_fence(__ATOMIC_ACQUIRE, "agent");
            xb_add(&bar[XB_XGEN(b.x)], 1u);
            asm volatile("s_waitcnt vmcnt(0)" ::: "memory");
        } else {
            XB_SPIN(xb_ld(&bar[XB_XGEN(b.x)]) == gen, bar);
            __builtin_amdgcn_fence(__ATOMIC_ACQUIRE, "agent");
            asm volatile("s_waitcnt vmcnt(0)" ::: "memory");
        }
    }
    __syncthreads();
}

struct Args { const float* in[24]; float* out; unsigned char* ws; int ph_lo, ph_hi; };
struct Frame {
    LAS unsigned char* lds;
    int tid, lane, wave, vcu, G;
    const float* const* in; float* out; unsigned char* ws;
};
#define IN_X 0
#define IN_C 1
#define IN_CTX 2
#define IN_CCTX 3
#define IN_WADA 4
#define IN_BADA 5
#define IN_NMIX 6
#define IN_NMLP 7
#define IN_WIN 8
#define IN_WGKF 9
#define IN_BGKF 10
#define IN_WGKB 11
#define IN_BGKB 12
#define IN_GLANW 13
#define IN_WPOOL 14
#define IN_PSCALE 15
#define IN_WOUT 16
#define IN_WROUTER 17
#define IN_BROUTER 18
#define IN_WGU 19
#define IN_BGU 20
#define IN_WDOWN 21
#define IN_BDOWN 22
#define IN_FNW 23

__device__ __forceinline__ void p0_transpose_item(const float* W, int ldw, int k0, int n0, bf16_t* WT, int ldd, int drow, int dk0, LAS float* scr, int lane) {
#pragma unroll 8
    for (int i = 0; i < 32; ++i) { const int kk = 2 * i + (lane >> 5); scr[kk * 33 + (lane & 31)] = W[(size_t)(k0 + kk) * ldw + n0 + (lane & 31)]; }
    LDS_WAIT(); asm volatile("" ::: "memory");
    const int c = lane & 7;
#pragma unroll
    for (int j = 0; j < 4; ++j) { const int n = (lane >> 3) + 8 * j; const LAS float* s = scr + (8 * c) * 33 + n;
        u32x4 o; o.x = pk2(s[0 * 33], s[1 * 33]); o.y = pk2(s[2 * 33], s[3 * 33]); o.z = pk2(s[4 * 33], s[5 * 33]); o.w = pk2(s[6 * 33], s[7 * 33]);
        *(u32x4*)(WT + (size_t)(drow + n) * ldd + dk0 + k0 + 8 * c) = o; }
    LDS_WAIT(); asm volatile("" ::: "memory");
}
__device__ __forceinline__ int win_drow(int n0) {
    if (n0 < 256) return 4 * 256 + n0;
    if (n0 < 512) return n0 - 256;
    if (n0 < 1024) return 256 + (n0 - 512);
    if (n0 < 1536) return 5 * 256 + (n0 - 1024);
    if (n0 < 1568) return 3 * 256 + (n0 - 1536);
    return 7 * 256 + (n0 - 1568);
}
__device__ __forceinline__ void p0_mod_item(Frame& F, int item, const LAS float* SL, float* mod) {
    const float* w_ada = F.in[IN_WADA]; const float* b_ada = F.in[IN_BADA];
    const int j = item * 8 + (F.lane & 7), kp = F.lane >> 3;
    float acc[17];
#pragma unroll
    for (int r = 0; r < 17; ++r) acc[r] = 0.f;
#pragma unroll 4
    for (int i = 0; i < 128; ++i) { const int k = kp + 8 * i; const float w = w_ada[(size_t)k * NMOD + j];
#pragma unroll
        for (int r = 0; r < 17; ++r) acc[r] += SL[r * 1024 + k] * w; }
#pragma unroll
    for (int r = 0; r < 17; ++r) { float a = acc[r]; a += __shfl_xor(a, 8); a += __shfl_xor(a, 16); a += __shfl_xor(a, 32); if (kp == 0) mod[r * NMOD + j] = a + b_ada[j]; }
}
__device__ __forceinline__ void p0_weff_item(Frame& F, int item, LAS float* scr, bf16_t* Wout_t) {
    const float* w_pool = F.in[IN_WPOOL]; const float* pscale = F.in[IN_PSCALE]; const float* w_out = F.in[IN_WOUT];
    const int g = item >> 6, n0 = (item & 63) * 16, lane = F.lane;
#pragma unroll 4
    for (int q = 0; q < 32; ++q) { const int idx = lane + 64 * q, j = idx >> 4, nn = idx & 15; scr[idx] = w_out[(size_t)(512 + g * 128 + j) * D + n0 + nn] * pscale[g * 128 + j]; }
    LDS_WAIT(); asm volatile("" ::: "memory");
    float a0[16], a1[16];
#pragma unroll
    for (int nn = 0; nn < 16; ++nn) { a0[nn] = 0.f; a1[nn] = 0.f; }
    const float* wp0 = w_pool + (size_t)(g * 128 + lane) * 128; const float* wp1 = wp0 + 64 * 128;
    for (int j = 0; j < 128; ++j) { const float p0 = wp0[j], p1 = wp1[j];
#pragma unroll
        for (int q = 0; q < 4; ++q) { const f32x4 t = *(const LAS f32x4*)(scr + j * 16 + 4 * q);
#pragma unroll
            for (int z = 0; z < 4; ++z) { a0[4 * q + z] += p0 * t[z]; a1[4 * q + z] += p1 * t[z]; } } }
#pragma unroll
    for (int nn = 0; nn < 16; ++nn) { bf16_t* o = Wout_t + (size_t)(n0 + nn) * D + 512 + g * 128 + lane; o[0] = (bf16_t)f2bf(a0[nn]); o[64] = (bf16_t)f2bf(a1[nn]); }
    LDS_WAIT(); asm volatile("" ::: "memory");
}
constexpr int P0_CVT_E = 0;
constexpr float WSCALE = 32.f;
constexpr int CVP = 260;
__device__ __forceinline__ unsigned pk4_fp8s(float a, float b, float c, float d) { int w = 0; w = __builtin_amdgcn_cvt_pk_fp8_f32(a * WSCALE, b * WSCALE, w, false); w = __builtin_amdgcn_cvt_pk_fp8_f32(c * WSCALE, d * WSCALE, w, true); return (unsigned)w; }
struct CvtItem { const float* src; int ldw, k0, n0, e; bool gu; };
__device__ __forceinline__ CvtItem cvt_decode(Frame& F, int item) {
    CvtItem c;
    if (item < 2048) { c.gu = true; c.e = item >> 6; c.k0 = ((item >> 3) & 7) * 128; c.n0 = (item & 7) * 256; c.src = F.in[IN_WGU] + (size_t)c.e * D * 2048; c.ldw = 2048; }
    else { const int r = item - 2048 + P0_CVT_E * 32; c.gu = false; c.e = r >> 5; c.k0 = ((r >> 2) & 7) * 128; c.n0 = (r & 3) * 256; c.src = F.in[IN_WDOWN] + (size_t)c.e * DFF * D; c.ldw = D; }
    return c;
}
template <int MODE>
__device__ __forceinline__ void cvt_expert_items(Frame& F, int first, int stride, int nitems) {
    if (first >= nitems) return;
    LAS float* T = (LAS float*)F.lds;
    int tid = F.tid; asm volatile("" : "+v"(tid));
    f32x4 R[16];
    { const CvtItem c = cvt_decode(F, first);
#pragma unroll
      for (int i = 0; i < 16; ++i) { const int idx = tid + NTHR * i, kk = idx >> 6, n4 = idx & 63; R[i] = __builtin_nontemporal_load((const f32x4*)(c.src + (size_t)(c.k0 + kk) * c.ldw + c.n0 + 4 * n4)); } }
    for (int item = first; item < nitems; item += stride) {
        const CvtItem c = cvt_decode(F, item);
#pragma unroll
        for (int i = 0; i < 16; ++i) { const int idx = tid + NTHR * i, kk = idx >> 6, n4 = idx & 63; *(LAS f32x4*)(T + kk * CVP + 4 * n4) = R[i]; }
        __syncthreads();
        if (MODE != 1 && item + stride < nitems) { const CvtItem cn = cvt_decode(F, item + stride);
#pragma unroll
            for (int i = 0; i < 16; ++i) { const int idx = tid + NTHR * i, kk = idx >> 6, n4 = idx & 63; R[i] = __builtin_nontemporal_load((const f32x4*)(cn.src + (size_t)(cn.k0 + kk) * cn.ldw + cn.n0 + 4 * n4)); } }
        u32x4 o[4];
        { const int n = F.wave * 32 + (F.lane & 31), half = F.lane >> 5;
          const LAS float* col = T + (64 * half) * CVP + n;
#pragma unroll
          for (int q = 0; q < 4; ++q) { unsigned w4[4];
#pragma unroll
              for (int z = 0; z < 4; ++z) { const LAS float* p = col + (16 * q + 4 * z) * CVP; w4[z] = pk4_fp8s(p[0], p[CVP], p[2 * CVP], p[3 * CVP]); }
              o[q] = (u32x4){w4[0], w4[1], w4[2], w4[3]}; }
          __syncthreads();
          LAS unsigned char* OUTL = (LAS unsigned char*)F.lds;
#pragma unroll
          for (int q = 0; q < 4; ++q) *(LAS u32x4*)(OUTL + n * 144 + half * 64 + q * 16) = o[q]; }
        __syncthreads();
#pragma unroll
        for (int i = 0; i < 4; ++i) { const int idx = tid + NTHR * i, n = idx >> 3, ch = idx & 7;
            const u32x4 v = *(const LAS u32x4*)((const LAS unsigned char*)F.lds + n * 144 + ch * 16);
            size_t drow;
            if (c.gu) { const int jn = (c.n0 + n) & 1023; drow = (size_t)c.e * 2048 + (jn >> 7) * 256 + ((c.n0 + n) >= 1024 ? 128 : 0) + (jn & 127); }
            else drow = (size_t)c.e * D + c.n0 + n;
            if (MODE != 2 || v.x == 0x12345678u) *(u32x4*)((unsigned char*)(F.ws + (c.gu ? WS_WGU : WS_WD)) + drow * 1024 + c.k0 + ch * 16) = v; }
        __syncthreads();
    }
}

constexpr int CVH = 64 * CVP * 4;
__device__ __forceinline__ void cvt_dma_issue(Frame& F, int first, int stride, int t) {
    const CvtItem c = cvt_decode(F, first + (t >> 1) * stride); const int half = t & 1;
    LAS unsigned char* buf = F.lds + (t & 1) * CVH;
#pragma unroll
    for (int i = 0; i < 8; ++i) { const int row = 8 * F.wave + i;
        __builtin_amdgcn_global_load_lds((const unsigned*)(c.src + (size_t)(c.k0 + 64 * half + row) * c.ldw + c.n0 + 4 * F.lane), (LAS unsigned*)(buf + row * (CVP * 4)), 16, 0, 2); }
}
#define CVT_LW() asm volatile("s_waitcnt lgkmcnt(0)" ::: "memory")
#define CVT_BAR() do { __builtin_amdgcn_s_barrier(); asm volatile("" ::: "memory"); } while (0)
__device__ __forceinline__ void cvt_expert_items_dma(Frame& F, int first, int stride, int nitems) {
    if (first >= nitems) return;
    const int nh = 2 * ((nitems - first + stride - 1) / stride);
    int tid = F.tid; asm volatile("" : "+v"(tid));
    cvt_dma_issue(F, first, stride, 0); cvt_dma_issue(F, first, stride, 1);
    for (int t = 0; t < nh; ++t) {
        const CvtItem c = cvt_decode(F, first + (t >> 1) * stride); const int half = t & 1;
        LAS unsigned char* buf = F.lds + (t & 1) * CVH; const LAS float* T = (const LAS float*)buf;
        if (t + 1 < nh) asm volatile("s_waitcnt vmcnt(8)" ::: "memory"); else asm volatile("s_waitcnt vmcnt(0)" ::: "memory");
        CVT_BAR();
        u32x4 o0, o1;
        { const int n = F.wave * 32 + (F.lane & 31), kq = F.lane >> 5;
          const LAS float* col = T + (32 * kq) * CVP + n; unsigned w8[8];
#pragma unroll
          for (int z = 0; z < 8; ++z) { const LAS float* p = col + (4 * z) * CVP; w8[z] = pk4_fp8s(p[0], p[CVP], p[2 * CVP], p[3 * CVP]); }
          o0 = (u32x4){w8[0], w8[1], w8[2], w8[3]}; o1 = (u32x4){w8[4], w8[5], w8[6], w8[7]};
          CVT_LW(); CVT_BAR();
          *(LAS u32x4*)(buf + n * 80 + kq * 32) = o0; *(LAS u32x4*)(buf + n * 80 + kq * 32 + 16) = o1; }
        CVT_LW(); CVT_BAR();
#pragma unroll
        for (int i = 0; i < 2; ++i) { const int idx = tid + NTHR * i, n = idx >> 2, ch = idx & 3;
            const u32x4 v = *(const LAS u32x4*)(buf + n * 80 + ch * 16);
            size_t drow;
            if (c.gu) { const int jn = (c.n0 + n) & 1023; drow = (size_t)c.e * 2048 + (jn >> 7) * 256 + ((c.n0 + n) >= 1024 ? 128 : 0) + (jn & 127); }
            else drow = (size_t)c.e * D + c.n0 + n;
            *(u32x4*)((unsigned char*)(F.ws + (c.gu ? WS_WGU : WS_WD)) + drow * 1024 + c.k0 + 64 * half + ch * 16) = v; }
        CVT_LW(); CVT_BAR();
        if (t + 2 < nh) cvt_dma_issue(F, first, stride, t + 2);
    }
}
#undef CVT_LW
#undef CVT_BAR


__device__ __forceinline__ void p0_prologue(Frame& F, bool do_experts) {
    { bf16_t* WRT = (bf16_t*)(F.ws + WS_WRT); const float* wr = F.in[IN_WROUTER];
      for (int idx = F.vcu * NTHR + F.tid; idx < D * NE; idx += F.G * NTHR) { const int k = idx >> 5, e = idx & 31; const float v = wr[idx]; const unsigned hi = f2bf(v);
          WRT[e * D + k] = (bf16_t)hi; WRT[NE * D + e * D + k] = (bf16_t)f2bf(v - bf2f(hi)); } }
    LAS float* SL = (LAS float*)F.lds;
    for (int idx = F.tid; idx < 17 * 1024; idx += NTHR) { const int r = idx >> 10, k = idx & 1023; const float v = r < NB ? F.in[IN_C][r * D + k] : F.in[IN_CCTX][k]; SL[idx] = silu_f(v); }
    __syncthreads();
    LAS float* scr = (LAS float*)(F.lds + 69632 + F.wave * 8448);
    bf16_t* Win_t = (bf16_t*)(F.ws + WS_WIN); bf16_t* Wout_t = (bf16_t*)(F.ws + WS_WOUT); bf16_t* Wgu_t = (bf16_t*)(F.ws + WS_WGU); bf16_t* Wd_t = (bf16_t*)(F.ws + WS_WD);
    float* mod = (float*)(F.ws + WS_MOD);
    constexpr int I_MOD = NMOD / 8, I_WEFF = 4 * 64, I_WIN = 16 * (DIN / 32), I_ZERO = 224, I_WOUT = 8 * 32, I_GU = NE * 16 * 64, I_DN = NE * 16 * 32;
    const int nitems = I_MOD + I_WEFF + I_WIN + I_ZERO + I_WOUT + (do_experts ? I_GU + I_DN : 0);
    const int gw = F.wave * F.G + F.vcu, NGW = F.G * NWAVES;
    for (int it = gw; it < nitems; it += NGW) {
        int r = it;
        if (r < I_MOD) { p0_mod_item(F, r, SL, mod); continue; } r -= I_MOD;
        if (r < I_WEFF) { p0_weff_item(F, r, scr, Wout_t); continue; } r -= I_WEFF;
        if (r < I_WIN) { const int kb = r / (DIN / 32), nb = r % (DIN / 32); p0_transpose_item(F.in[IN_WIN], DIN, 64 * kb, 32 * nb, Win_t, D, win_drow(32 * nb), 0, scr, F.lane); continue; } r -= I_WIN;
        if (r < I_ZERO) { u32x4* o = (u32x4*)(Win_t + (size_t)(3 * 256 + 32 + r) * D) + F.lane * 2; o[0] = (u32x4){0u, 0u, 0u, 0u}; o[1] = (u32x4){0u, 0u, 0u, 0u}; continue; } r -= I_ZERO;
        if (r < I_WOUT) { const int kb = r / 32, nb = r % 32; p0_transpose_item(F.in[IN_WOUT], D, 64 * kb, 32 * nb, Wout_t, D, 32 * nb, 0, scr, F.lane); continue; } r -= I_WOUT;
        if (r < I_GU) { const int e = r / (16 * 64), q = r % (16 * 64), kb = q / 64, nb = q % 64, n0 = 32 * nb, jn = n0 & 1023;
            const int drow = e * 2048 + (jn >> 7) * 256 + (n0 >= 1024 ? 128 : 0) + (jn & 127);
            p0_transpose_item(F.in[IN_WGU] + (size_t)e * D * 2048, 2048, 64 * kb, n0, Wgu_t, D, drow, 0, scr, F.lane); continue; } r -= I_GU;
        { const int e = r / (16 * 32), q = r % (16 * 32), kb = q / 32, nb = q % 32;
            p0_transpose_item(F.in[IN_WDOWN] + (size_t)e * DFF * D, D, 64 * kb, 32 * nb, Wd_t, DFF, e * D + 32 * nb, 0, scr, F.lane); }
    }}

__device__ __forceinline__ void norm_row_bf16(const float* src, const float* wn, const float* sh, const float* sc, bf16_t* dst, int lane) {
    const f32x4* xr = (const f32x4*)src + lane;
    f32x4 v[4]; float s = 0.f;
#pragma unroll
    for (int j = 0; j < 4; ++j) { v[j] = xr[64 * j]; s += (v[j].x * v[j].x + v[j].y * v[j].y) + (v[j].z * v[j].z + v[j].w * v[j].w); }
    const float rstd = rsqrtf(wave_sum(s) * (1.f / D) + EPS);
    u32x2* o8 = (u32x2*)dst + lane;
#pragma unroll
    for (int j = 0; j < 4; ++j) { const f32x4 w = ((const f32x4*)wn)[lane + 64 * j], a = ((const f32x4*)sc)[lane + 64 * j], b = ((const f32x4*)sh)[lane + 64 * j];
        const f32x4 y = v[j] * rstd * w * (a + 1.f) + b; u32x2 p; p.x = pk2(y.x, y.y); p.y = pk2(y.z, y.w); o8[64 * j] = p; }
}
__device__ __forceinline__ void p1_norm1(Frame& F) {
    const float* mod = (const float*)(F.ws + WS_MOD); bf16_t* HN = (bf16_t*)(F.ws + WS_HN1);
    constexpr int RPB = NROW / 256;
    for (int blk = F.vcu; blk < 256; blk += F.G)
        for (int r = F.wave; r < RPB; r += NWAVES) { const int row = blk * RPB + r;
            const float* src = row < NTOK ? F.in[IN_X] + (size_t)row * D : F.in[IN_CTX] + (size_t)(row - NTOK) * D;
            const float* mr = mod + (size_t)(row < NTOK ? row / SEQ : NB) * NMOD;
            norm_row_bf16(src, F.in[IN_NMIX], mr, mr + 1024, HN + (size_t)row * D, F.lane); }
}

typedef __bf16 bf16x2n __attribute__((ext_vector_type(2)));
__device__ __forceinline__ unsigned pkbf(float lo, float hi) { f32x2 v = {lo, hi}; return __builtin_bit_cast(unsigned, __builtin_convertvector(v, bf16x2n)); }
#define MFMA32(a, b, c) __builtin_amdgcn_mfma_f32_32x32x16_bf16((a), (b), (c), 0, 0, 0)
constexpr int GP = 72;
constexpr int GL_QP = 0, GL_KP = 9216, GL_QQ = 18432, GL_KKT = 27648, GL_VT = 36864, GL_DEC = 55296, GL_GSUM = 55552, GL_R = 57600, GL_END = 61696;

__device__ __forceinline__ bf16x8 pack8(const f32x16& x, int s) {
    u32x4 p; p.x = pkbf(x[8 * s + 0], x[8 * s + 1]); p.y = pkbf(x[8 * s + 2], x[8 * s + 3]); p.z = pkbf(x[8 * s + 4], x[8 * s + 5]); p.w = pkbf(x[8 * s + 6], x[8 * s + 7]);
    return __builtin_bit_cast(bf16x8, p);
}
__device__ __forceinline__ bf16x8 ld_perm8(const LAS bf16_t* p) {
    const u32x2 a = *(const LAS u32x2*)p, b = *(const LAS u32x2*)(p + 8); u32x4 r; r.x = a.x; r.y = a.y; r.z = b.x; r.w = b.y; return __builtin_bit_cast(bf16x8, r);
}
__device__ __forceinline__ bf16x8 ld_nat8(const LAS bf16_t* p) { return *(const LAS bf16x8*)p; }

template <int GM>
__device__ __forceinline__ void gla_unit(Frame& F, const int unit) {
    const int b = unit >> 3, h = (unit >> 1) & 3, dir = unit & 1;
    const int w = F.wave, lane = F.lane, tid = F.tid;
    LAS unsigned char* L = F.lds;
    LAS bf16_t* QP = (LAS bf16_t*)(L + GL_QP); LAS bf16_t* KP = (LAS bf16_t*)(L + GL_KP); LAS bf16_t* QQ = (LAS bf16_t*)(L + GL_QQ);
    LAS bf16_t* KKT = (LAS bf16_t*)(L + GL_KKT); LAS bf16_t* VT = (LAS bf16_t*)(L + GL_VT);
    LAS float* DEC = (LAS float*)(L + GL_DEC); LAS float* GSUM = (LAS float*)(L + GL_GSUM); LAS float* RL = (LAS float*)(L + GL_R);
    const bf16_t* QB = (const bf16_t*)(F.ws + WS_QB); const bf16_t* KB = (const bf16_t*)(F.ws + WS_KB); const bf16_t* VB = (const bf16_t*)(F.ws + WS_VB);
    const float* RB = (const float*)(F.ws + WS_RB);
    bf16_t* OD = (bf16_t*)(F.ws + (GM >= 3 ? (dir ? 870 * MiB : 830 * MiB) : (dir ? WS_OB : WS_OF)));
    const float* wgk = F.in[dir ? IN_WGKB : IN_WGKF]; const float* bgk = F.in[dir ? IN_BGKB : IN_BGKF];
    f32x2 wg[8];
#pragma unroll
    for (int j = 0; j < 8; ++j) wg[j] = (f32x2){wgk[(2 * j) * 256 + h * 64 + lane], wgk[(2 * j + 1) * 256 + h * 64 + lane]};
    const float bg = bgk[h * 64 + lane];
    f32x16 S0, S1;
#pragma unroll
    for (int i = 0; i < 16; ++i) { S0[i] = 0.f; S1[i] = 0.f; }
    const int tb = w >> 2, vb = w & 3, c = lane & 31, hh = lane >> 5;
    const int vs = lane, vc = w;
    const int rs = tid >> 3, rc = tid & 7;
    unsigned pq[8], pk[8]; u32x4 pv0, pv1; f32x2 pr;
#define GLA_LOAD(step) do { const int _s = (step); const bool _ctx = _s < 4; const int _ci = _ctx ? _s : _s - 4; const int _ch = dir ? ((_ctx ? 3 : 31) - _ci) : _ci; \
        const int _row0 = _ctx ? NTOK + b * CTX + _ch * 64 : b * SEQ + _ch * 64; \
        _Pragma("unroll") for (int _i = 0; _i < 8; ++_i) { const int _t = 8 * w + _i; const size_t _row = (size_t)(_row0 + (dir ? 63 - _t : _t)); \
            pk[_i] = KB[_row * 256 + h * 64 + lane]; pq[_i] = _ctx ? 0u : (unsigned)QB[_row * 256 + h * 64 + lane]; } \
        { const size_t _row = (size_t)(_row0 + (dir ? 63 - vs : vs)); const u32x4* _vp = (const u32x4*)(VB + _row * 512 + h * 128 + vc * 16); pv0 = _vp[0]; pv1 = _vp[1]; \
          const size_t _rr = (size_t)(_row0 + (dir ? 63 - rs : rs)); pr = *(const f32x2*)(RB + _rr * 32 + dir * 16 + rc * 2); } } while (0)
    GLA_LOAD(0);
    for (int step = 0; step < 36; ++step) {
        const bool isctx = step < 4; const int ci = isctx ? step : step - 4; const int chunk = dir ? ((isctx ? 3 : 31) - ci) : ci;
        const int row0 = isctx ? NTOK + b * CTX + chunk * 64 : b * SEQ + chunk * 64;
        unsigned cq[8], ck[8]; u32x4 cv0 = pv0, cv1 = pv1;
#pragma unroll
        for (int i = 0; i < 8; ++i) { cq[i] = pq[i]; ck[i] = pk[i]; }
        *(LAS f32x2*)(RL + rs * 16 + rc * 2) = pr;
        __syncthreads();
        float cs[8];
        { float run = 0.f;
#pragma unroll
          for (int i = 0; i < 8; ++i) { const LAS f32x4* rp = (const LAS f32x4*)(RL + (8 * w + i) * 16); f32x2 a2 = {bg, 0.f};
#pragma unroll
              for (int q4 = 0; q4 < ((GM == 3) ? 1 : 4); ++q4) { const f32x4 rv = rp[q4]; a2 = __builtin_elementwise_fma((f32x2){rv[0], rv[1]}, wg[2 * q4], a2); a2 = __builtin_elementwise_fma((f32x2){rv[2], rv[3]}, wg[2 * q4 + 1], a2); }
              const float x = a2.x + a2.y;
              const float gk = (GM == 3) ? x * 1e-3f : __builtin_fmaf(__builtin_amdgcn_logf(1.f + __builtin_amdgcn_exp2f(fabsf(x) * -1.44269504089f)), -0.69314718056f / 16.f, fminf(x, 0.f) * (1.f / 16.f));
              run += gk; cs[i] = run; }
          GSUM[w * 64 + lane] = run; }
        __syncthreads();
        { float pre = 0.f, mid = 0.f, tot = 0.f;
#pragma unroll
          for (int g = 0; g < 8; ++g) { const float gsum = GSUM[g * 64 + lane]; if (g < w) pre += gsum; if (g < 4) mid += gsum; tot += gsum; }
          if (w == 0) DEC[lane] = __expf(tot);
          const f32x2 emt = {__expf(mid), __expf(tot - mid)}; const float pm = pre - mid;
          u32x4 kk4;
          float kkf[8];
#pragma unroll
          for (int i = 0; i < ((GM == 4) ? 1 : 8); ++i) { const int t = 8 * w + i; const float dd = pm + cs[i];
              const f32x2 ea = __builtin_elementwise_fma((f32x2){dd, dd}, (f32x2){1.44269504089f, -1.44269504089f}, (f32x2){-3.f, 0.f});
              const f32x2 e = {__builtin_amdgcn_exp2f(ea.x), __builtin_amdgcn_exp2f(ea.y)};
              const f32x2 qk = {bf2f(cq[i]), bf2f(ck[i])};
              const f32x2 o2 = qk * (e * emt); kkf[i] = o2.y;
              if (!isctx) { const f32x2 o1 = qk * e; const unsigned w1 = pkbf(o1.x, o1.y), w2 = pkbf(o2.x, 0.f);
                  QP[t * GP + lane] = (bf16_t)(w1 & 0xffffu); KP[t * GP + lane] = (bf16_t)(w1 >> 16); QQ[t * GP + lane] = (bf16_t)(w2 & 0xffffu); } }
          kk4.x = pkbf(kkf[0], kkf[1]); kk4.y = pkbf(kkf[2], kkf[3]); kk4.z = pkbf(kkf[4], kkf[5]); kk4.w = pkbf(kkf[6], kkf[7]);
          *(LAS u32x4*)(KKT + lane * GP + 8 * w) = kk4;
          const unsigned vw[8] = {cv0.x, cv0.y, cv0.z, cv0.w, cv1.x, cv1.y, cv1.z, cv1.w};
#pragma unroll
          for (int e = 0; e < ((GM == 4) ? 1 : 8); ++e) { VT[(vc * 16 + 2 * e) * GP + vs] = (bf16_t)(vw[e] & 0xffffu); VT[(vc * 16 + 2 * e + 1) * GP + vs] = (bf16_t)(vw[e] >> 16); } }
        if (step + 1 < 36) GLA_LOAD(step + 1);
        __syncthreads();
        if (!isctx && GM != 1) {
            f32x16 O;
#pragma unroll
            for (int i = 0; i < 16; ++i) O[i] = 0.f;
#pragma unroll
            for (int s = 0; s < 2; ++s) { O = MFMA32(ld_perm8(QQ + (32 * tb + c) * GP + 16 * s + 4 * hh), pack8(S0, s), O);
                                          O = MFMA32(ld_perm8(QQ + (32 * tb + c) * GP + 32 + 16 * s + 4 * hh), pack8(S1, s), O); }
#pragma unroll
            for (int sb = 0; sb < 2; ++sb) { if (sb > tb) continue;
                f32x16 X;
#pragma unroll
                for (int i = 0; i < 16; ++i) X[i] = 0.f;
#pragma unroll
                for (int s = 0; s < 4; ++s) X = MFMA32(ld_nat8(KP + (32 * sb + c) * GP + 16 * s + 8 * hh), ld_nat8(QP + (32 * tb + c) * GP + 16 * s + 8 * hh), X);
                if (sb == tb) {
#pragma unroll
                    for (int r = 0; r < 16; ++r) { const int sl = (r & 3) + 8 * (r >> 2) + 4 * hh; X[r] = (sl <= c) ? X[r] : 0.f; } }
#pragma unroll
                for (int s = 0; s < 2; ++s) O = MFMA32(pack8(X, s), ld_perm8(VT + (32 * vb + c) * GP + 32 * sb + 16 * s + 4 * hh), O);
            }
#pragma unroll
            for (int r = 0; r < ((GM == 2) ? 1 : 16); ++r) { const int t = 32 * tb + (r & 3) + 8 * (r >> 2) + 4 * hh; const size_t row = (size_t)(row0 + (dir ? 63 - t : t));
                OD[row * 512 + h * 128 + 32 * vb + c] = (bf16_t)(pkbf(O[r], 0.f) & 0xffffu); }
        }
        if (GM != 1) {
#pragma unroll
            for (int g4 = 0; g4 < 4; ++g4) { const f32x4 d0 = *(const LAS f32x4*)(DEC + 8 * g4 + 4 * hh), d1 = *(const LAS f32x4*)(DEC + 32 + 8 * g4 + 4 * hh);
#pragma unroll
                for (int z = 0; z < 4; ++z) { S0[4 * g4 + z] *= d0[z]; S1[4 * g4 + z] *= d1[z]; } }
#pragma unroll
            for (int s = 0; s < 4; ++s) { const bf16x8 vf = ld_nat8(VT + (32 * vb + c) * GP + 16 * s + 8 * hh);
                S0 = MFMA32(ld_nat8(KKT + c * GP + 16 * s + 8 * hh), vf, S0);
                S1 = MFMA32(ld_nat8(KKT + (32 + c) * GP + 16 * s + 8 * hh), vf, S1); }
        }
    }
#undef GLA_LOAD
    __syncthreads();
}

constexpr int PRS = 72 * 2;
__device__ __forceinline__ int pslot(int x) { return 2 * (x + (x >> 3)); }
template <int G_>
__device__ __forceinline__ void pool_unit_g(Frame& F, const int cblk, const int b) {
    constexpr int g = G_, wdw = 2 << g, lo = wdw >> 1, hi = wdw - 1 - lo;
    LAS f32x4* X = (LAS f32x4*)F.lds;
    LAS f32x4* H = (LAS f32x4*)(F.lds + 73728);
    const bf16_t* PB = (const bf16_t*)(F.ws + WS_PB) + ((size_t)((b * 4 + g) * 16 + cblk) * 2048) * 8;
    bf16_t* MIX = (bf16_t*)(F.ws + WS_MIX);
    int tid = F.tid; asm volatile("" : "+v"(tid));
#pragma unroll
    for (int i = 0; i < 4; ++i) { const int tok = tid + 512 * i, r = tok >> 6, x = tok & 63; const u32x4 v = *(const u32x4*)(PB + (size_t)tok * 8);
        LAS f32x4* p = X + r * PRS + pslot(x);
        p[0] = (f32x4){bflo(v.x), bfhi(v.x), bflo(v.y), bfhi(v.y)}; p[1] = (f32x4){bflo(v.z), bfhi(v.z), bflo(v.w), bfhi(v.w)}; }
    __syncthreads();
    { const int q = tid & 1, cs = (tid >> 1) & 7, r = tid >> 4; const LAS f32x4* xr = X + r * PRS + q; LAS f32x4* hr = H + r * PRS + q;
      const int c0 = 8 * cs; f32x4 s = {0.f, 0.f, 0.f, 0.f};
#pragma unroll
      for (int d = -lo; d <= hi; ++d) { const int x = c0 + d; const bool ok = (x >= 0) && (x < GW); const int xc = x < 0 ? 0 : (x > GW - 1 ? GW - 1 : x); const f32x4 v = xr[pslot(xc)]; s += ok ? v : (f32x4){0.f, 0.f, 0.f, 0.f}; if (((d + lo) & 3) == 3) asm volatile("" ::: "memory"); }
      hr[pslot(c0)] = s;
#pragma unroll
      for (int j = 1; j < 8; ++j) { const int xin = c0 + j + hi, xout = c0 + j - 1 - lo; const bool oki = xin < GW, oko = xout >= 0;
          const f32x4 vi = xr[pslot(oki ? xin : GW - 1)], vo = xr[pslot(oko ? xout : 0)];
          s += oki ? vi : (f32x4){0.f, 0.f, 0.f, 0.f}; s -= oko ? vo : (f32x4){0.f, 0.f, 0.f, 0.f}; hr[pslot(c0 + j)] = s; } }
    __syncthreads();
    { const int q = tid & 1, cc = (tid >> 1) & 63, rs = tid >> 7; const int col = pslot(cc) + q; const int r0s = 8 * rs;
      const int c0 = max(cc - lo, 0), c1 = min(cc + hi + 1, GW); const float ncol = (float)(c1 - c0);
      f32x4 s = {0.f, 0.f, 0.f, 0.f};
#pragma unroll
      for (int d = -lo; d <= hi; ++d) { const int y = r0s + d; const bool ok = (y >= 0) && (y < GROWS); const int yc = y < 0 ? 0 : (y > GROWS - 1 ? GROWS - 1 : y); const f32x4 v = H[yc * PRS + col]; s += ok ? v : (f32x4){0.f, 0.f, 0.f, 0.f}; if (((d + lo) & 3) == 3) asm volatile("" ::: "memory"); }
#pragma unroll
      for (int j = 0; j < 8; ++j) { const int r = r0s + j;
          if (j > 0) { const int yin = r + hi, yout = r - 1 - lo; const bool oki = yin < GROWS, oko = yout >= 0;
              const f32x4 vi = H[(oki ? yin : GROWS - 1) * PRS + col], vo = H[(oko ? yout : 0) * PRS + col];
              s += oki ? vi : (f32x4){0.f, 0.f, 0.f, 0.f}; s -= oko ? vo : (f32x4){0.f, 0.f, 0.f, 0.f}; }
          const int ra = max(r - lo, 0), rb = min(r + hi + 1, GROWS);
          const float inv = 1.f / ((float)(rb - ra) * ncol);
          const f32x4 o = s * inv - X[r * PRS + col];
          u32x2 pw; pw.x = pkbf(o[0], o[1]); pw.y = pkbf(o[2], o[3]);
          *(u32x2*)(MIX + (size_t)(b * SEQ + r * GW + cc) * D + 512 + g * 128 + cblk * 8 + q * 4) = pw; } }
    __syncthreads();
}
__device__ __forceinline__ void pool_unit(Frame& F, const int unit) {
    const int g = unit & 3, cblk = (unit >> 2) & 15, b = unit >> 6;
    if (g == 0) pool_unit_g<0>(F, cblk, b); else if (g == 1) pool_unit_g<1>(F, cblk, b); else if (g == 2) pool_unit_g<2>(F, cblk, b); else pool_unit_g<3>(F, cblk, b);
}

__device__ __forceinline__ void p4_gla_out(Frame& F) {
    const bf16_t* OFp = (const bf16_t*)(F.ws + WS_OF); const bf16_t* OBp = (const bf16_t*)(F.ws + WS_OB); const bf16_t* GB = (const bf16_t*)(F.ws + WS_GB);
    bf16_t* MIX = (bf16_t*)(F.ws + WS_MIX); const float* wn = F.in[IN_GLANW];
    const int lane = F.lane, gw = F.vcu * NWAVES + F.wave, NGW = F.G * NWAVES;
    const f32x4 w0 = *(const f32x4*)(wn + (lane & 15) * 8), w1 = *(const f32x4*)(wn + (lane & 15) * 8 + 4);
    for (int tok = gw; tok < NTOK; tok += NGW) {
        const u32x4 fa = *((const u32x4*)(OFp + (size_t)tok * 512) + lane), fb = *((const u32x4*)(OBp + (size_t)tok * 512) + lane);
        const f32x4 o0 = (f32x4){bflo(fa.x) + bflo(fb.x), bfhi(fa.x) + bfhi(fb.x), bflo(fa.y) + bflo(fb.y), bfhi(fa.y) + bfhi(fb.y)};
        const f32x4 o1 = (f32x4){bflo(fa.z) + bflo(fb.z), bfhi(fa.z) + bfhi(fb.z), bflo(fa.w) + bflo(fb.w), bfhi(fa.w) + bfhi(fb.w)};
        const u32x4 gv = *((const u32x4*)(GB + (size_t)tok * 512) + lane);
        float ss = (o0[0] * o0[0] + o0[1] * o0[1]) + (o0[2] * o0[2] + o0[3] * o0[3]) + (o1[0] * o1[0] + o1[1] * o1[1]) + (o1[2] * o1[2] + o1[3] * o1[3]);
        ss += __shfl_xor(ss, 1); ss += __shfl_xor(ss, 2); ss += __shfl_xor(ss, 4); ss += __shfl_xor(ss, 8);
        const float rstd = rsqrtf(ss * (1.f / 128.f) + EPS);
        const float gg[8] = {bflo(gv.x), bfhi(gv.x), bflo(gv.y), bfhi(gv.y), bflo(gv.z), bfhi(gv.z), bflo(gv.w), bfhi(gv.w)};
        float y[8];
#pragma unroll
        for (int j = 0; j < 4; ++j) { y[j] = o0[j] * rstd * w0[j] * silu_f(gg[j]); y[4 + j] = o1[j] * rstd * w1[j] * silu_f(gg[4 + j]); }
        u32x4 pw; pw.x = pkbf(y[0], y[1]); pw.y = pkbf(y[2], y[3]); pw.z = pkbf(y[4], y[5]); pw.w = pkbf(y[6], y[7]);
        *((u32x4*)(MIX + (size_t)tok * D) + lane) = pw;
    }
}

constexpr int P6_AP = 1032;
constexpr int L6_AH = 0, L6_AL = 32 * P6_AP * 2, L6_LG = 2 * L6_AL;
constexpr int L6_REC = L6_LG + 128 * 33 * 4;
constexpr int L6_RED = 0;
static_assert(L6_REC + 4096 <= LDSCTL_OFF && 8 * 32 * 33 * 4 <= L6_LG, "P6 LDS map");
template <int PRB = 0>
__device__ __forceinline__ void p6_router(Frame& F) {
    LAS bf16_t* AH = (LAS bf16_t*)(F.lds + L6_AH); LAS bf16_t* AL = (LAS bf16_t*)(F.lds + L6_AL); LAS float* LG = (LAS float*)(F.lds + L6_LG); LAS float* RED = (LAS float*)(F.lds + L6_RED);
    LAS unsigned* REC = (LAS unsigned*)(F.lds + L6_REC); LAS float* RECW = (LAS float*)(F.lds + L6_REC + 2048);
    LAS int* LCNT = (LAS int*)(F.lds + LDSCTL_OFF) + LC_CNT; LAS int* GBASE = LCNT + 32;
    const float* b_router = F.in[IN_BROUTER]; const float* wn = F.in[IN_NMLP];
    const float* mod = (const float*)(F.ws + WS_MOD); const bf16_t* h1 = (const bf16_t*)(F.ws + WS_H1B);
    unsigned char* HN2 = (unsigned char*)(F.ws + WS_HN2);
    int* gcnt = (int*)(F.ws + WS_CTL) + CW_CNT + (PRB ? 65536 : 0); int* list = (int*)(F.ws + (PRB ? 830 * MiB : WS_LIST)); unsigned* ASG = (unsigned*)(F.ws + (PRB ? 900 * MiB : WS_ASG)); float* TOPW = (float*)(F.ws + (PRB ? 905 * MiB : WS_TOPW));
    const int lane = F.lane, w = F.wave, tid = F.tid, c = lane & 31, hh = lane >> 5;
    bf16x8 bh[8], bl[8];
    { const bf16_t* WRT = (const bf16_t*)(F.ws + WS_WRT);
#pragma unroll
      for (int s = 0; s < 8; ++s) { bh[s] = *(const bf16x8*)(WRT + c * D + 128 * w + 16 * s + 8 * hh); bl[s] = *(const bf16x8*)(WRT + NE * D + c * D + 128 * w + 16 * s + 8 * hh); } }
    const f32x4 wn4[4] = {((const f32x4*)wn)[lane], ((const f32x4*)wn)[lane + 64], ((const f32x4*)wn)[lane + 128], ((const f32x4*)wn)[lane + 192]};
    for (int tblk = F.vcu; tblk < NTOK / 128; tblk += F.G) {
        if (tid < 32) LCNT[tid] = 0;
        const float* mrow = mod + (size_t)((tblk * 128) >> 11) * NMOD;
        f32x4 sc4[4], sh4[4];
#pragma unroll
        for (int j = 0; j < 4; ++j) { sc4[j] = ((const f32x4*)(mrow + 4096))[lane + 64 * j] + 1.f; sh4[j] = ((const f32x4*)(mrow + 3072))[lane + 64 * j]; }
        u32x2 hn[4][4];
#pragma unroll
        for (int q = 0; q < 4; ++q) { const u32x2* xr = (const u32x2*)(h1 + (size_t)(tblk * 128 + 4 * w + q) * D) + lane;
#pragma unroll
          for (int j = 0; j < 4; ++j) hn[q][j] = xr[64 * j]; }
        for (int tile = 0; tile < 4; ++tile) {
#pragma unroll
            for (int q = 0; q < 4; ++q) { const int tl = 4 * w + q, tok = tblk * 128 + tile * 32 + tl;
                f32x4 hv[4]; float s = 0.f;
#pragma unroll
                for (int j = 0; j < 4; ++j) { hv[j] = (f32x4){bflo(hn[q][j].x), bfhi(hn[q][j].x), bflo(hn[q][j].y), bfhi(hn[q][j].y)}; s += (hv[j].x * hv[j].x + hv[j].y * hv[j].y) + (hv[j].z * hv[j].z + hv[j].w * hv[j].w); }
                if (tile < 3) { const u32x2* xr = (const u32x2*)(h1 + (size_t)(tok + 32) * D) + lane;
#pragma unroll
                    for (int j = 0; j < 4; ++j) hn[q][j] = xr[64 * j]; }
                const float rstd = rsqrtf(wave_sum(s) * (1.f / D) + EPS);
                unsigned* o4 = (unsigned*)(HN2 + (size_t)tok * D) + lane;
#pragma unroll
                for (int j = 0; j < 4; ++j) { const f32x4 y = hv[j] * rstd * wn4[j] * sc4[j] + sh4[j];
                    o4[64 * j] = pg8::pk4_fp8(y.x, y.y, y.z, y.w);
                    u32x2 hi2; hi2.x = pkbf(y.x, y.y); hi2.y = pkbf(y.z, y.w);
                    u32x2 lo2; lo2.x = pkbf(y.x - bflo(hi2.x), y.y - bfhi(hi2.x)); lo2.y = pkbf(y.z - bflo(hi2.y), y.w - bfhi(hi2.y));
                    *(LAS u32x2*)(AH + tl * P6_AP + 4 * lane + 256 * j) = hi2; *(LAS u32x2*)(AL + tl * P6_AP + 4 * lane + 256 * j) = lo2; } }
            __syncthreads();
            f32x16 Dp;
#pragma unroll
            for (int i = 0; i < 16; ++i) Dp[i] = 0.f;
#pragma unroll
            for (int s = 0; s < 8; ++s) { const bf16x8 ah = *(const LAS bf16x8*)(AH + c * P6_AP + 128 * w + 16 * s + 8 * hh), al = *(const LAS bf16x8*)(AL + c * P6_AP + 128 * w + 16 * s + 8 * hh);
                Dp = MFMA32(ah, bh[s], Dp); Dp = MFMA32(ah, bl[s], Dp); Dp = MFMA32(al, bh[s], Dp); }
            __syncthreads();
#pragma unroll
            for (int r = 0; r < 16; ++r) RED[w * (32 * 33) + ((r & 3) + 8 * (r >> 2) + 4 * hh) * 33 + c] = Dp[r];
            __syncthreads();
            { const int tl = tid >> 4, e0 = tid & 15; float a0 = 0.f, a1 = 0.f;
#pragma unroll
              for (int ww = 0; ww < 8; ++ww) { a0 += RED[ww * (32 * 33) + tl * 33 + e0]; a1 += RED[ww * (32 * 33) + tl * 33 + e0 + 16]; }
              LG[(tile * 32 + tl) * 33 + e0] = a0 + b_router[e0]; LG[(tile * 32 + tl) * 33 + e0 + 16] = a1 + b_router[e0 + 16]; }
            __syncthreads();
        }
        if (tid < 128) { float lgv[32];
#pragma unroll
            for (int e = 0; e < 32; ++e) lgv[e] = LG[tid * 33 + e];
            int se[4]; float sv[4];
#pragma unroll
            for (int r = 0; r < 4; ++r) { float bv = -3.0e38f; int bi = 0;
#pragma unroll
                for (int e = 0; e < 32; ++e) { bool ok = lgv[e] > bv;
#pragma unroll
                    for (int q = 0; q < r; ++q) ok = ok && (se[q] != e);
                    bv = ok ? lgv[e] : bv; bi = ok ? e : bi; }
                se[r] = bi; sv[r] = bv; }
            float ex[4], den = 0.f;
#pragma unroll
            for (int r = 0; r < 4; ++r) { ex[r] = __expf(sv[r] - sv[0]); den += ex[r]; }
            const float inv = 1.f / den;
#pragma unroll
            for (int r = 0; r < 4; ++r) { const int lp = __hip_atomic_fetch_add(&LCNT[se[r]], 1, __ATOMIC_RELAXED, __HIP_MEMORY_SCOPE_WORKGROUP);
                REC[tid * 4 + r] = ((unsigned)se[r] << 16) | (unsigned)lp; RECW[tid * 4 + r] = ex[r] * inv; } }
        __syncthreads();
        { int t2 = tid; asm volatile("" : "+v"(t2)); if (t2 < 32) GBASE[t2] = atomicAdd(&gcnt[64 * t2], LCNT[t2]); }
        __syncthreads();
        { const unsigned rec = REC[tid]; const int e = rec >> 16, pos = GBASE[e] + (int)(rec & 0xffffu), aid = tblk * 512 + tid;
          list[e * NTOK + pos] = aid; ASG[aid] = ((unsigned)e << 16) | (unsigned)pos; TOPW[aid] = RECW[tid]; }
        __syncthreads();
    }
}
__device__ __forceinline__ void moe_tables(Frame& F) {
    LAS int* TST = (LAS int*)(F.lds + LDSCTL_OFF) + LC_TST; LAS int* LCNT = (LAS int*)(F.lds + LDSCTL_OFF) + LC_CNT;
    const int* gcnt = (const int*)(F.ws + WS_CTL) + CW_CNT;
    if (F.tid < 64) {
        const int lane = F.lane; const int c = lane < NE ? gcnt[64 * lane] : 0; const int mt = (c + 255) >> 8; int inc = mt;
#pragma unroll
        for (int o = 1; o < 32; o <<= 1) { const int up = __shfl_up(inc, o); if (lane >= o) inc += up; }
        if (lane < NE) { LCNT[lane] = c; TST[lane] = inc - mt; }
        if (lane == NE - 1) TST[NE] = inc;
    }
    __syncthreads();
}
__device__ __forceinline__ f32x4 fp8x4_to_f32(unsigned w) { const f32x2 lo = __builtin_amdgcn_cvt_pk_f32_fp8((int)w, false), hi = __builtin_amdgcn_cvt_pk_f32_fp8((int)w, true); return (f32x4){lo.x, lo.y, hi.x, hi.y}; }
__device__ __forceinline__ void p9_final(Frame& F) {
    const LAS int* TST = (const LAS int*)(F.lds + LDSCTL_OFF) + LC_TST;
    const unsigned* ASG = (const unsigned*)(F.ws + WS_ASG); const float* TOPW = (const float*)(F.ws + WS_TOPW); const unsigned char* Y = (const unsigned char*)(F.ws + WS_Y);
    const float* mod = (const float*)(F.ws + WS_MOD); const float* fw = F.in[IN_FNW]; float* out = F.out; const bf16_t* H1B = (const bf16_t*)(F.ws + WS_H1B);
    const int lane = F.lane, gw = F.vcu * NWAVES + F.wave, NGW = F.G * NWAVES;
    f32x4 fwv[4];
#pragma unroll
    for (int j = 0; j < 4; ++j) fwv[j] = ((const f32x4*)fw)[lane + 64 * j];
    u32x4 na4[2]; f32x4 nw4[2];
#pragma unroll
    for (int u = 0; u < 2; ++u) { const int t = (gw + u * NGW < NTOK) ? gw + u * NGW : gw; na4[u] = *(const u32x4*)(ASG + (size_t)t * 4); nw4[u] = *(const f32x4*)(TOPW + (size_t)t * 4); }
    for (int tok0 = gw; tok0 < NTOK; tok0 += 2 * NGW) {
        int tk[2]; tk[0] = tok0; tk[1] = (tok0 + NGW < NTOK) ? tok0 + NGW : tok0;
        unsigned yv[2][4][4]; float wg[2][4]; u32x2 xv[2][4]; f32x4 gv[2][4];
#pragma unroll
        for (int u = 0; u < 2; ++u) { const u32x4 a4 = na4[u]; const f32x4 w4 = nw4[u];
            const unsigned aa[4] = {a4.x, a4.y, a4.z, a4.w};
#pragma unroll
            for (int r = 0; r < 4; ++r) { const unsigned a = (unsigned)__builtin_amdgcn_readfirstlane((int)aa[r]); wg[u][r] = w4[r];
                const size_t row = (size_t)TST[a >> 16] * 256 + (a & 0xffffu); const unsigned* yp = (const unsigned*)(Y + row * D) + lane;
#pragma unroll
                for (int j = 0; j < 4; ++j) yv[u][r][j] = yp[64 * j]; }
            const u32x2* xr = (const u32x2*)(H1B + (size_t)tk[u] * D) + lane; const f32x4* g2 = (const f32x4*)(mod + (size_t)(tk[u] >> 11) * NMOD + 5120) + lane;
#pragma unroll
            for (int j = 0; j < 4; ++j) { xv[u][j] = xr[64 * j]; gv[u][j] = g2[64 * j]; } }
        { const int n0 = tok0 + 2 * NGW;
          if (n0 < NTOK) {
#pragma unroll
              for (int u = 0; u < 2; ++u) { const int t = (n0 + u * NGW < NTOK) ? n0 + u * NGW : n0; na4[u] = *(const u32x4*)(ASG + (size_t)t * 4); nw4[u] = *(const f32x4*)(TOPW + (size_t)t * 4); } } }
#pragma unroll
        for (int u = 0; u < 2; ++u) { f32x4 v[4]; float s = 0.f;
#pragma unroll
            for (int j = 0; j < 4; ++j) { f32x4 acc = fp8x4_to_f32(yv[u][0][j]) * wg[u][0];
#pragma unroll
                for (int r = 1; r < 4; ++r) acc += fp8x4_to_f32(yv[u][r][j]) * wg[u][r];
                v[j] = (f32x4){bflo(xv[u][j].x), bfhi(xv[u][j].x), bflo(xv[u][j].y), bfhi(xv[u][j].y)} + gv[u][j] * acc; s += (v[j].x * v[j].x + v[j].y * v[j].y) + (v[j].z * v[j].z + v[j].w * v[j].w); }
            const float rstd = rsqrtf(wave_sum(s) * (1.f / D) + EPS);
            if (u == 0 || tk[1] != tk[0]) { f32x4* xo = (f32x4*)(out + (size_t)tk[u] * D) + lane;
#pragma unroll
                for (int j = 0; j < 4; ++j) xo[64 * j] = v[j] * rstd * fwv[j]; } }
    }
}

#ifndef MK_N_LAUNCHES
#define MK_N_LAUNCHES 1
#endif
constexpr int N_PHASES = 10;
#ifndef PROBE_TWICE
#define PROBE_TWICE -1
#endif
__global__ void __launch_bounds__(NTHR, 2) mk_fwd(Args args) {
    extern __shared__ __attribute__((aligned(16))) unsigned char lds_raw[];
    Frame F;
    F.lds = (LAS unsigned char*)lds_raw;
    F.tid = threadIdx.x; F.lane = F.tid & 63; F.wave = __builtin_amdgcn_readfirstlane(F.tid >> 6);
    F.G = gridDim.x; { const int bx = blockIdx.x; F.vcu = (F.G % 8 == 0) ? (bx % 8) * (F.G / 8) + bx / 8 : bx; }
    F.in = args.in; F.out = args.out; F.ws = args.ws;
    for (int u = F.tid; u < (LDS_BYTES - LDSCTL_OFF) / 4; u += NTHR) ((LAS unsigned*)(F.lds + LDSCTL_OFF))[u] = 0u;
    __syncthreads();
    const int lo = args.ph_lo, hi = args.ph_hi;
    XcdBarrier bar; bar.bar = (unsigned*)(F.ws + WS_CTL) + CW_BAR; bar.x = 0; bar.st = nullptr;
    if (hi - lo > 1) bar = xcd_barrier_post((unsigned*)(F.ws + WS_CTL) + CW_BAR, (volatile LAS unsigned*)(F.lds + LDSCTL_OFF) + LC_BAR);
#define IN(k) (lo <= (k) && (k) < hi)
#define SEAM(k) do { if (IN(k) && IN((k) + 1)) xcd_barrier(bar); } while (0)
    if (IN(0)) { p0_prologue(F, false); } SEAM(0);
    if (IN(1)) { p1_norm1(F); } SEAM(1);
    if (IN(2)) for (int rep_ = 0; rep_ < (PROBE_TWICE == 2 ? 2 : 1); ++rep_) { if (rep_) xcd_barrier(bar);
        pg8::SchedInProj S{F.G, (int)blockIdx.x};
        pg8::EpiInProj E{(bf16_t*)(F.ws + WS_KB), (bf16_t*)(F.ws + WS_VB), (bf16_t*)(F.ws + WS_QB), (bf16_t*)(F.ws + WS_GB), (bf16_t*)(F.ws + WS_PB), (float*)(F.ws + WS_RB)};
        pg8::gemm_phase<pg8::EpiInProj, pg8::SchedInProj, true, false>(F.lds, (const char*)(F.ws + WS_HN1), (const char*)(F.ws + WS_WIN), D * 2, S, E);
    } SEAM(2);
    if (IN(3)) {
        const int bx = blockIdx.x, nG = (F.G + 1) >> 1, nP = F.G - nG;
        constexpr int CVT_N = 2048 + 1024, CVT_ODD = 2432, CVT_ODD2 = CVT_ODD + 256;
        if ((bx & 1) == 0) { for (int u = bx >> 1; u < NB * 8; u += nG) gla_unit<0>(F, u);
#if PROBE_TWICE >= 380 && PROBE_TWICE < 390
                             for (int u = bx >> 1; u < NB * 8; u += nG) gla_unit<PROBE_TWICE - 380>(F, u);
#endif
                             cvt_expert_items_dma(F, CVT_ODD2 + (bx >> 1), nG, CVT_N); }
        else { for (int u = bx >> 1; u < NB * 64; u += nP) pool_unit(F, u);
#if PROBE_TWICE == 37
               for (int u = bx >> 1; u < NB * 64; u += nP) pool_unit(F, u);
#endif
               cvt_expert_items_dma(F, bx >> 1, nP, CVT_ODD);
               if ((bx >> 1) >= 64) cvt_expert_items_dma(F, CVT_ODD + (bx >> 1) - 64, 64, CVT_ODD2);
#if PROBE_TWICE == 36
               __syncthreads(); cvt_expert_items_dma(F, bx >> 1, nP, CVT_ODD);
#endif
               __syncthreads();
               for (int rep_ = 0; rep_ < (PROBE_TWICE == 35 ? 2 : 1); ++rep_)
               { pg8::SchedInProjG S{nP, bx >> 1};
                 pg8::EpiInProj E{(bf16_t*)(F.ws + WS_KB), (bf16_t*)(F.ws + WS_VB), (bf16_t*)(F.ws + WS_QB), (bf16_t*)(F.ws + WS_GB), (bf16_t*)(F.ws + WS_PB), (float*)(F.ws + WS_RB)};
                 pg8::gemm_phase<pg8::EpiInProj, pg8::SchedInProjG, true, false>(F.lds, (const char*)(F.ws + WS_HN1), (const char*)(F.ws + WS_WIN), D * 2, S, E); } }
    } SEAM(3);
    if (IN(4)) { p4_gla_out(F); } SEAM(4);
    if (IN(5)) {
        pg8::SchedPlain S{F.G, (int)blockIdx.x, NTOK / 256, D / 256};
        pg8::EpiResid E{F.in[IN_X], (const float*)(F.ws + WS_MOD), (bf16_t*)(F.ws + WS_H1B)};
        pg8::gemm_phase<pg8::EpiResid, pg8::SchedPlain, true, false>(F.lds, (const char*)(F.ws + WS_MIX), (const char*)(F.ws + WS_WOUT), D * 2, S, E);
    } SEAM(5);
    if (IN(6)) { p6_router<0>(F);
#if PROBE_TWICE == 6
                 __syncthreads(); p6_router<1>(F);
#endif
    } SEAM(6);
    const LAS int* TST = (const LAS int*)(F.lds + LDSCTL_OFF) + LC_TST; const LAS int* LCN = (const LAS int*)(F.lds + LDSCTL_OFF) + LC_CNT;
    if (IN(7)) {
        moe_tables(F);
        pg8::SchedMoE<8, true> S{F.G, (int)blockIdx.x, TST, LCN, (const int*)(F.ws + WS_LIST)};
        pg8::EpiSwiglu<true> E{(void*)(F.ws + WS_ACT), F.in[IN_BGU], 1.f / WSCALE};
        pg8::gemm_phase<pg8::EpiSwiglu<true>, pg8::SchedMoE<8, true>, true, true>(F.lds, (const char*)(F.ws + WS_HN2), (const char*)(F.ws + WS_WGU), D, S, E);
    } SEAM(7);
    if (IN(8)) {
        moe_tables(F);
        pg8::SchedMoE<4, false> S{F.G, (int)blockIdx.x, TST, LCN, nullptr};
        pg8::EpiDown E{(unsigned char*)(F.ws + WS_Y), F.in[IN_BDOWN], 1.f / WSCALE};
        pg8::gemm_phase<pg8::EpiDown, pg8::SchedMoE<4, false>, true, true>(F.lds, (const char*)(F.ws + WS_ACT), (const char*)(F.ws + WS_WD), DFF, S, E);
    } SEAM(8);
    if (IN(9)) { moe_tables(F); p9_final(F); }
#undef IN
#undef SEAM
}

extern "C" void kernel_launch(void* const* d_in, const int* in_sizes, int n_in, void* d_out, int out_size, void* d_ws, size_t ws_size, hipStream_t stream) {
    static int grid = 0;
    if (grid == 0) {
        if (n_in != 24 || ws_size < WS_END || out_size != NTOK * D) { fprintf(stderr, "kernel_launch: unexpected n_in %d / ws_size %zu / out %d\n", n_in, ws_size, out_size); grid = -1; return; }
        int dev = 0, cus = 0, per_cu = 0;
        if (hipGetDevice(&dev) != hipSuccess || hipDeviceGetAttribute(&cus, hipDeviceAttributeMultiprocessorCount, dev) != hipSuccess) { grid = -1; return; }
        if (hipFuncSetAttribute((const void*)mk_fwd, hipFuncAttributeMaxDynamicSharedMemorySize, LDS_BYTES) != hipSuccess) { fprintf(stderr, "kernel_launch: hipFuncSetAttribute failed\n"); grid = -1; return; }
        if (hipOccupancyMaxActiveBlocksPerMultiprocessor(&per_cu, (const void*)mk_fwd, NTHR, LDS_BYTES) != hipSuccess || per_cu < 1) { fprintf(stderr, "kernel_launch: occupancy query says %d workgroups per CU\n", per_cu); (void)hipGetLastError(); grid = -1; return; }
        (void)hipGetLastError();
        grid = cus;
    }
    if (grid < 0) return;
    (void)hipMemsetAsync((char*)d_ws + WS_CTL, 0, 1 * MiB, stream);
    Args a{};
    for (int i = 0; i < 24; ++i) a.in[i] = (const float*)d_in[i];
    a.out = (float*)d_out; a.ws = (unsigned char*)d_ws;
    if (MK_N_LAUNCHES == 1) {
        a.ph_lo = 0; a.ph_hi = N_PHASES;
        void* kargs[] = {&a};
        const hipError_t e = hipLaunchCooperativeKernel((const void*)mk_fwd, dim3(grid), dim3(NTHR), kargs, LDS_BYTES, stream);
        if (e != hipSuccess) fprintf(stderr, "kernel_launch: cooperative launch failed: %s (grid %d)\n", hipGetErrorString(e), grid);
    } else {
        for (int ph = 0; ph < N_PHASES; ++ph) { a.ph_lo = ph; a.ph_hi = ph + 1; hipLaunchKernelGGL(mk_fwd, dim3(grid), dim3(NTHR), LDS_BYTES, stream, a); }
    }
}
```
